# Optimizing an MI355X kernel written in HIP

```python
import math
import jax, jax.numpy as jnp
from jax import lax
import numpy as np

D_MODEL = 1024
BATCH = 8
SEQ = 4096
DEPTH = 2

CHUNK = 64
Q_BLOCK = 128
EPS = 1e-6

A_HEADS = 4
A_DK = 64
A_DV = 2 * A_DK
B_HEADS = 4
B_DH = 64
IDX_HEADS = 8
IDX_DIM = 32
DSA_TOPK_MAX = 256
C_HEADS = 4
C_Q_LORA = 256
C_KV_LORA = 128
C_NOPE = 32
C_ROPE = 16
C_DV = 64
ROPE_THETA = 10000.0
REL_BUCKETS = 32
REL_MAX_DIST = 128
N_GROUPS = 4
EXPERTS_PER_GROUP = 8
N_EXPERTS = N_GROUPS * EXPERTS_PER_GROUP
TOP_K_IN_GROUP = 2
D_EXPERT = 512
MOE_BLOCK = 256

IN_SPLITS = (A_HEADS * 2 * A_DK, A_HEADS * 2 * A_DK, A_HEADS * A_DV,
             B_HEADS * B_DH, B_HEADS * B_DH, B_HEADS * B_DH,
             IDX_HEADS * IDX_DIM, IDX_DIM, IDX_HEADS,
             C_Q_LORA, C_KV_LORA, C_ROPE)
D_IN = sum(IN_SPLITS)
D_MIX = A_HEADS * A_DV + B_HEADS * B_DH + C_HEADS * C_DV

kernel_name = "hymba_style_diff_dsa_mla_hiermoe"


def _rms_norm(x, g):
    xf = x.astype(jnp.float32)
    y = xf * lax.rsqrt(jnp.mean(xf * xf, axis=-1, keepdims=True) + EPS)
    return (y * g.astype(jnp.float32)).astype(x.dtype)


def _t5_bucket(rel):
    half = REL_BUCKETS // 2
    exact = half // 2
    ret = jnp.where(rel > 0, half, 0)
    n = jnp.abs(rel)
    nf = jnp.maximum(n, 1).astype(jnp.float32)
    large = exact + (jnp.log(nf / exact) / math.log(REL_MAX_DIST / exact) * (half - exact)).astype(jnp.int32)
    large = jnp.minimum(large, half - 1)
    return ret + jnp.where(n < exact, n, large)


def _chunk_mask(q0, n_keys):
    t = q0 + jnp.arange(Q_BLOCK)
    s = jnp.arange(n_keys)
    return (s[None, :] // CHUNK) <= (t[:, None] // CHUNK)


def _rel_bias(table, q0, n_keys):
    t = q0 + jnp.arange(Q_BLOCK)
    s = jnp.arange(n_keys)
    b = table[_t5_bucket(s[None, :] - t[:, None])]
    return jnp.transpose(b, (2, 0, 1)).astype(jnp.float32)


def _rope_tables(seq):
    pos = jnp.arange(seq, dtype=jnp.float32)
    inv = ROPE_THETA ** (-jnp.arange(0, C_ROPE, 2, dtype=jnp.float32) / C_ROPE)
    ang = pos[:, None] * inv[None, :]
    return jnp.cos(ang), jnp.sin(ang)


def _rope(x, cos, sin):
    xf = x.astype(jnp.float32)
    x1, x2 = jnp.split(xf, 2, axis=-1)
    return jnp.concatenate([x1 * cos - x2 * sin, x1 * sin + x2 * cos], axis=-1).astype(x.dtype)


def _diff_attention(q, k, v, lam, lam_init, sub_gain, table):
    seq = q.shape[1]
    outs = []
    for q0 in range(0, seq, Q_BLOCK):
        n_keys = q0 + Q_BLOCK
        logits = jnp.einsum('bqhmd,bkhmd->bhmqk', q[:, q0:n_keys], k[:, :n_keys],
                            preferred_element_type=jnp.float32) * (A_DK ** -0.5)
        logits = logits + _rel_bias(table, q0, n_keys)[None, :, None]
        logits = jnp.where(_chunk_mask(q0, n_keys), logits, -jnp.inf)
        p = jax.nn.softmax(logits, axis=-1)
        a = p[:, :, 0] - lam * p[:, :, 1]
        outs.append(jnp.einsum('bhqk,bkhd->bqhd', a.astype(v.dtype), v[:, :n_keys]))
    o = jnp.concatenate(outs, axis=1)
    return _rms_norm(o, sub_gain) * (1.0 - lam_init)


def _dsa_attention(q, k, v, q_idx, k_idx, w_idx, table):
    seq = q.shape[1]
    topk = min(DSA_TOPK_MAX, seq // 4)
    outs = []
    for q0 in range(0, seq, Q_BLOCK):
        q1 = q0 + Q_BLOCK
        n_idx = max(q1, topk)
        t = q0 + jnp.arange(Q_BLOCK)
        s = jnp.arange(n_idx)
        adm = (s[None, :] // CHUNK) <= (t[:, None] // CHUNK)
        dots = jnp.einsum('bqhd,bkd->bqhk', q_idx[:, q0:q1], k_idx[:, :n_idx],
                          preferred_element_type=jnp.float32) * (IDX_DIM ** -0.5)
        w = w_idx[:, q0:q1].astype(jnp.float32) * (IDX_HEADS ** -0.5)
        score = jnp.einsum('bqh,bqhk->bqk', w, jax.nn.relu(dots))
        score = jnp.where(adm[None], score, -jnp.inf)
        vals, sel = lax.top_k(score, topk)
        valid = jnp.isfinite(vals)
        k_sel = jax.vmap(lambda kk, ii: kk[ii])(k, sel)
        v_sel = jax.vmap(lambda vv, ii: vv[ii])(v, sel)
        bias = table[_t5_bucket(sel - t[None, :, None])].astype(jnp.float32)
        logits = jnp.einsum('bqhd,bqkhd->bqhk', q[:, q0:q1], k_sel,
                            preferred_element_type=jnp.float32) * (B_DH ** -0.5)
        logits = logits + jnp.swapaxes(bias, 2, 3)
        logits = jnp.where(valid[:, :, None, :], logits, -jnp.inf)
        p = jax.nn.softmax(logits, axis=-1)
        outs.append(jnp.einsum('bqhk,bqkhd->bqhd', p.astype(v.dtype), v_sel))
    return jnp.concatenate(outs, axis=1)


def _mla(c_q, c_kv, k_r, q_gain, kv_gain, w_uq, w_ukv, cos, sin):
    bsz, seq, _ = c_q.shape
    q = (_rms_norm(c_q, q_gain) @ w_uq).reshape(bsz, seq, C_HEADS, C_NOPE + C_ROPE)
    q_nope = q[..., :C_NOPE]
    q_rope = _rope(q[..., C_NOPE:], cos[:, None], sin[:, None])
    kv = (_rms_norm(c_kv, kv_gain) @ w_ukv).reshape(bsz, seq, C_HEADS, C_NOPE + C_DV)
    k_nope, v = kv[..., :C_NOPE], kv[..., C_NOPE:]
    k_rope = _rope(k_r, cos, sin)
    scale = (C_NOPE + C_ROPE) ** -0.5
    outs = []
    for q0 in range(0, seq, Q_BLOCK):
        n_keys = q0 + Q_BLOCK
        logits = (jnp.einsum('bqhd,bkhd->bhqk', q_nope[:, q0:n_keys], k_nope[:, :n_keys],
                             preferred_element_type=jnp.float32)
                  + jnp.einsum('bqhr,bkr->bhqk', q_rope[:, q0:n_keys], k_rope[:, :n_keys],
                               preferred_element_type=jnp.float32)) * scale
        logits = jnp.where(_chunk_mask(q0, n_keys), logits, -jnp.inf)
        p = jax.nn.softmax(logits, axis=-1)
        outs.append(jnp.einsum('bhqk,bkhd->bqhd', p.astype(v.dtype), v[:, :n_keys]))
    return jnp.concatenate(outs, axis=1)


def _hier_moe(x, w_group, b_group, w_expert, b_expert, w_gate, w_up, w_down):
    bsz, seq, d = x.shape
    n = bsz * seq
    xf = x.reshape(n, d)
    xr = xf.astype(jnp.float32)
    g_prob = jax.nn.softmax(xr @ w_group.astype(jnp.float32) + b_group.astype(jnp.float32), axis=-1)
    g_p, g_sel = lax.top_k(g_prob, 1)
    e_logits = (xr @ w_expert.astype(jnp.float32) + b_expert.astype(jnp.float32))
    e_logits = e_logits.reshape(n, N_GROUPS, EXPERTS_PER_GROUP)
    e_logits = jnp.take_along_axis(e_logits, g_sel[:, :, None], axis=1)[:, 0]
    e_p, e_sel = lax.top_k(jax.nn.softmax(e_logits, axis=-1), TOP_K_IN_GROUP)
    gate = g_p * e_p / jnp.sum(e_p, axis=-1, keepdims=True)
    expert = g_sel * EXPERTS_PER_GROUP + e_sel
    n_assign = n * TOP_K_IN_GROUP
    flat_e = expert.reshape(-1)
    flat_tok = jnp.repeat(jnp.arange(n), TOP_K_IN_GROUP)
    flat_gate = gate.reshape(-1)
    order = jnp.argsort(flat_e)
    se, stok, sgate = flat_e[order], flat_tok[order], flat_gate[order]
    counts = jnp.bincount(flat_e, length=N_EXPERTS)
    padded = (counts + MOE_BLOCK - 1) // MOE_BLOCK * MOE_BLOCK
    pad_end = jnp.cumsum(padded)
    pad_start = pad_end - padded
    raw_start = jnp.cumsum(counts) - counts
    dest = pad_start[se] + (jnp.arange(n_assign) - raw_start[se])
    n_rows = (n_assign + MOE_BLOCK - 1) // MOE_BLOCK * MOE_BLOCK + N_EXPERTS * MOE_BLOCK
    n_blocks = n_rows // MOE_BLOCK
    buf = jnp.zeros((n_rows, d), x.dtype).at[dest].set(xf[stok])
    blk_e = jnp.minimum(jnp.searchsorted(pad_end, jnp.arange(n_blocks) * MOE_BLOCK, side='right'),
                        N_EXPERTS - 1)

    def expert_block(args):
        xb, e = args
        h = jax.nn.silu(xb @ w_gate[e]) * (xb @ w_up[e])
        return h @ w_down[e]

    y = lax.map(expert_block, (buf.reshape(n_blocks, MOE_BLOCK, d), blk_e)).reshape(n_rows, d)
    y = y[dest] * sgate[:, None].astype(y.dtype)
    out = jax.ops.segment_sum(y, stok, num_segments=n)
    return out.reshape(bsz, seq, d)


def setup_inputs(seed: int = 0) -> dict:
    key = jax.random.key(seed)
    ks = jax.random.split(key, 24)
    f32 = jnp.float32

    def nrm(k, shape, scale):
        return jax.random.normal(k, shape, f32) * scale

    def gain(k, shape):
        return 1.0 + 0.02 * jax.random.normal(k, shape, f32)

    return {
        "x": nrm(ks[0], (BATCH, SEQ, D_MODEL), 1.0),
        "w_in": nrm(ks[1], (DEPTH, D_MODEL, D_IN), D_MODEL ** -0.5),
        "w_out": nrm(ks[2], (DEPTH, D_MIX, D_MODEL), D_MIX ** -0.5),
        "norm_mix": gain(ks[3], (DEPTH, D_MODEL)),
        "norm_ffn": gain(ks[4], (DEPTH, D_MODEL)),
        "rel_bias": nrm(ks[5], (REL_BUCKETS, A_HEADS + B_HEADS), 0.5),
        "lam_q1": nrm(ks[6], (DEPTH, A_DK), 0.1),
        "lam_k1": nrm(ks[7], (DEPTH, A_DK), 0.1),
        "lam_q2": nrm(ks[8], (DEPTH, A_DK), 0.1),
        "lam_k2": nrm(ks[9], (DEPTH, A_DK), 0.1),
        "diff_subln": gain(ks[10], (DEPTH, A_DV)),
        "mla_q_norm": gain(ks[11], (DEPTH, C_Q_LORA)),
        "mla_kv_norm": gain(ks[12], (DEPTH, C_KV_LORA)),
        "w_uq": nrm(ks[13], (DEPTH, C_Q_LORA, C_HEADS * (C_NOPE + C_ROPE)), C_Q_LORA ** -0.5),
        "w_ukv": nrm(ks[14], (DEPTH, C_KV_LORA, C_HEADS * (C_NOPE + C_DV)), C_KV_LORA ** -0.5),
        "w_group": nrm(ks[15], (DEPTH, D_MODEL, N_GROUPS), D_MODEL ** -0.5),
        "b_group": nrm(ks[16], (DEPTH, N_GROUPS), 0.01),
        "w_expert": nrm(ks[17], (DEPTH, D_MODEL, N_EXPERTS), D_MODEL ** -0.5),
        "b_expert": nrm(ks[18], (DEPTH, N_EXPERTS), 0.01),
        "w_gate": nrm(ks[19], (DEPTH, N_EXPERTS, D_MODEL, D_EXPERT), D_MODEL ** -0.5),
        "w_up": nrm(ks[20], (DEPTH, N_EXPERTS, D_MODEL, D_EXPERT), D_MODEL ** -0.5),
        "w_down": nrm(ks[21], (DEPTH, N_EXPERTS, D_EXPERT, D_MODEL), D_EXPERT ** -0.5),
        "norm_final": gain(ks[22], (D_MODEL,)),
    }


def reference(x, w_in, w_out, norm_mix, norm_ffn, rel_bias, lam_q1, lam_k1, lam_q2, lam_k2,
              diff_subln, mla_q_norm, mla_kv_norm, w_uq, w_ukv, w_group, b_group, w_expert,
              b_expert, w_gate, w_up, w_down, norm_final):
    bsz, seq, _ = x.shape
    cos, sin = _rope_tables(seq)
    split_at = np.cumsum(IN_SPLITS)[:-1].tolist()
    table_a = rel_bias[:, :A_HEADS]
    table_b = rel_bias[:, A_HEADS:]
    for l in range(DEPTH):
        h = _rms_norm(x, norm_mix[l])
        z = h @ w_in[l]
        (aq, ak, av, bq, bk, bv, iq, ik, iw, cq, ckv, ckr) = jnp.split(z, split_at, axis=-1)
        lam_init = 0.8 - 0.6 * math.exp(-0.3 * l)
        lam = (jnp.exp(jnp.sum(lam_q1[l].astype(jnp.float32) * lam_k1[l].astype(jnp.float32)))
               - jnp.exp(jnp.sum(lam_q2[l].astype(jnp.float32) * lam_k2[l].astype(jnp.float32)))
               + lam_init)
        ya = _diff_attention(aq.reshape(bsz, seq, A_HEADS, 2, A_DK),
                             ak.reshape(bsz, seq, A_HEADS, 2, A_DK),
                             av.reshape(bsz, seq, A_HEADS, A_DV),
                             lam, lam_init, diff_subln[l], table_a)
        yb = _dsa_attention(bq.reshape(bsz, seq, B_HEADS, B_DH),
                            bk.reshape(bsz, seq, B_HEADS, B_DH),
                            bv.reshape(bsz, seq, B_HEADS, B_DH),
                            iq.reshape(bsz, seq, IDX_HEADS, IDX_DIM), ik, iw, table_b)
        yc = _mla(cq, ckv, ckr, mla_q_norm[l], mla_kv_norm[l], w_uq[l], w_ukv[l], cos, sin)
        mix = jnp.concatenate([ya.reshape(bsz, seq, -1), yb.reshape(bsz, seq, -1),
                               yc.reshape(bsz, seq, -1)], axis=-1)
        x = x + mix @ w_out[l]
        x = x + _hier_moe(_rms_norm(x, norm_ffn[l]), w_group[l], b_group[l], w_expert[l],
                          b_expert[l], w_gate[l], w_up[l], w_down[l])
    return _rms_norm(x, norm_final)
```

```cpp
#include <hip/hip_runtime.h>
#include <cstdio>
#include <cstdint>

#define GAS __attribute__((address_space(1)))
#define LAS __attribute__((address_space(3)))
typedef unsigned short bf16;
typedef short bf16x8 __attribute__((ext_vector_type(8)));
typedef short s16x4 __attribute__((ext_vector_type(4)));
typedef float f32x2 __attribute__((ext_vector_type(2)));
typedef float f32x4 __attribute__((ext_vector_type(4)));
typedef float f32x16 __attribute__((ext_vector_type(16)));
typedef unsigned u32x2 __attribute__((ext_vector_type(2)));
typedef unsigned u32x4 __attribute__((ext_vector_type(4)));
typedef __bf16 bf16x2_t __attribute__((ext_vector_type(2)));
typedef short v4i16_t __attribute__((ext_vector_type(4)));
typedef GAS unsigned gu32;
#define RLX_AGENT __ATOMIC_RELAXED, __HIP_MEMORY_SCOPE_AGENT
#define DI __device__ __forceinline__

constexpr int NB = 8, SEQ = 4096, DM = 1024, M = NB * SEQ;
constexpr int DIN = 3000, ZP = 3072;
constexpr int Z_AQ = 0, Z_AK = 512, Z_AV = 1024, Z_BQ = 1536, Z_BK = 1792, Z_BV = 2048, Z_IQ = 2304, Z_IK = 2560, Z_IW = 2592, Z_CQ = 2600, Z_CKV = 2856, Z_CKR = 2984;
constexpr int NEXP = 32, DEXP = 512, MAXROWS = 2 * M + NEXP * 256;
constexpr int MLAP = 768;
constexpr float EPS = 1e-6f, LOG2E = 1.4426950408889634f;
constexpr int NWAVES = 8, NTHR = 512;

constexpr size_t MiB = 1u << 20;
constexpr size_t WS_CTL = 0, CTL_ZERO_BYTES = 1 * MiB;
constexpr size_t WS_PAR = 1 * MiB;
constexpr size_t WS_WIN = 2 * MiB;
constexpr size_t WS_WOUT = 14 * MiB;
constexpr size_t WS_WUQ = 18 * MiB;
constexpr size_t WS_WUKV = WS_WUQ + 256 * 1024;
constexpr size_t WS_WR = WS_WUQ + 512 * 1024;
constexpr size_t WS_ROUTE = 19 * MiB;
constexpr size_t WS_WGU = 20 * MiB;
constexpr size_t WS_WD = 84 * MiB;
constexpr size_t WS_XA = 116 * MiB;
constexpr size_t WS_XN = 116 * MiB;
constexpr size_t WS_Z = 180 * MiB;
constexpr size_t WS_MLA = 372 * MiB;
constexpr size_t WS_MASK = 444 * MiB;
constexpr size_t WS_KIDX = 460 * MiB;
constexpr size_t WS_O0 = 462 * MiB;
constexpr size_t WS_XT = WS_Z + 128 * MiB;
constexpr size_t WS_SRC = WS_Z + 176 * MiB;
constexpr size_t WS_RS = WS_Z + 177 * MiB;
constexpr size_t WS_END = 478 * MiB;
constexpr size_t PAR_LAM = 0, PAR_LUT = 256, PAR_ORD = 8704, PAR_COS = 16384, PAR_SIN = 16384 + 131072;
constexpr size_t RT_E = 0, RT_G = 262144, RT_D = 524288, RT_CNT = 786432, RT_BLK = 786432 + 32768, RT_NBLK = 786432 + 36864, RT_RSTD = 786432 + 65536;
constexpr int CW_BAR = 4096;
constexpr int CW_QCTR = 200000;
constexpr int RING_BYTES = 131072, AUX_OFF = RING_BYTES, AUX_BYTES = 8192, MISC_OFF = AUX_OFF + AUX_BYTES, PARK_A = 81920, PARK_B = MISC_OFF + 256, LDS_BYTES = PARK_B + 16384;

DI float bf2f(bf16 v) { return __builtin_bit_cast(float, (unsigned)v << 16); }
DI unsigned cvtpk(float lo, float hi) { f32x2 v = {lo, hi}; bf16x2_t b = __builtin_convertvector(v, bf16x2_t); return __builtin_bit_cast(unsigned, b); }
DI bf16 f2bf(float f) { return (bf16)(cvtpk(f, 0.f) & 0xffffu); }
DI float wave_sum(float v) {
#pragma unroll
    for (int o = 1; o < 64; o <<= 1) v += __shfl_xor(v, o);
    return v;
}
DI float halfswap_max(float m) { auto rr = __builtin_amdgcn_permlane32_swap(__float_as_uint(m), __float_as_uint(m), false, false); return fmaxf(__uint_as_float(rr[0]), __uint_as_float(rr[1])); }
DI float halfswap_sum(float m) { auto rr = __builtin_amdgcn_permlane32_swap(__float_as_uint(m), __float_as_uint(m), false, false); return __uint_as_float(rr[0]) + __uint_as_float(rr[1]); }
#define MFMA32(a, b, c) __builtin_amdgcn_mfma_f32_32x32x16_bf16((a), (b), (c), 0, 0, 0)
namespace pg8 {
#define PG8_LAS __attribute__((address_space(3)))
typedef unsigned short bf16_t;
constexpr int BM = 256, BK = 64, HALF = 128, HTB = HALF * BK * 2  , STAGE_BYTES = 8 * HTB, NXCD = 8, WGM = 8;

__host__ __device__ __forceinline__ int lds_byte(int r, int c) { const int st = (r >> 4) * 2 + (c >> 5), rr = r & 15, cc = c & 31, ob = rr * 64 + cc * 2; return st * 1024 + (ob ^ (((ob >> 9) & 1) << 5)); }
__host__ __device__ __forceinline__ void stage_rc(int b, int& R, int& C) { const int st = b / 1024, sb = b % 1024, swz = sb ^ (((sb >> 9) & 1) << 5); R = (st >> 1) * 16 + swz / 64; C = (st & 1) * 32 + (swz % 64) / 2; }
__host__ __device__ __forceinline__ int perm32(int rho) { const int n = rho >> 4, i = rho & 15; return 8 * (i >> 2) + 4 * n + (i & 3); }

struct Unit { int pm, pn, pb; };
struct Gemm { const void* A; const void* Bt; int lda, K; };

struct StaticOrder {
    static constexpr const int* src = nullptr;
    int nM, nN, nwg, G, c, rep = 1;
    __host__ __device__ void init(int M_, int N_, int G_, int c_) { nM = M_ / BM; nN = N_ / BM; nwg = nM * nN; G = G_; c = c_; }
    __host__ __device__ bool next(int i, Unit& u) const {
        if (rep > 1) { const int cntU = c < nwg ? (nwg - c + G - 1) / G : 0; if (i >= cntU * rep) return false; i %= cntU; }
        const long L = (long)i * G + c; if (L >= nwg) return false;
        int wgid = (int)L; { const int q = nwg / NXCD, r = nwg % NXCD, xcd = wgid % NXCD, off = wgid / NXCD; wgid = (xcd < r ? xcd * (q + 1) : r * (q + 1) + (xcd - r) * q) + off; }
        const int nig = WGM * nN, gid = wgid / nig, fm = gid * WGM, gsz = (nM - fm) < WGM ? (nM - fm) : WGM;
        u.pm = fm + ((wgid % nig) % gsz); u.pn = (wgid % nig) / gsz; u.pb = u.pn; return true;
    }
    __device__ __forceinline__ void a_ready(const Unit&) const {}
    __device__ __forceinline__ void done(const Unit&) const {}
};
struct MoeOrder {
    const int* blk_e; int nunits, G, c, rep = 1; const int* src = nullptr;
    __device__ __forceinline__ bool next(int i, Unit& u) const {
        if (rep > 1) { const int cntU = c < nunits ? (nunits - c + G - 1) / G : 0; if (i >= cntU * rep) return false; i %= cntU; }
        int pm, pn;
        if ((G & 31) == 0) { const int x = c & 7, j = c >> 3, rpx = G >> 5; pm = i * (G >> 2) + x * rpx + (j >> 2); pn = j & 3; }
        else { const int L = i * G + c; pm = L >> 2; pn = L & 3; }
        if (pm * 4 >= nunits) return false;
        u.pm = pm; u.pn = pn; u.pb = blk_e[pm] * 4 + pn; return true;
    }
    __device__ __forceinline__ void a_ready(const Unit&) const {}
    __device__ __forceinline__ void done(const Unit&) const {}
};

struct EpiBf16 {
    static constexpr bool PERM = true, AFTER_DRAIN = false;
    bf16_t* O; int ldc; float scale = 1.f;
    __device__ __forceinline__ void operator()(const f32x4 (&acc)[2][2][4][2], const Unit& u, int wr, int wc, int fr, int fq) const {
        const int row0 = u.pm * BM + wr * 64 + fr, col0 = u.pn * BM + wc * 32 + 8 * fq;
#pragma unroll
        for (int ai = 0; ai < 2; ++ai)
#pragma unroll
            for (int m = 0; m < 4; ++m) { bf16_t* rowp = O + (size_t)(row0 + ai * HALF + m * 16) * ldc + col0;
#pragma unroll
                for (int bj = 0; bj < 2; ++bj) { const f32x4 v0 = acc[ai][bj][m][0] * scale, v1 = acc[ai][bj][m][1] * scale;
                    u32x4 w; w.x = cvtpk(v0[0], v0[1]); w.y = cvtpk(v0[2], v0[3]); w.z = cvtpk(v1[0], v1[1]); w.w = cvtpk(v1[2], v1[3]);
                    *(u32x4*)(rowp + bj * HALF) = w; } }
    }
};
struct EpiF8 {
    static constexpr bool PERM = true, AFTER_DRAIN = false;
    unsigned char* O; int ldc; float scale;
    __device__ __forceinline__ void operator()(const f32x4 (&acc)[2][2][4][2], const Unit& u, int wr, int wc, int fr, int fq) const {
        const int row0 = u.pm * BM + wr * 64 + fr, col0 = u.pn * BM + wc * 32 + 8 * fq;
#pragma unroll
        for (int ai = 0; ai < 2; ++ai)
#pragma unroll
            for (int m = 0; m < 4; ++m) { unsigned char* rowp = O + (size_t)(row0 + ai * HALF + m * 16) * ldc + col0;
#pragma unroll
                for (int bj = 0; bj < 2; ++bj) { float h[8];
#pragma unroll
                    for (int n = 0; n < 2; ++n)
#pragma unroll
                        for (int e = 0; e < 4; ++e) h[4 * n + e] = __builtin_amdgcn_fmed3f(acc[ai][bj][m][n][e] * scale, -448.f, 448.f);
                    int w0 = 0, w1 = 0;
                    w0 = __builtin_amdgcn_cvt_pk_fp8_f32(h[0], h[1], w0, false); w0 = __builtin_amdgcn_cvt_pk_fp8_f32(h[2], h[3], w0, true);
                    w1 = __builtin_amdgcn_cvt_pk_fp8_f32(h[4], h[5], w1, false); w1 = __builtin_amdgcn_cvt_pk_fp8_f32(h[6], h[7], w1, true);
                    u32x2 w; w.x = (unsigned)w0; w.y = (unsigned)w1; *(u32x2*)(rowp + bj * HALF) = w; } }
    }
};
struct EpiF8A {
    static constexpr bool PERM = true, AFTER_DRAIN = false;
    unsigned char* O; int ldc; float scale;
    __device__ __forceinline__ void operator()(const f32x4 (&acc)[2][2][4][2], const Unit& u, int wr, int wc, int fr, int fq) const {
        const int row0 = u.pm * BM + wr * 64 + fr, col0 = u.pn * BM + wc * 64 + 16 * fq;
#pragma unroll
        for (int ai = 0; ai < 2; ++ai)
#pragma unroll
            for (int m = 0; m < 4; ++m) { unsigned char* rowp = O + (size_t)(row0 + ai * HALF + m * 16) * ldc + col0; u32x4 w;
#pragma unroll
                for (int bj = 0; bj < 2; ++bj) { float h[8];
#pragma unroll
                    for (int n = 0; n < 2; ++n)
#pragma unroll
                        for (int e = 0; e < 4; ++e) h[4 * n + e] = __builtin_amdgcn_fmed3f(acc[ai][bj][m][n][e] * scale, -448.f, 448.f);
                    int w0 = 0, w1 = 0;
                    w0 = __builtin_amdgcn_cvt_pk_fp8_f32(h[0], h[1], w0, false); w0 = __builtin_amdgcn_cvt_pk_fp8_f32(h[2], h[3], w0, true);
                    w1 = __builtin_amdgcn_cvt_pk_fp8_f32(h[4], h[5], w1, false); w1 = __builtin_amdgcn_cvt_pk_fp8_f32(h[6], h[7], w1, true);
                    w[2 * bj] = (unsigned)w0; w[2 * bj + 1] = (unsigned)w1; }
                *(u32x4*)rowp = w; }
    }
};
struct EpiZ {
    static constexpr bool PERM = true, AFTER_DRAIN = false;
    bf16_t* O; bf16_t* KIDX;
    __device__ __forceinline__ void operator()(const f32x4 (&acc)[2][2][4][2], const Unit& u, int wr, int wc, int fr, int fq) const {
        const int row0 = u.pm * BM + wr * 64 + fr, col0 = u.pn * BM + wc * 32 + 8 * fq;
        const bool kx = (u.pn == 10) && (wc == 0);
#pragma unroll
        for (int ai = 0; ai < 2; ++ai)
#pragma unroll
            for (int m = 0; m < 4; ++m) { const int row = row0 + ai * HALF + m * 16; bf16_t* rowp = O + (size_t)row * 3072 + col0;
#pragma unroll
                for (int bj = 0; bj < 2; ++bj) { const f32x4 v0 = acc[ai][bj][m][0], v1 = acc[ai][bj][m][1];
                    u32x4 w; w.x = cvtpk(v0[0], v0[1]); w.y = cvtpk(v0[2], v0[3]); w.z = cvtpk(v1[0], v1[1]); w.w = cvtpk(v1[2], v1[3]);
                    *(u32x4*)(rowp + bj * HALF) = w;
                    if (bj == 0 && kx) *(u32x4*)(KIDX + (size_t)row * 32 + 8 * fq) = w; } }
    }
};
template <bool BASE16>
struct EpiRes {
    static constexpr bool PERM = true, AFTER_DRAIN = false;
    const void* base; bf16_t* out; const float* gain; unsigned char* XT;
    __device__ __forceinline__ void operator()(const f32x4 (&acc)[2][2][4][2], const Unit& u, int wr, int wc, int fr, int fq) const {
        const int row0 = u.pm * BM + wr * 64 + fr, col0 = u.pn * BM + wc * 32 + 8 * fq;
        f32x4 gn[2][2];
#pragma unroll
        for (int bj = 0; bj < 2; ++bj) { gn[bj][0] = *(const f32x4*)(gain + col0 + bj * HALF); gn[bj][1] = *(const f32x4*)(gain + col0 + bj * HALF + 4); }
#pragma unroll
        for (int ai = 0; ai < 2; ++ai)
#pragma unroll
            for (int m = 0; m < 4; ++m) { const size_t off = (size_t)(row0 + ai * HALF + m * 16) * 1024 + col0;
#pragma unroll
                for (int bj = 0; bj < 2; ++bj) { f32x4 b0, b1;
                    if constexpr (BASE16) { const u32x4 bw = *(const u32x4*)((const bf16_t*)base + off + bj * HALF);
                        b0 = (f32x4){__uint_as_float(bw.x << 16), __uint_as_float(bw.x & 0xffff0000u), __uint_as_float(bw.y << 16), __uint_as_float(bw.y & 0xffff0000u)};
                        b1 = (f32x4){__uint_as_float(bw.z << 16), __uint_as_float(bw.z & 0xffff0000u), __uint_as_float(bw.w << 16), __uint_as_float(bw.w & 0xffff0000u)}; }
                    else { b0 = *(const f32x4*)((const float*)base + off + bj * HALF); b1 = *(const f32x4*)((const float*)base + off + bj * HALF + 4); }
                    const f32x4 o0 = b0 + acc[ai][bj][m][0], o1 = b1 + acc[ai][bj][m][1];
                    { u32x4 ow; ow.x = cvtpk(o0[0], o0[1]); ow.y = cvtpk(o0[2], o0[3]); ow.z = cvtpk(o1[0], o1[1]); ow.w = cvtpk(o1[2], o1[3]); *(u32x4*)(out + off + bj * HALF) = ow; }
                    const f32x4 t0 = o0 * gn[bj][0], t1 = o1 * gn[bj][1]; int w0 = 0, w1 = 0;
                    w0 = __builtin_amdgcn_cvt_pk_fp8_f32(t0[0], t0[1], w0, false); w0 = __builtin_amdgcn_cvt_pk_fp8_f32(t0[2], t0[3], w0, true);
                    w1 = __builtin_amdgcn_cvt_pk_fp8_f32(t1[0], t1[1], w1, false); w1 = __builtin_amdgcn_cvt_pk_fp8_f32(t1[2], t1[3], w1, true);
                    u32x2 w8; w8.x = (unsigned)w0; w8.y = (unsigned)w1; *(u32x2*)(XT + off + bj * HALF) = w8; } }
    }
};
struct EpiGU {
    static constexpr bool PERM = true, AFTER_DRAIN = false;
    unsigned char* H; const float* RS;
    __device__ __forceinline__ void operator()(const f32x4 (&acc)[2][2][4][2], const Unit& u, int wr, int wc, int fr, int fq) const {
        const int row0 = u.pm * BM + wr * 64 + fr, col0 = u.pn * HALF + wc * 32 + 8 * fq;
        float rs[2][4];
#pragma unroll
        for (int ai = 0; ai < 2; ++ai)
#pragma unroll
            for (int m = 0; m < 4; ++m) rs[ai][m] = RS[row0 + ai * HALF + m * 16] * 0.03125f;
#pragma unroll
        for (int ai = 0; ai < 2; ++ai)
#pragma unroll
            for (int m = 0; m < 4; ++m) { unsigned char* rowp = H + (size_t)(row0 + ai * HALF + m * 16) * 512 + col0;
                float h[8];
#pragma unroll
                for (int n = 0; n < 2; ++n)
#pragma unroll
                    for (int e = 0; e < 4; ++e) { const float g = acc[ai][0][m][n][e] * rs[ai][m], up = acc[ai][1][m][n][e] * rs[ai][m];
                        const float hv = 8.f * g * __builtin_amdgcn_rcpf(1.f + __builtin_amdgcn_exp2f(-g * 1.4426950408889634f)) * up;
                        h[4 * n + e] = __builtin_amdgcn_fmed3f(hv, -448.f, 448.f); }
                int w0 = 0, w1 = 0;
                w0 = __builtin_amdgcn_cvt_pk_fp8_f32(h[0], h[1], w0, false); w0 = __builtin_amdgcn_cvt_pk_fp8_f32(h[2], h[3], w0, true);
                w1 = __builtin_amdgcn_cvt_pk_fp8_f32(h[4], h[5], w1, false); w1 = __builtin_amdgcn_cvt_pk_fp8_f32(h[6], h[7], w1, true);
                u32x2 w; w.x = (unsigned)w0; w.y = (unsigned)w1; *(u32x2*)rowp = w; }
    }
};

template <class Epi, class Sched, bool ALIGN_EPI = false, bool SP2 = false, int ESZ = 2  ,
          bool GATHER = false  ,
          bool BADJ = false  >
__device__ __forceinline__ void gemm_phase(PG8_LAS unsigned char* lds, const Gemm g, const Sched& S, const Epi& E, const int tid) {
    const int wid = __builtin_amdgcn_readfirstlane(tid >> 6), lane = tid & 63, wr = wid >> 2, wc = wid & 3, fr = lane & 15, fq = lane >> 4;
    const int K = g.K, nt = K * ESZ / (BK * 2);
    unsigned voffA[2], voffB[2], colA[2]; int rowA[2];
#pragma unroll
    for (int i = 0; i < 2; ++i) { int R, C; stage_rc(tid * 16 + i * 8192, R, C); const int c32_ = perm32(R & 31);
        const int Rb = BADJ ? (64 * (R >> 5) + 16 * (c32_ >> 3) + (c32_ & 7)) : (Epi::PERM ? ((R & ~31) + c32_) : R);
        voffA[i] = (unsigned)(R * g.lda * ESZ + C * 2); voffB[i] = (unsigned)(Rb * K * ESZ + C * 2); rowA[i] = R; colA[i] = (unsigned)(C * 2); }
    unsigned vgc[2][2], vgn[2][2];
#define PG8_SRC(u, vg) do { _Pragma("unroll") for (int h_ = 0; h_ < 2; ++h_) _Pragma("unroll") for (int i_ = 0; i_ < 2; ++i_) \
        vg[h_][i_] = (unsigned)S.src[(u).pm * BM + h_ * HALF + rowA[i_]] * (unsigned)(g.lda * ESZ) + colA[i_]; } while (0)
#define PG8_STAGE_A(bufoff, gbase, h, VG) do { if constexpr (GATHER) PG8_STAGE(bufoff, gbase, VG[h]); else PG8_STAGE(bufoff, (gbase) + (h) * hstepA, voffA); } while (0)
    const size_t kstep = (size_t)(BK * 2);
    const size_t hstepA = (size_t)HALF * g.lda * ESZ, hstepB = (size_t)(BADJ ? 8 : HALF) * K * ESZ;
    const size_t tstepA = 2 * hstepA, tstepB = (size_t)BM * K * ESZ;
    const unsigned ldsw = (unsigned)wid * 1024u;
    const int aoff = lds_byte(wr * 64 + fr, fq * 8), boff = lds_byte(wc * 32 + fr, fq * 8);
#define PG8_SA(b, h) (((b) * 2 + (h)) * HTB)
#define PG8_SB(b, h) ((4 + (b) * 2 + (h)) * HTB)
#define PG8_STAGE(bufoff, gbase, voff) do { _Pragma("unroll") for (int _i = 0; _i < 2; ++_i) \
        __builtin_amdgcn_global_load_lds((const unsigned*)((const char*)(gbase) + (voff)[_i]), (PG8_LAS unsigned*)(lds + (bufoff) + ldsw + _i * 8192), 16, 0, 0); } while (0)
#define PG8_LDA(dst, b, h) do { _Pragma("unroll") for (int m = 0; m < 4; ++m) { if constexpr (ESZ == 2) { _Pragma("unroll") for (int k = 0; k < 2; ++k) dst[m][k] = *(const PG8_LAS bf16x8*)(lds + PG8_SA(b, h) + aoff + m * 2048 + k * 1024); } \
        else { const u32x4 lo_ = *(const PG8_LAS u32x4*)(lds + PG8_SA(b, h) + aoff + m * 2048), hi_ = *(const PG8_LAS u32x4*)(lds + PG8_SA(b, h) + aoff + m * 2048 + 1024); dst##8[m] = __builtin_shufflevector(lo_, hi_, 0, 1, 2, 3, 4, 5, 6, 7); } } } while (0)
#define PG8_LDB(dst, b, h) do { _Pragma("unroll") for (int n = 0; n < 2; ++n) { if constexpr (ESZ == 2) { _Pragma("unroll") for (int k = 0; k < 2; ++k) dst[n][k] = *(const PG8_LAS bf16x8*)(lds + PG8_SB(b, h) + boff + n * 2048 + k * 1024); } \
        else { const u32x4 lo_ = *(const PG8_LAS u32x4*)(lds + PG8_SB(b, h) + boff + n * 2048), hi_ = *(const PG8_LAS u32x4*)(lds + PG8_SB(b, h) + boff + n * 2048 + 1024); dst##8[n] = __builtin_shufflevector(lo_, hi_, 0, 1, 2, 3, 4, 5, 6, 7); } } } while (0)
#define PG8_MMA(ai, bj, At, Bt) do { __builtin_amdgcn_s_setprio(1); _Pragma("unroll") for (int m = 0; m < 4; ++m) _Pragma("unroll") for (int n = 0; n < 2; ++n) { \
        if constexpr (ESZ == 2) { _Pragma("unroll") for (int k = 0; k < 2; ++k) acc[ai][bj][m][n] = __builtin_amdgcn_mfma_f32_16x16x32_bf16(Bt[n][k], At[m][k], acc[ai][bj][m][n], 0, 0, 0); } \
        else acc[ai][bj][m][n] = __builtin_amdgcn_mfma_scale_f32_16x16x128_f8f6f4(__builtin_bit_cast(v8i_t, Bt##8[n]), __builtin_bit_cast(v8i_t, At##8[m]), acc[ai][bj][m][n], 0, 0, 0, 0, 0, 0); } \
        __builtin_amdgcn_s_setprio(0); if constexpr (ESZ == 1) { _Pragma("unroll") for (int m = 0; m < 4; ++m) _Pragma("unroll") for (int n = 0; n < 2; ++n) asm volatile("" : "+v"(acc[ai][bj][m][n])); } } while (0)
#define PG8_WAIT_V(n) asm volatile("s_waitcnt vmcnt(" #n ")" ::: "memory")
#define PG8_WAIT_L(n) asm volatile("s_waitcnt lgkmcnt(" #n ")" ::: "memory")
#define PG8_BAR __builtin_amdgcn_s_barrier()
#define PG8_SCHED __builtin_amdgcn_sched_barrier(0)
    Unit cur, nxt; int ui = 0;
    if (!S.next(0, cur)) return;
    f32x4 acc[2][2][4][2];
#pragma unroll
    for (int a = 0; a < 2; ++a)
#pragma unroll
        for (int b = 0; b < 2; ++b)
#pragma unroll
            for (int m = 0; m < 4; ++m)
#pragma unroll
                for (int n = 0; n < 2; ++n) acc[a][b][m][n] = (f32x4){0.f, 0.f, 0.f, 0.f};
    typedef int v8i_t __attribute__((ext_vector_type(8))); typedef unsigned u32x8_t __attribute__((ext_vector_type(8)));
    bf16x8 At[4][2], B0[2][2], B1[2][2]; u32x8_t At8[4], B08[2], B18[2];
    const char* cA = (const char*)g.A + (GATHER ? (size_t)0 : (size_t)cur.pm * tstepA); const char* cB = (const char*)g.Bt + (size_t)cur.pb * tstepB;
    if constexpr (GATHER) PG8_SRC(cur, vgc);
    S.a_ready(cur);
    if constexpr (SP2) {
        PG8_STAGE(PG8_SB(0, 0), cB, voffB); PG8_STAGE(PG8_SB(0, 1), cB + hstepB, voffB); PG8_STAGE_A(PG8_SA(0, 0), cA, 0, vgc); PG8_STAGE_A(PG8_SA(0, 1), cA, 1, vgc);
        if (wr == 1) PG8_BAR;
        PG8_WAIT_V(2); PG8_BAR;
        PG8_STAGE(PG8_SB(1, 0), cB + kstep, voffB); PG8_STAGE_A(PG8_SA(1, 0), cA + kstep, 0, vgc); PG8_STAGE(PG8_SB(1, 1), cB + hstepB + kstep, voffB);
        PG8_WAIT_V(6); PG8_BAR;
    } else {
        PG8_STAGE(PG8_SB(0, 0), cB, voffB); PG8_STAGE(PG8_SA(0, 0), cA, voffA); PG8_STAGE(PG8_SB(0, 1), cB + hstepB, voffB); PG8_STAGE(PG8_SA(0, 1), cA + hstepA, voffA);
        if (wr == 1) PG8_BAR;
        PG8_WAIT_V(4); PG8_BAR;
        PG8_STAGE(PG8_SB(1, 0), cB + kstep, voffB); PG8_STAGE(PG8_SA(1, 0), cA + kstep, voffA); PG8_STAGE(PG8_SB(1, 1), cB + hstepB + kstep, voffB);
        PG8_WAIT_V(6); PG8_BAR;
    }
    for (;;) {
        const bool has_next = S.next(ui + 1, nxt);
        const char* nA = (has_next && !GATHER) ? (const char*)g.A + (size_t)nxt.pm * tstepA : cA; const char* nB = has_next ? (const char*)g.Bt + (size_t)nxt.pb * tstepB : cB;
        if constexpr (GATHER) { static_assert(!GATHER || SP2, "GATHER is wired into the SP2 loop only"); if (has_next) PG8_SRC(nxt, vgn); else { _Pragma("unroll") for (int h_ = 0; h_ < 2; ++h_) _Pragma("unroll") for (int i_ = 0; i_ < 2; ++i_) vgn[h_][i_] = vgc[h_][i_]; } }
#pragma unroll 1
        for (int t = 0; t < nt; t += 2) {
            const bool last = (t == nt - 2);
            const char* a1 = cA + (size_t)(t + 1) * kstep;
            const char* a2 = last ? nA : cA + (size_t)(t + 2) * kstep; const char* b2 = last ? nB : cB + (size_t)(t + 2) * kstep;
            const char* a3 = a2 + kstep; const char* b3 = b2 + kstep;
            if (last && has_next) S.a_ready(nxt);
            unsigned vg2[2][2];
            if constexpr (GATHER) { _Pragma("unroll") for (int h_ = 0; h_ < 2; ++h_) _Pragma("unroll") for (int i_ = 0; i_ < 2; ++i_) vg2[h_][i_] = last ? vgn[h_][i_] : vgc[h_][i_]; }
            if constexpr (SP2) {
            PG8_LDB(B0, 0, 0); PG8_LDB(B1, 0, 1); PG8_SCHED; PG8_LDA(At, 0, 0); PG8_STAGE_A(PG8_SA(1, 1), a1, 1, vgc);
            PG8_WAIT_V(8); PG8_WAIT_L(0); PG8_BAR; PG8_MMA(0, 0, At, B0); PG8_MMA(0, 1, At, B1); PG8_BAR; PG8_SCHED;
            PG8_LDA(At, 0, 1); PG8_STAGE(PG8_SB(0, 0), b2, voffB); PG8_STAGE(PG8_SB(0, 1), b2 + hstepB, voffB); PG8_STAGE_A(PG8_SA(0, 0), a2, 0, vg2);
            PG8_WAIT_V(8); PG8_WAIT_L(0); PG8_BAR; PG8_MMA(1, 0, At, B0); PG8_MMA(1, 1, At, B1); PG8_BAR; PG8_SCHED;
            PG8_LDB(B0, 1, 0); PG8_LDB(B1, 1, 1); PG8_SCHED; PG8_LDA(At, 1, 0); PG8_STAGE_A(PG8_SA(0, 1), a2, 1, vg2);
            PG8_WAIT_V(8); PG8_WAIT_L(0); PG8_BAR; PG8_MMA(0, 0, At, B0); PG8_MMA(0, 1, At, B1); PG8_BAR; PG8_SCHED;
            PG8_LDA(At, 1, 1); PG8_STAGE(PG8_SB(1, 0), b3, voffB); PG8_STAGE(PG8_SB(1, 1), b3 + hstepB, voffB); PG8_STAGE_A(PG8_SA(1, 0), a3, 0, vg2);
            PG8_WAIT_V(8); PG8_WAIT_L(0); PG8_BAR; PG8_MMA(1, 0, At, B0); PG8_MMA(1, 1, At, B1); PG8_BAR; PG8_SCHED;
            } else {
            PG8_LDB(B0, 0, 0); PG8_SCHED; PG8_LDA(At, 0, 0); PG8_STAGE(PG8_SA(1, 1), a1 + hstepA, voffA);
            PG8_WAIT_L(8); PG8_BAR; PG8_WAIT_L(0); PG8_MMA(0, 0, At, B0); PG8_BAR; PG8_SCHED;
            PG8_LDB(B1, 0, 1); PG8_STAGE(PG8_SB(0, 0), b2, voffB);
            PG8_BAR; PG8_WAIT_L(0); PG8_MMA(0, 1, At, B1); PG8_BAR;
            PG8_LDA(At, 0, 1); PG8_STAGE(PG8_SA(0, 0), a2, voffA);
            PG8_BAR; PG8_WAIT_L(0); PG8_MMA(1, 0, At, B0); PG8_BAR; PG8_SCHED;
            PG8_STAGE(PG8_SB(0, 1), b2 + hstepB, voffB);
            PG8_WAIT_V(6); PG8_BAR; PG8_MMA(1, 1, At, B1); PG8_BAR;
            PG8_LDB(B0, 1, 0); PG8_SCHED; PG8_LDA(At, 1, 0); PG8_STAGE(PG8_SA(0, 1), a2 + hstepA, voffA);
            PG8_WAIT_L(8); PG8_BAR; PG8_WAIT_L(0); PG8_MMA(0, 0, At, B0); PG8_BAR; PG8_SCHED;
            PG8_LDB(B1, 1, 1); PG8_STAGE(PG8_SB(1, 0), b3, voffB);
            PG8_BAR; PG8_WAIT_L(0); PG8_MMA(0, 1, At, B1); PG8_BAR;
            PG8_LDA(At, 1, 1); PG8_STAGE(PG8_SA(1, 0), a3, voffA);
            PG8_BAR; PG8_WAIT_L(0); PG8_MMA(1, 0, At, B0); PG8_BAR; PG8_SCHED;
            PG8_STAGE(PG8_SB(1, 1), b3 + hstepB, voffB);
            PG8_WAIT_V(6); PG8_BAR; PG8_MMA(1, 1, At, B1); PG8_BAR;
            }
        }
        if constexpr (ALIGN_EPI) { if (wr == 0) PG8_BAR; }
        if constexpr (!Epi::AFTER_DRAIN) { E(acc, cur, wr, wc, fr, fq); S.done(cur); }
        if (!has_next) break;
#pragma unroll
        for (int a = 0; a < 2; ++a)
#pragma unroll
            for (int b = 0; b < 2; ++b)
#pragma unroll
                for (int m = 0; m < 4; ++m)
#pragma unroll
                    for (int n = 0; n < 2; ++n) acc[a][b][m][n] = (f32x4){0.f, 0.f, 0.f, 0.f};
        cur = nxt; cA = nA; cB = nB; ++ui;
        if constexpr (GATHER) { _Pragma("unroll") for (int h_ = 0; h_ < 2; ++h_) _Pragma("unroll") for (int i_ = 0; i_ < 2; ++i_) vgc[h_][i_] = vgn[h_][i_]; }
        if constexpr (ALIGN_EPI) { if (wr == 1) PG8_BAR; }
    }
    PG8_WAIT_V(0);
    if constexpr (!ALIGN_EPI) { if (wr == 0) PG8_BAR; }
    PG8_BAR;
    if constexpr (Epi::AFTER_DRAIN) { E.fused(acc, cur, wr, wc, fr, fq, lds, wid, lane); S.done(cur); }
#undef PG8_SA
#undef PG8_SB
#undef PG8_STAGE
#undef PG8_STAGE_A
#undef PG8_SRC
#undef PG8_LDA
#undef PG8_LDB
#undef PG8_MMA
#undef PG8_WAIT_V
#undef PG8_WAIT_L
#undef PG8_BAR
#undef PG8_SCHED
}
}

#define XB_TMO      128
#define XB_XCNT(j)  (256  + 64 * (j))
#define XB_XSUB(j)  (1280 + 64 * (j))
#define XB_XGEN(j)  (2304 + 64 * (j))
#define XB_TOP      3328
#define XB_TOPGEN   3392
#define XCD_BAR_WORDS 3456
#define XB_SPIN_CAP (1u << 18)

__device__ __forceinline__ unsigned xb_ld(unsigned* p)              { return __hip_atomic_load(p, __ATOMIC_RELAXED, __HIP_MEMORY_SCOPE_AGENT); }
__device__ __forceinline__ unsigned xb_add(unsigned* p, unsigned v) { return __hip_atomic_fetch_add(p, v, __ATOMIC_RELAXED, __HIP_MEMORY_SCOPE_AGENT); }
__device__ __forceinline__ unsigned xb_xcc_id() { return (unsigned)__builtin_amdgcn_s_getreg((3 << 11) | 20) & 0xFu; }
#define XB_SPIN(cond, bar) do { unsigned _sp = 0; while (cond) { __builtin_amdgcn_s_sleep(1); \
    if ((++_sp & 255u) == 0u) { if (xb_ld(&(bar)[XB_TMO])) break; if (_sp > XB_SPIN_CAP) { atomicAdd(&(bar)[XB_TMO], 1u); break; } } } } while (0)

struct XcdBarrier {
    unsigned* bar; unsigned x;
    volatile LAS unsigned* st;
};

__device__ __forceinline__ XcdBarrier xcd_barrier_post(unsigned* bar, volatile LAS unsigned* st) {
    XcdBarrier b; b.bar = bar; b.x = xb_xcc_id(); b.st = st;
    if (threadIdx.x == 0) (void)xb_add(&bar[XB_XCNT(b.x)], 1u);
    return b;
}
__device__ __forceinline__ void xcd_barrier_complete(unsigned* bar, unsigned x, unsigned& nloc, unsigned& nx) {
    const unsigned G = gridDim.x * gridDim.y * gridDim.z;
    unsigned sum, cnt, mine, sp = 0u;
    for (;;) {
        sum = 0u; cnt = 0u; mine = 0u;
#pragma unroll
        for (unsigned j = 0; j < 16; ++j) { const unsigned c = xb_ld(&bar[XB_XCNT(j)]); sum += c; cnt += (c > 0u) ? 1u : 0u; mine = (j == x) ? c : mine; }
        if (sum == G) break;
        __builtin_amdgcn_s_sleep(1);
        if ((++sp & 255u) == 0u) { if (xb_ld(&bar[XB_TMO])) break; if (sp > XB_SPIN_CAP) { atomicAdd(&bar[XB_TMO], 1u); break; } }
    }
    nloc = mine > 0u ? mine : 1u; nx = cnt > 0u ? cnt : 1u;
}

__device__ __forceinline__ void xcd_barrier(const XcdBarrier& b) {
    asm volatile("s_waitcnt vmcnt(0)" ::: "memory");
    __syncthreads();
    if (threadIdx.x == 0) {
        unsigned* bar = b.bar;
        __builtin_amdgcn_s_waitcnt(0);
        unsigned nloc = b.st[0], nx = b.st[1];
        if (nloc == 0u) { xcd_barrier_complete(bar, b.x, nloc, nx); b.st[0] = nloc; b.st[1] = nx; }
        const unsigned old = xb_add(&bar[XB_XSUB(b.x)], 1u);
        const unsigned gen = old / nloc;
        if (old + 1u == (gen + 1u) * nloc) {
            __builtin_amdgcn_fence(__ATOMIC_RELEASE, "agent");
            asm volatile("s_waitcnt vmcnt(0)" ::: "memory");
            const unsigned og = xb_add(&bar[XB_TOP], 1u);
            const unsigned tg = og / nx;
            if (og + 1u == (tg + 1u) * nx) xb_add(&bar[XB_TOPGEN], 1u);
            else XB_SPIN(xb_ld(&bar[XB_TOPGEN]) == tg, bar);
            __builtin_amdgcn_fence(__ATOMIC_ACQUIRE, "agent");
            xb_add(&bar[XB_XGEN(b.x)], 1u);
            asm volatile("s_waitcnt vmcnt(0)" ::: "memory");
        } else {
            XB_SPIN(xb_ld(&bar[XB_XGEN(b.x)]) == gen, bar);
            __builtin_amdgcn_fence(__ATOMIC_ACQUIRE, "agent");
            asm volatile("s_waitcnt vmcnt(0)" ::: "memory");
        }
    }
    __syncthreads();
}

template <class Fetch, class Dst>
DI void tr_item(LAS float* scr, int k0, int n0, int lane, const Fetch& fetch, const Dst& dst) {
#pragma unroll 8
    for (int i = 0; i < 32; ++i) { const int kk = 2 * i + (lane >> 5); scr[kk * 33 + (lane & 31)] = fetch(k0 + kk, n0 + (lane & 31)); }
    asm volatile("s_waitcnt lgkmcnt(0)" ::: "memory");
    const int c = lane & 7;
#pragma unroll
    for (int j = 0; j < 4; ++j) { const int n = (lane >> 3) + 8 * j; const LAS float* s = scr + (8 * c) * 33 + n;
        u32x4 o; o.x = cvtpk(s[0], s[33]); o.y = cvtpk(s[66], s[99]); o.z = cvtpk(s[132], s[165]); o.w = cvtpk(s[198], s[231]);
        *(u32x4*)(dst(n0 + n) + k0 + 8 * c) = o; }
    asm volatile("s_waitcnt lgkmcnt(0)" ::: "memory");
}

DI int t5_bucket(int rel) {
    const int n = rel < 0 ? -rel : rel; const int ret = rel > 0 ? 16 : 0;
    int v;
    if (n < 8) v = n; else if (n < 12) v = 8; else if (n < 16) v = 9; else if (n < 23) v = 10; else if (n < 32) v = 11; else if (n < 46) v = 12; else if (n < 64) v = 13; else if (n < 91) v = 14; else v = 15;
    return ret + v;
}

struct MoeItem { const float* src; unsigned char* dst; int ns, kd; };
DI MoeItem moe_item_of(const float* w_gate, const float* w_up, const float* w_down, unsigned char* WGU, unsigned char* WD, int it) {
    constexpr int I_GU = NEXP * 16 * 16 * 2;
    MoeItem m;
    if (it < I_GU) { const int up = it & 1, r = it >> 1, nb = r & 15, kb = (r >> 4) & 15, e = r >> 8; const int n0 = nb * 32;
        m.src = (up ? w_up : w_gate) + (size_t)e * 1024 * 512 + (size_t)(kb * 64) * 512 + n0; m.ns = 512; m.kd = 1024;
        m.dst = WGU + (size_t)e * 1024 * 1024 + (size_t)((up ? 128 : 0) + ((n0 >> 7) << 8) + (n0 & 127)) * 1024 + kb * 64;
    } else { const int r = it - I_GU, nb = r & 31, kb = (r >> 5) & 7, e = r >> 8;
        m.src = w_down + (size_t)e * 512 * 1024 + (size_t)(kb * 64) * 1024 + nb * 32; m.ns = 1024; m.kd = 512;
        m.dst = WD + (size_t)e * 1024 * 512 + (size_t)(nb * 32) * 512 + kb * 64; }
    return m;
}
DI void moe_item_load(const MoeItem& m, f32x4 (&r)[8], int lane) {
#pragma unroll
    for (int i = 0; i < 8; ++i) r[i] = __builtin_nontemporal_load((const f32x4*)(m.src + (size_t)(8 * i + (lane >> 3)) * m.ns + 4 * (lane & 7)));
}
DI void moe_item_store(const MoeItem& m, const f32x4 (&r)[8], LAS float* scr, int lane) {
#pragma unroll
    for (int i = 0; i < 8; ++i) { LAS float* p = scr + (8 * i + (lane >> 3)) * 33 + 4 * (lane & 7); p[0] = r[i][0]; p[1] = r[i][1]; p[2] = r[i][2]; p[3] = r[i][3]; }
    asm volatile("s_waitcnt lgkmcnt(0)" ::: "memory");
    const int c = lane & 3;
#pragma unroll
    for (int j = 0; j < 2; ++j) { const int n = (lane >> 2) + 16 * j; const LAS float* s = scr + (16 * c) * 33 + n;
        u32x4 o;
#pragma unroll
        for (int q = 0; q < 4; ++q) { int w = 0;
            w = __builtin_amdgcn_cvt_pk_fp8_f32(s[(4 * q) * 33] * 32.f, s[(4 * q + 1) * 33] * 32.f, w, false);
            w = __builtin_amdgcn_cvt_pk_fp8_f32(s[(4 * q + 2) * 33] * 32.f, s[(4 * q + 3) * 33] * 32.f, w, true); o[q] = (unsigned)w; }
        *(u32x4*)(m.dst + (size_t)n * m.kd + 16 * c) = o; }
    asm volatile("s_waitcnt lgkmcnt(0)" ::: "memory");
}
template <int NI>
DI void moe_convert_items(const float* w_gate, const float* w_up, const float* w_down, unsigned char* WGU, unsigned char* WD, LAS float* scr, int it0, int lane) {
    f32x4 ra[NI][8]; MoeItem ma[NI];
#pragma unroll
    for (int i = 0; i < NI; ++i) { ma[i] = moe_item_of(w_gate, w_up, w_down, WGU, WD, it0 + i); moe_item_load(ma[i], ra[i], lane); }
#pragma unroll
    for (int i = 0; i < NI; ++i) moe_item_store(ma[i], ra[i], scr, lane);
}
constexpr int MOE_CONV_ITEMS = NEXP * 16 * 16 * 2 + NEXP * 8 * 32;

struct In {
    const float *x, *w_in, *w_out, *norm_mix, *norm_ffn, *rel_bias, *lam_q1, *lam_k1, *lam_q2, *lam_k2, *diff_subln, *mla_q_norm, *mla_kv_norm, *w_uq, *w_ukv,
                *w_group, *b_group, *w_expert, *b_expert, *w_gate, *w_up, *w_down, *norm_final;
};

DI void prologue_phase(const In& I, unsigned char* ws, LAS unsigned char* lds, int gw, int NGW, int lane, int wave) {
    LAS float* scr = (LAS float*)(lds + wave * 16384);
    bf16* WinT = (bf16*)(ws + WS_WIN); bf16* WoT = (bf16*)(ws + WS_WOUT); bf16* WuqT = (bf16*)(ws + WS_WUQ); bf16* WukvT = (bf16*)(ws + WS_WUKV); bf16* WR = (bf16*)(ws + WS_WR);
    constexpr int I1 = 2 * 16 * 96, I2 = 2 * 16 * 32, I3 = 2 * 4 * 6, I4 = 2 * 2 * 12, I5 = 2 * 2 * 16 * 2;
    for (int it = gw; it < I1 + I2 + I3 + I4 + I5; it += NGW) {
        int r = it;
        if (r < I1) { const int l = r / 1536, q = r % 1536, kb = q / 96, nb = q % 96; const float* W = I.w_in + (size_t)l * 1024 * DIN; bf16* D = WinT + (size_t)l * ZP * 1024;
            tr_item(scr, kb * 64, nb * 32, lane, [=](int k, int n) { if (n >= DIN) return 0.f; float s = 1.f; if (n < 512 || (n >= Z_BQ && n < Z_BK)) s = 0.125f * LOG2E; else if (n >= Z_IW && n < Z_CQ) s = 0.0625f; return W[(size_t)k * DIN + n] * s; },
                    [=](int n) { return D + (size_t)n * 1024; }); continue; }
        r -= I1;
        if (r < I2) { const int l = r / 512, q = r % 512, kb = q / 32, nb = q % 32; const float* W = I.w_out + (size_t)l * 1024 * 1024; bf16* D = WoT + (size_t)l * 1024 * 1024;
            tr_item(scr, kb * 64, nb * 32, lane, [=](int k, int n) { return W[(size_t)k * 1024 + n]; }, [=](int n) { return D + (size_t)n * 1024; }); continue; }
        r -= I2;
        if (r < I3) { const int l = r / 24, q = r % 24, kb = q / 6, nb = q % 6; const float* W = I.w_uq + (size_t)l * 256 * 192; const float* g = I.mla_q_norm + l * 256; bf16* D = WuqT + (size_t)l * 192 * 256;
            const float qs = 0.14433756729740643f * LOG2E;
            tr_item(scr, kb * 64, nb * 32, lane, [=](int k, int n) { const int o = n < 128 ? (n >> 5) * 48 + (n & 31) : ((n - 128) >> 4) * 48 + 32 + ((n - 128) & 15); return W[(size_t)k * 192 + o] * g[k] * qs; },
                    [=](int n) { return D + (size_t)n * 256; }); continue; }
        r -= I3;
        if (r < I4) { const int l = r / 24, q = r % 24, kb = q / 12, nb = q % 12; const float* W = I.w_ukv + (size_t)l * 128 * 384; const float* g = I.mla_kv_norm + l * 128; bf16* D = WukvT + (size_t)l * 384 * 128;
            tr_item(scr, kb * 64, nb * 32, lane, [=](int k, int n) { const int o = n < 128 ? (n >> 5) * 96 + (n & 31) : ((n - 128) >> 6) * 96 + 32 + ((n - 128) & 63); return W[(size_t)k * 384 + o] * g[k]; },
                    [=](int n) { return D + (size_t)n * 128; }); continue; }
        r -= I4;
        { const int lo = r & 1, q = r >> 1, nb = q & 1, kb = (q >> 1) & 15, l = q >> 5; const float* We = I.w_expert + (size_t)l * 1024 * 32; const float* Wg = I.w_group + (size_t)l * 1024 * 4; const float* gf = I.norm_ffn + (size_t)l * DM;
          bf16* D = WR + ((size_t)(l * 2 + lo) * 64) * 1024;
          tr_item(scr, kb * 64, nb * 32, lane, [=](int k, int n) { float w = (n < 32 ? We[(size_t)k * 32 + n] : (n < 36 ? Wg[(size_t)k * 4 + (n - 32)] : 0.f)) * gf[k]; if (lo) w = w - bf2f(f2bf(w)); return w; },
                  [=](int n) { return D + (size_t)n * 1024; }); }
    }
    float* par = (float*)(ws + WS_PAR);
    const int gt = gw * 64 + lane, NGT = NGW * 64;
    for (int i = gt; i < SEQ * 8; i += NGT) { const int t = i >> 3, f = i & 7; const float inv = powf(10000.f, -(float)(2 * f) / 16.f); const float ang = (float)t * inv;
        ((float*)(ws + WS_PAR + PAR_COS))[i] = cosf(ang); ((float*)(ws + WS_PAR + PAR_SIN))[i] = sinf(ang); }
    for (int i = gt; i < 8 * 256; i += NGT) { const int hh = i >> 8, rel = (i & 255) - 192; ((float*)(ws + WS_PAR + PAR_LUT))[i] = I.rel_bias[t5_bucket(rel) * 8 + hh] * LOG2E; }
    if (gw == 2 && lane == 0) {
        unsigned* ord = (unsigned*)(ws + WS_PAR + PAR_ORD); int n = 0;
        for (int c = 32; c >= 1; --c) {
            if (c % 2 == 0 && c / 2 - 1 <= 15) for (int bh = 0; bh < 32; ++bh) ord[n++] = (0u << 16) | ((unsigned)(c / 2 - 1) << 8) | (unsigned)bh;
            if (c <= 16) for (int ty = 1; ty < 3; ++ty) for (int bh = 0; bh < 32; ++bh) ord[n++] = ((unsigned)ty << 16) | ((unsigned)(c - 1) << 8) | (unsigned)bh; }
    }
    if (gw < 2) { const int l = gw; const float a = wave_sum(I.lam_q1[l * 64 + lane] * I.lam_k1[l * 64 + lane]), b = wave_sum(I.lam_q2[l * 64 + lane] * I.lam_k2[l * 64 + lane]);
        const float li = 0.8f - 0.6f * expf(-0.3f * (float)l); if (lane == 0) { par[l] = expf(a) - expf(b) + li; par[2 + l] = 1.f - li; } }
}

template <int MODE>
DI void norm_phase(const float* src, bf16* XA, float* OUT, bf16* XN, const float* gain, const unsigned char* Y  , const int* rt_d, const float* rt_g, int gw, int NGW, int lane) {
    f32x4 g4[4];
#pragma unroll
    for (int j = 0; j < 4; ++j) g4[j] = *(const f32x4*)(gain + 4 * lane + 256 * j);
    for (int m = gw; m < M; m += NGW) {
        f32x4 v[4];
        if (MODE == 0) {
#pragma unroll
            for (int j = 0; j < 4; ++j) v[j] = *(const f32x4*)(src + (size_t)m * DM + 4 * lane + 256 * j);
        } else {
#pragma unroll
            for (int j = 0; j < 4; ++j) { const u32x2 w = *(const u32x2*)(XA + (size_t)m * DM + 4 * lane + 256 * j);
                v[j] = (f32x4){__uint_as_float(w.x << 16), __uint_as_float(w.x & 0xffff0000u), __uint_as_float(w.y << 16), __uint_as_float(w.y & 0xffff0000u)}; }
        }
        if (MODE != 0) {
            const int d0 = rt_d[2 * m], d1 = rt_d[2 * m + 1]; const float w0 = rt_g[2 * m] * 0.0625f, w1 = rt_g[2 * m + 1] * 0.0625f;
            const unsigned char* y0 = Y + (size_t)d0 * DM, * y1 = Y + (size_t)d1 * DM;
#pragma unroll
            for (int j = 0; j < 4; ++j) { const int a = *(const int*)(y0 + 4 * lane + 256 * j), b = *(const int*)(y1 + 4 * lane + 256 * j);
                const f32x2 a01 = __builtin_amdgcn_cvt_pk_f32_fp8(a, false), a23 = __builtin_amdgcn_cvt_pk_f32_fp8(a, true), b01 = __builtin_amdgcn_cvt_pk_f32_fp8(b, false), b23 = __builtin_amdgcn_cvt_pk_f32_fp8(b, true);
                v[j][0] += w0 * a01[0] + w1 * b01[0]; v[j][1] += w0 * a01[1] + w1 * b01[1]; v[j][2] += w0 * a23[0] + w1 * b23[0]; v[j][3] += w0 * a23[1] + w1 * b23[1]; }
        }
        float ss = 0.f;
#pragma unroll
        for (int j = 0; j < 4; ++j) ss += (v[j][0] * v[j][0] + v[j][1] * v[j][1]) + (v[j][2] * v[j][2] + v[j][3] * v[j][3]);
        const float rstd = rsqrtf(wave_sum(ss) * (1.f / DM) + EPS);
        if (MODE == 1) {
#pragma unroll
            for (int j = 0; j < 4; ++j) { u32x2 w; w.x = cvtpk(v[j][0], v[j][1]); w.y = cvtpk(v[j][2], v[j][3]); *(u32x2*)(XA + (size_t)m * DM + 4 * lane + 256 * j) = w; }
        }
        if (MODE == 2) {
#pragma unroll
            for (int j = 0; j < 4; ++j) *(f32x4*)(OUT + (size_t)m * DM + 4 * lane + 256 * j) = v[j] * rstd * g4[j];
        } else {
#pragma unroll
            for (int j = 0; j < 4; ++j) { const f32x4 o = v[j] * rstd * g4[j]; u32x2 w; w.x = cvtpk(o[0], o[1]); w.y = cvtpk(o[2], o[3]); *(u32x2*)(XN + (size_t)m * DM + 4 * lane + 256 * j) = w; }
        }
    }
}

DI void st4(bf16* p, float a, float b, float c, float d) { u32x2 w; w.x = cvtpk(a, b); w.y = cvtpk(c, d); *(u32x2*)p = w; }
DI void mla_prep_unit(const bf16* Z, const bf16* WuqT, const bf16* WukvT, const float* cosT, const float* sinT, bf16* MLA, int unit, int lane) {
    const int slice = unit >> 1, part = unit & 1, r32 = lane & 31, hi = lane >> 5;
    const int row = slice * 32 + r32, t = row & (SEQ - 1);
    const bf16* zr = Z + (size_t)row * ZP; bf16* orow = MLA + (size_t)row * MLAP;
    const f32x4 cs = *(const f32x4*)(cosT + t * 8 + 4 * hi), sn = *(const f32x4*)(sinT + t * 8 + 4 * hi);
    const u32x4 zero4 = {0u, 0u, 0u, 0u};
    if (part == 0) {
        bf16x8 bq[16]; float ss = 0.f;
#pragma unroll
        for (int s = 0; s < 16; ++s) { bq[s] = *(const bf16x8*)(zr + Z_CQ + 16 * s + 8 * hi);
#pragma unroll
            for (int j = 0; j < 8; ++j) { const float f = bf2f((bf16)bq[s][j]); ss += f * f; } }
        const float rstd = rsqrtf(halfswap_sum(ss) * (1.f / 256.f) + EPS);
        auto epi_q = [&](const int nb, const f32x16& acc) __attribute__((always_inline)) {
            if (nb < 4) {
#pragma unroll
                for (int g = 0; g < 4; ++g) st4(orow + nb * 64 + 8 * g + 4 * hi, acc[4 * g] * rstd, acc[4 * g + 1] * rstd, acc[4 * g + 2] * rstd, acc[4 * g + 3] * rstd);
            } else {
#pragma unroll
                for (int hb = 0; hb < 2; ++hb) { const int head = 2 * (nb - 4) + hb; float o1[4], o2[4];
#pragma unroll
                    for (int j = 0; j < 4; ++j) { const float x1 = acc[8 * hb + j] * rstd, x2 = acc[8 * hb + 4 + j] * rstd; o1[j] = x1 * cs[j] - x2 * sn[j]; o2[j] = x1 * sn[j] + x2 * cs[j]; }
                    st4(orow + head * 64 + 32 + 4 * hi, o1[0], o1[1], o1[2], o1[3]); st4(orow + head * 64 + 40 + 4 * hi, o2[0], o2[1], o2[2], o2[3]);
                    *(u32x4*)(orow + head * 64 + 48 + 8 * hi) = zero4; }
            }
        };
        bf16x8 wA[16], wB[16];
#define MLA_WLOAD(W, nbx) do { const bf16* wp_ = WuqT + (size_t)((nbx) * 32 + r32) * 256 + 8 * hi; _Pragma("unroll") for (int s = 0; s < 16; ++s) W[s] = *(const bf16x8*)(wp_ + 16 * s); } while (0)
        MLA_WLOAD(wA, 0);
#pragma unroll 1
        for (int nb = 0; nb < 6; nb += 2) {
            MLA_WLOAD(wB, nb + 1);
            { f32x16 acc = {};
#pragma unroll
              for (int s = 0; s < 16; ++s) acc = MFMA32(wA[s], bq[s], acc);
              epi_q(nb, acc); }
            MLA_WLOAD(wA, nb + 2 < 6 ? nb + 2 : 5);
            { f32x16 acc = {};
#pragma unroll
              for (int s = 0; s < 16; ++s) acc = MFMA32(wB[s], bq[s], acc);
              epi_q(nb + 1, acc); }
        }
#undef MLA_WLOAD
    } else {
        bf16x8 bk[8]; float ss = 0.f;
#pragma unroll
        for (int s = 0; s < 8; ++s) { bk[s] = *(const bf16x8*)(zr + Z_CKV + 16 * s + 8 * hi);
#pragma unroll
            for (int j = 0; j < 8; ++j) { const float f = bf2f((bf16)bk[s][j]); ss += f * f; } }
        const float rstd = rsqrtf(halfswap_sum(ss) * (1.f / 128.f) + EPS);
        auto epi_kv = [&](const int nb, const f32x16& acc) __attribute__((always_inline)) {
            bf16* o = nb < 4 ? orow + 256 + nb * 64 : orow + 512 + ((nb - 4) >> 1) * 64 + ((nb - 4) & 1) * 32;
#pragma unroll
            for (int g = 0; g < 4; ++g) st4(o + 8 * g + 4 * hi, acc[4 * g] * rstd, acc[4 * g + 1] * rstd, acc[4 * g + 2] * rstd, acc[4 * g + 3] * rstd);
        };
        bf16x8 wA[8], wB[8];
#define MLA_WLOAD(W, nbx) do { const bf16* wp_ = WukvT + (size_t)((nbx) * 32 + r32) * 128 + 8 * hi; _Pragma("unroll") for (int s = 0; s < 8; ++s) W[s] = *(const bf16x8*)(wp_ + 16 * s); } while (0)
        MLA_WLOAD(wA, 0);
#pragma unroll 1
        for (int nb = 0; nb < 12; nb += 2) {
            MLA_WLOAD(wB, nb + 1);
            { f32x16 acc = {};
#pragma unroll
              for (int s = 0; s < 8; ++s) acc = MFMA32(wA[s], bk[s], acc);
              epi_kv(nb, acc); }
            MLA_WLOAD(wA, nb + 2 < 12 ? nb + 2 : 11);
            { f32x16 acc = {};
#pragma unroll
              for (int s = 0; s < 8; ++s) acc = MFMA32(wB[s], bk[s], acc);
              epi_kv(nb + 1, acc); }
        }
#undef MLA_WLOAD
        const u32x2 a = *(const u32x2*)(zr + Z_CKR + 4 * hi), b = *(const u32x2*)(zr + Z_CKR + 8 + 4 * hi);
        const float x1[4] = {__uint_as_float(a.x << 16), __uint_as_float(a.x & 0xffff0000u), __uint_as_float(a.y << 16), __uint_as_float(a.y & 0xffff0000u)};
        const float x2[4] = {__uint_as_float(b.x << 16), __uint_as_float(b.x & 0xffff0000u), __uint_as_float(b.y << 16), __uint_as_float(b.y & 0xffff0000u)};
        float o1[4], o2[4];
#pragma unroll
        for (int j = 0; j < 4; ++j) { o1[j] = x1[j] * cs[j] - x2[j] * sn[j]; o2[j] = x1[j] * sn[j] + x2[j] * cs[j]; }
#pragma unroll
        for (int h = 0; h < 4; ++h) { st4(orow + 256 + h * 64 + 32 + 4 * hi, o1[0], o1[1], o1[2], o1[3]); st4(orow + 256 + h * 64 + 40 + 4 * hi, o2[0], o2[1], o2[2], o2[3]);
            *(u32x4*)(orow + 256 + h * 64 + 48 + 8 * hi) = zero4; }
    }
}

DI int wave_sum_i(int v) {
    v += __builtin_amdgcn_update_dpp(0, v, 0x111, 0xf, 0xf, false); v += __builtin_amdgcn_update_dpp(0, v, 0x112, 0xf, 0xf, false);
    v += __builtin_amdgcn_update_dpp(0, v, 0x114, 0xf, 0xf, false); v += __builtin_amdgcn_update_dpp(0, v, 0x118, 0xf, 0xf, false);
    return __builtin_amdgcn_readlane(v, 15) + __builtin_amdgcn_readlane(v, 31) + __builtin_amdgcn_readlane(v, 47) + __builtin_amdgcn_readlane(v, 63);
}
DI float wave_max_f(float f) {
    const int ninf = (int)0xff800000u; int v = __float_as_int(f);
#define WMX(ctrl) v = __float_as_int(fmaxf(__int_as_float(v), __int_as_float(__builtin_amdgcn_update_dpp(ninf, v, ctrl, 0xf, 0xf, false))))
    WMX(0x111); WMX(0x112); WMX(0x114); WMX(0x118);
#undef WMX
    return fmaxf(fmaxf(__int_as_float(__builtin_amdgcn_readlane(v, 15)), __int_as_float(__builtin_amdgcn_readlane(v, 31))), fmaxf(__int_as_float(__builtin_amdgcn_readlane(v, 47)), __int_as_float(__builtin_amdgcn_readlane(v, 63))));
}
DI float relu_i(float x) { const int i = __float_as_int(x); return __int_as_float(i > 0 ? i : 0); }
DI unsigned fkey(float f) { const unsigned u = __float_as_uint(f); return (u & 0x80000000u) ? ~u : (u | 0x80000000u); }

struct DsaOps { bf16x8 af[2][2]; bf16x8 w8[2][2]; bf16x8 cb[2][2]; };
DI void dsa_load_ops(const bf16* Z, const bf16* KIDX, int item, int wave, int lane, DsaOps& o) {
    const int r32 = lane & 31, hi = lane >> 5;
    const int c = 63 - (item >> 6), rem = item & 63, b = rem >> 3, sg = rem & 7;
    const int n = 64 * (c + 1), t0 = 64 * c + 8 * sg; const size_t rowbase = (size_t)b * SEQ;
    const int ql = ((r32 >> 4) & 1) * 2 + ((r32 >> 2) & 1), hh = ((r32 >> 3) & 1) * 4 + (r32 & 3);
#pragma unroll
    for (int rb = 0; rb < 2; ++rb) {
#pragma unroll
        for (int s = 0; s < 2; ++s) o.af[rb][s] = *(const bf16x8*)(Z + (rowbase + t0 + 4 * rb + ql) * ZP + Z_IQ + hh * 32 + 16 * s + 8 * hi);
#pragma unroll
        for (int q2 = 0; q2 < 2; ++q2) o.w8[rb][q2] = *(const bf16x8*)(Z + (rowbase + t0 + 4 * rb + 2 * q2 + hi) * ZP + Z_IW);
    }
    const int nkb = n >> 5;
    const bf16* kp0 = KIDX + (rowbase + r32) * 32 + 8 * hi;
#pragma unroll
    for (int u = 0; u < 2; ++u) { const int k2 = wave + 8 * u; const int kk = k2 < nkb ? k2 : wave; const bf16* kp = kp0 + (size_t)(32 * kk) * 32; o.cb[u][0] = *(const bf16x8*)kp; o.cb[u][1] = *(const bf16x8*)(kp + 16); }
}
DI void dsa_select_item(const bf16* Z, const bf16* KIDX, unsigned long long* MASK, LAS unsigned char* lds, const DsaOps& ops, int item, int tid) {
    const int lane = tid & 63, wave = __builtin_amdgcn_readfirstlane(tid >> 6), r32 = lane & 31, hi = lane >> 5;
    const int c = 63 - (item >> 6), rem = item & 63, b = rem >> 3, sg = rem & 7;
    const int n = 64 * (c + 1), t0 = 64 * c + 8 * sg; const size_t rowbase = (size_t)b * SEQ;
    LAS float* sc = (LAS float*)lds;
    bf16x8 af[2][2]; float wv[2][16];
#pragma unroll
    for (int rb = 0; rb < 2; ++rb) {
#pragma unroll
        for (int s = 0; s < 2; ++s) af[rb][s] = ops.af[rb][s];
#pragma unroll
        for (int q2 = 0; q2 < 2; ++q2) {
#pragma unroll
            for (int j = 0; j < 8; ++j) wv[rb][8 * q2 + j] = bf2f((bf16)ops.w8[rb][q2][j]); }
    }
    {
        const int nkb = n >> 5;
        const bf16* kp0 = KIDX + (rowbase + r32) * 32 + 8 * hi;
        bf16x8 cb[2][2], nb[2][2];
#pragma unroll
        for (int u = 0; u < 2; ++u) { cb[u][0] = ops.cb[u][0]; cb[u][1] = ops.cb[u][1]; }
        for (int kb = wave; kb < nkb; kb += 2 * NWAVES) {
#pragma unroll
            for (int u = 0; u < 2; ++u) { const int k2 = kb + 16 + 8 * u; const int kk = k2 < nkb ? k2 : wave; const bf16* kp = kp0 + (size_t)(32 * kk) * 32; nb[u][0] = *(const bf16x8*)kp; nb[u][1] = *(const bf16x8*)(kp + 16); }
#pragma unroll
            for (int u = 0; u < 2; ++u) if (kb + 8 * u < nkb) {
                const int key = 32 * (kb + 8 * u) + r32;
#pragma unroll
                for (int rb = 0; rb < 2; ++rb) {
                    f32x16 acc = {};
                    acc = MFMA32(af[rb][0], cb[u][0], acc); acc = MFMA32(af[rb][1], cb[u][1], acc);
                    float s0 = 0.f, s1 = 0.f;
#pragma unroll
                    for (int r = 0; r < 8; ++r) { s0 = fmaf(wv[rb][r], relu_i(acc[r]), s0); s1 = fmaf(wv[rb][8 + r], relu_i(acc[8 + r]), s1); }
                    sc[(4 * rb + hi) * n + key] = s0; sc[(4 * rb + 2 + hi) * n + key] = s1;
                }
            }
#pragma unroll
            for (int u = 0; u < 2; ++u) { cb[u][0] = nb[u][0]; cb[u][1] = nb[u][1]; }
        }
    }
    __syncthreads();
    {
        const int nreg = c + 1, ngrp = (nreg + 7) >> 3;
        float v[64];
#pragma unroll
        for (int g = 0; g < 8; ++g) {
#pragma unroll
            for (int jj = 0; jj < 8; ++jj) v[8 * g + jj] = -INFINITY;
            if (g < ngrp) {
#pragma unroll
                for (int jj = 0; jj < 8; ++jj) { const int j = 8 * g + jj; if (j < nreg) v[j] = sc[wave * n + 64 * j + lane]; } } }
        float mxl = v[0], mnl = fminf(fminf(v[0], v[1]), fminf(v[2], v[3]));
#pragma unroll
        for (int g = 0; g < 8; ++g) if (g < ngrp) {
#pragma unroll
            for (int jj = 0; jj < 8; ++jj) mxl = fmaxf(mxl, v[8 * g + jj]);
            if (8 * g + 8 <= nreg) {
#pragma unroll
                for (int jj = 0; jj < 8; ++jj) mnl = fminf(mnl, v[8 * g + jj]); } }
        const float mx = wave_max_f(mxl), mn = -wave_max_f(-mnl);
        unsigned T = 0u; bool haveT = false; int c_hi = 0, neq = -1;
        if (mx > mn) {
            const float scale = 126.5f / (mx - mn);
            unsigned w[16];
#pragma unroll
            for (int q = 0; q < 16; ++q) { unsigned x = 0x80808080u;
                if (q < 2 * ngrp) {
#pragma unroll
                    for (int k = 0; k < 4; ++k) { const unsigned cc = (unsigned)((v[4 * q + k] - mn) * scale); x |= cc << (8 * k); } }
                w[q] = x; }
            unsigned p = 0u;
#pragma unroll
            for (int bit = 6; bit >= 0; --bit) { const unsigned cand = p | (1u << bit), rep = cand * 0x01010101u; int cl = 0;
#pragma unroll
                for (int g = 0; g < 8; ++g) if (g < ngrp) { cl += __builtin_popcount((w[2 * g] - rep) & 0x80808080u); cl += __builtin_popcount((w[2 * g + 1] - rep) & 0x80808080u); }
                const int cnt = wave_sum_i(cl);
                if (cnt >= 256) p = cand; else c_hi = cnt; }
            LAS unsigned* cand_l = (LAS unsigned*)(lds + AUX_OFF + wave * 512);
            int off = 0;
#pragma unroll
            for (int g = 0; g < 8; ++g) if (g < ngrp) {
#pragma unroll
                for (int jj = 0; jj < 8; ++jj) { const int j = 8 * g + jj; const bool isc = ((w[j >> 2] >> (8 * (j & 3))) & 0xffu) == (p | 0x80u); const unsigned long long bal = __builtin_amdgcn_ballot_w64(isc);
                    if (bal) { const int pos = off + (int)__builtin_amdgcn_mbcnt_hi((unsigned)(bal >> 32), __builtin_amdgcn_mbcnt_lo((unsigned)bal, 0u));
                        if (isc && pos < 128) cand_l[pos] = fkey(v[j]);
                        off += __builtin_popcountll(bal); } } }
            const int need = 256 - c_hi;
            if (off <= 128) {
                const unsigned ck0 = lane < off ? cand_l[lane] : 0u, ck1 = lane + 64 < off ? cand_l[lane + 64] : 0u;
                unsigned prefix = 0u;
                for (int bit = 31; bit >= 0; --bit) { const unsigned cd = prefix | (1u << bit);
                    const int cnt = __builtin_popcountll(__builtin_amdgcn_ballot_w64(ck0 >= cd)) + __builtin_popcountll(__builtin_amdgcn_ballot_w64(ck1 >= cd));
                    if (cnt >= need) prefix = cd; }
                T = prefix; haveT = true;
                c_hi += __builtin_popcountll(__builtin_amdgcn_ballot_w64(ck0 > T)) + __builtin_popcountll(__builtin_amdgcn_ballot_w64(ck1 > T));
                neq = __builtin_popcountll(__builtin_amdgcn_ballot_w64(ck0 == T)) + __builtin_popcountll(__builtin_amdgcn_ballot_w64(ck1 == T));
            }
        }
        if (!haveT) {
            unsigned prefix = 0u;
            for (int bit = 31; bit >= 0; --bit) { const unsigned cd = prefix | (1u << bit); int cnt = 0;
#pragma unroll
                for (int g = 0; g < 8; ++g) if (g < ngrp) {
#pragma unroll
                    for (int jj = 0; jj < 8; ++jj) cnt += __builtin_popcountll(__builtin_amdgcn_ballot_w64(fkey(v[8 * g + jj]) >= cd)); }
                if (cnt >= 256) prefix = cd; }
            T = prefix; c_hi = 0;
#pragma unroll
            for (int g = 0; g < 8; ++g) if (g < ngrp) {
#pragma unroll
                for (int jj = 0; jj < 8; ++jj) c_hi += __builtin_popcountll(__builtin_amdgcn_ballot_w64(fkey(v[8 * g + jj]) > T)); }
        }
        int remn = 256 - c_hi; unsigned mlo = 0u, mhi = 0u;
        if (neq == remn) {
            const float Tf = __uint_as_float((T & 0x80000000u) ? (T & 0x7fffffffu) : ~T);
#pragma unroll
            for (int g = 0; g < 8; ++g) if (g < ngrp) {
#pragma unroll
                for (int jj = 0; jj < 8; ++jj) { const int j = 8 * g + jj; const unsigned long long ww = __builtin_amdgcn_ballot_w64(v[j] >= Tf); const unsigned wl = (unsigned)ww, wh2 = (unsigned)(ww >> 32);
                    asm volatile("s_nop 4\n\tv_writelane_b32 %0, %1, %2" : "+v"(mlo) : "s"(wl), "n"(j));
                    asm volatile("v_writelane_b32 %0, %1, %2" : "+v"(mhi) : "s"(wh2), "n"(j)); } }
        } else {
#pragma unroll
            for (int g = 0; g < 8; ++g) if (g < ngrp) {
#pragma unroll
                for (int jj = 0; jj < 8; ++jj) { const int j = 8 * g + jj;
                    const unsigned kj = fkey(v[j]);
                    const unsigned long long gt = __builtin_amdgcn_ballot_w64(kj > T); unsigned long long eq = __builtin_amdgcn_ballot_w64(kj == T);
                    if (eq) { const int ne = __builtin_popcountll(eq);
                        if (ne > remn) { unsigned long long tk = 0ull; for (int i = 0; i < remn; ++i) { const unsigned long long lb = eq & (0ull - eq); tk |= lb; eq ^= lb; } eq = tk; remn = 0; }
                        else remn -= ne; }
                    const unsigned long long ww = gt | eq; const unsigned wl = (unsigned)ww, wh2 = (unsigned)(ww >> 32);
                    asm volatile("s_nop 4\n\tv_writelane_b32 %0, %1, %2" : "+v"(mlo) : "s"(wl), "n"(j));
                    asm volatile("v_writelane_b32 %0, %1, %2" : "+v"(mhi) : "s"(wh2), "n"(j)); } }
        }
        if (lane < nreg) MASK[(rowbase + t0 + wave) * 64 + lane] = ((unsigned long long)mhi << 32) | mlo;
    }
    __syncthreads();
}

DI s16x4 vtr(const LAS unsigned char* p) { return __builtin_bit_cast(s16x4, __builtin_amdgcn_ds_read_tr16_b64_v4i16((LAS v4i16_t*)p)); }

template <int DV, bool BIAS, bool MASK, int KS = 4  >
DI void attn_pass(LAS unsigned char* lds, const bf16* Q, const bf16* K, const bf16* V, int pq, int pk, int pv, int q0, int nt, const unsigned long long* maskb, float cfar, f32x16 (&oT)[DV / 32], int tid) {
    constexpr int ND = DV / 32, NV = DV / 64;
    asm volatile("" : "+v"(tid));
    const int lane = tid & 63, wave = __builtin_amdgcn_readfirstlane(tid >> 6), r32 = lane & 31, hi = lane >> 5;
    const int qw0 = q0 + 32 * wave, mylimit = (qw0 >> 6) + 1;
    const LAS float* lut = (const LAS float*)(lds + AUX_OFF);
    float m_ref = -64.f;
    constexpr bool LMF = (DV == 64);
    f32x16 lacc = {}; float l_run = 0.f;
    const short one_hi0 = hi == 0 ? (short)0x3F80 : (short)0;
    const bf16x8 kx = {one_hi0, one_hi0, one_hi0, 0, 0, 0, 0, 0};
    bf16x8 qx;
#define SET_QX() do { const float c_ = cfar - m_ref; const unsigned b1_ = cvtpk(c_, 0.f) & 0xffffu; const float r1_ = c_ - __uint_as_float(b1_ << 16); const unsigned b2_ = cvtpk(r1_, 0.f) & 0xffffu; \
        const float r2_ = r1_ - __uint_as_float(b2_ << 16); const unsigned b3_ = cvtpk(r2_, 0.f) & 0xffffu; \
        qx = (bf16x8){(short)(hi == 0 ? b1_ : 0u), (short)(hi == 0 ? b2_ : 0u), (short)(hi == 0 ? b3_ : 0u), 0, 0, 0, 0, 0}; } while (0)
    SET_QX();
    const bf16x8 ones = {0x3F80, 0x3F80, 0x3F80, 0x3F80, 0x3F80, 0x3F80, 0x3F80, 0x3F80};
#pragma unroll
    for (int d = 0; d < ND; ++d) oT[d] = (f32x16){};
    bf16x8 qf[4];
#pragma unroll
    for (int d0 = 0; d0 < 4; ++d0) qf[d0] = *(const bf16x8*)(Q + (size_t)(qw0 + r32) * pq + 16 * d0 + 8 * hi);
    LAS bf16x8* qpark = (LAS bf16x8*)(lds + 49152 + wave * 4096) + lane;
    if constexpr (ND == 4) {
#pragma unroll
        for (int d0 = 0; d0 < 4; ++d0) qpark[d0 * 64] = qf[d0];
    }
    const bf16* ksrc = K + (size_t)lane * pk + wave * 8;
    const bf16* vsrc[NV];
#pragma unroll
    for (int i = 0; i < NV; ++i) { const int p = wave + 8 * i, dh = p >> 2, rg = p & 3; vsrc[i] = V + (size_t)(rg * 16 + (lane >> 2)) * pv + dh * 32 + (lane & 3) * 8; }
    LAS unsigned char* kdst = lds + wave * 1024 + lane * 16;
    LAS unsigned char* vdst = lds + 16384 + wave * 1024 + lane * 16;
    const LAS unsigned char* kfr = lds + hi * 1024 + r32 * 16;
    const LAS unsigned char* vfr = lds + 16384 + ((lane >> 4) & 1) * 32 + (lane & 3) * 8 + (4 * hi + ((lane & 15) >> 2)) * 64;
    u32x4 kA, vA[NV], kB, vB[NV];
#define AT_LOAD(t, KR, VR) do { KR = *(const u32x4*)(ksrc + (size_t)(t) * 64 * pk); _Pragma("unroll") for (int i = 0; i < NV; ++i) VR[i] = *(const u32x4*)(vsrc[i] + (size_t)(t) * 64 * pv); } while (0)
#define AT_STORE(buf, KR, VR) do { *(LAS u32x4*)(kdst + (buf) * 8192) = KR; _Pragma("unroll") for (int i = 0; i < NV; ++i) *(LAS u32x4*)(vdst + (buf) * 16384 + i * 8192) = VR[i]; } while (0)
    AT_LOAD(0, kA, vA); AT_LOAD(1, kB, vB);
    AT_STORE(0, kA, vA);
    __syncthreads();
#define SB() __builtin_amdgcn_sched_barrier(0)
#define VFRAG(SET, d) do { _Pragma("unroll") for (int ks = 0; ks < 4; ++ks) { SET[2 * ks] = vtr(vb + (d) * 4096 + ks * 1024); SET[2 * ks + 1] = vtr(vb + (d) * 4096 + ks * 1024 + 512); } } while (0)
#define VMMA(SET, d) do { _Pragma("unroll") for (int ks = 0; ks < 4; ++ks) { const bf16x8 vf = {SET[2 * ks][0], SET[2 * ks][1], SET[2 * ks][2], SET[2 * ks][3], SET[2 * ks + 1][0], SET[2 * ks + 1][1], SET[2 * ks + 1][2], SET[2 * ks + 1][3]}; \
        oT[d] = MFMA32(vf, __builtin_bit_cast(bf16x8, pw[ks]), oT[d]); } } while (0)
    auto compute = [&](const int kt, const int cur) __attribute__((always_inline)) {
        if (kt < mylimit) {
            unsigned long long mw = 0ull;
            if (MASK) mw = maskb[(size_t)(qw0 + r32) * 64 + kt];
            const int relb = kt * 64 - qw0;
            const bool nearb = BIAS && (relb + 63 > -91);
            f32x16 p0, p1;
            const LAS unsigned char* kb = kfr + cur * 8192;
            const LAS unsigned char* vb = vfr + cur * 16384;
            if constexpr (ND == 2) {
                bf16x8 kf[8];
#pragma unroll
                for (int d0 = 0; d0 < KS; ++d0) { kf[2 * d0] = *(const LAS bf16x8*)(kb + d0 * 2048); kf[2 * d0 + 1] = *(const LAS bf16x8*)(kb + d0 * 2048 + 512); }
                SB();
                p0 = MFMA32(kx, qx, (f32x16){}); p1 = MFMA32(kx, qx, (f32x16){});
#pragma unroll
                for (int d0 = 0; d0 < KS; ++d0) { p0 = MFMA32(kf[2 * d0], qf[d0], p0); p1 = MFMA32(kf[2 * d0 + 1], qf[d0], p1); }
            } else {
                bf16x8 kf[4], qh[2];
#pragma unroll
                for (int d0 = 0; d0 < 2; ++d0) { kf[2 * d0] = *(const LAS bf16x8*)(kb + d0 * 2048); kf[2 * d0 + 1] = *(const LAS bf16x8*)(kb + d0 * 2048 + 512); qh[d0] = qpark[d0 * 64]; }
                SB();
                p0 = MFMA32(kx, qx, (f32x16){}); p1 = MFMA32(kx, qx, (f32x16){});
                p0 = MFMA32(kf[0], qh[0], p0); p1 = MFMA32(kf[1], qh[0], p1); p0 = MFMA32(kf[2], qh[1], p0); p1 = MFMA32(kf[3], qh[1], p1);
                SB();
#pragma unroll
                for (int d0 = 0; d0 < 2; ++d0) { kf[2 * d0] = *(const LAS bf16x8*)(kb + (d0 + 2) * 2048); kf[2 * d0 + 1] = *(const LAS bf16x8*)(kb + (d0 + 2) * 2048 + 512); qh[d0] = qpark[(d0 + 2) * 64]; }
                SB();
                p0 = MFMA32(kf[0], qh[0], p0); p1 = MFMA32(kf[1], qh[0], p1); p0 = MFMA32(kf[2], qh[1], p0); p1 = MFMA32(kf[3], qh[1], p1);
            }
            SB();
            s16x4 vs0[8], vs1[8];
            VFRAG(vs0, 0); if constexpr (ND == 2) VFRAG(vs1, 1);
            SB();
            if (BIAS) { if (nearb) { const LAS float* lb = lut + (relb + 192 - r32 + 4 * hi);
#pragma unroll
                for (int r = 0; r < 16; ++r) { const int cc = (r & 3) + 8 * (r >> 2); p0[r] += lb[cc]; p1[r] += lb[cc + 32]; } } }
#pragma unroll
            for (int r = 0; r < 16; ++r) { p0[r] = __builtin_amdgcn_exp2f(p0[r]); p1[r] = __builtin_amdgcn_exp2f(p1[r]); }
            if (MASK) { const unsigned mlo = (unsigned)mw >> (4 * hi), mhi = (unsigned)(mw >> 32) >> (4 * hi);
#pragma unroll
                for (int r = 0; r < 16; ++r) { const int cc = (r & 3) + 8 * (r >> 2);
                    p0[r] = __int_as_float(__float_as_int(p0[r]) & ((int)(mlo << (31 - cc)) >> 31)); p1[r] = __int_as_float(__float_as_int(p1[r]) & ((int)(mhi << (31 - cc)) >> 31)); } }
            float em = fmaxf(p0[0], p1[0]);
#pragma unroll
            for (int r = 1; r < 16; ++r) em = fmaxf(em, fmaxf(p0[r], p1[r]));
            em = halfswap_max(em);
            if (__any(em > 256.f)) {
                const float dl = fmaxf(__builtin_amdgcn_logf(em), 0.f), alpha = __builtin_amdgcn_exp2f(-dl); m_ref += dl; SET_QX();
#pragma unroll
                for (int r = 0; r < 16; ++r) { p0[r] *= alpha; p1[r] *= alpha; if (LMF) lacc[r] *= alpha; }
                l_run *= alpha;
#pragma unroll
                for (int d = 0; d < ND; ++d)
#pragma unroll
                    for (int r = 0; r < 16; ++r) oT[d][r] *= alpha; }
            if (!LMF) {
#pragma unroll
                for (int r = 0; r < 16; ++r) l_run += p0[r] + p1[r]; }
            u32x4 pw[4];
#pragma unroll
            for (int s = 0; s < 2; ++s) { pw[s] = (u32x4){cvtpk(p0[8 * s], p0[8 * s + 1]), cvtpk(p0[8 * s + 2], p0[8 * s + 3]), cvtpk(p0[8 * s + 4], p0[8 * s + 5]), cvtpk(p0[8 * s + 6], p0[8 * s + 7])};
                pw[2 + s] = (u32x4){cvtpk(p1[8 * s], p1[8 * s + 1]), cvtpk(p1[8 * s + 2], p1[8 * s + 3]), cvtpk(p1[8 * s + 4], p1[8 * s + 5]), cvtpk(p1[8 * s + 6], p1[8 * s + 7])}; }
            SB();
            if constexpr (ND == 2) {
                VMMA(vs0, 0); VMMA(vs1, 1);
#pragma unroll
                for (int ks = 0; ks < 4; ++ks) if (LMF) lacc = MFMA32(ones, __builtin_bit_cast(bf16x8, pw[ks]), lacc);
            } else {
                VFRAG(vs1, 1); SB();
                VMMA(vs0, 0); SB();
                VFRAG(vs0, 2); SB();
                VMMA(vs1, 1); SB();
                VFRAG(vs1, 3); SB();
                VMMA(vs0, 2); SB();
                VMMA(vs1, 3);
            }
            SB();
        }
    };
    for (int kt = 0; kt < nt; kt += 2) {
        { const int t2 = kt + 2 < nt ? kt + 2 : nt - 1; AT_LOAD(t2, kA, vA); }
        compute(kt, 0);
        AT_STORE(1, kB, vB);
        __syncthreads();
        { const int t3 = kt + 3 < nt ? kt + 3 : nt - 1; AT_LOAD(t3, kB, vB); }
        compute(kt + 1, 1);
        AT_STORE(0, kA, vA);
        __syncthreads();
    }
#undef SET_QX
#undef AT_LOAD
#undef AT_STORE
#undef SB
#undef VFRAG
#undef VMMA
    const float inv = 1.f / (LMF ? lacc[0] : halfswap_sum(l_run));
#pragma unroll
    for (int d = 0; d < ND; ++d)
#pragma unroll
        for (int r = 0; r < 16; ++r) oT[d][r] *= inv;
}

#define H64_SBAR() __builtin_amdgcn_sched_barrier(0)
DI void glds16s(const void* base, unsigned voff, unsigned lds_base) {
    unsigned sv; asm volatile("s_mov_b32 %0, m0\n\ts_mov_b32 m0, %3\n\ts_nop 0\n\tglobal_load_lds_dwordx4 %1, %2\n\ts_mov_b32 m0, %0" : "=&s"(sv) : "v"(voff), "s"(base), "s"(lds_base) : "memory"); }
DI void glds4s(const void* base, unsigned voff, unsigned lds_base) {
    unsigned sv; asm volatile("s_mov_b32 %0, m0\n\ts_mov_b32 m0, %3\n\ts_nop 0\n\tglobal_load_lds_dword %1, %2\n\ts_mov_b32 m0, %0" : "=&s"(sv) : "v"(voff), "s"(base), "s"(lds_base) : "memory"); }
DI void gld64s(unsigned long long& dst, const void* base, unsigned voff) { asm volatile("global_load_dwordx2 %0, %1, %2" : "=&v"(dst) : "v"(voff), "s"(base) : "memory"); }
#define H64_PIN(x) asm volatile("" : "+v"(x))
template <bool BIAS, bool MASK, int KS>
DI void attn_pass_h64(LAS unsigned char* lds, const bf16* Q, const bf16* K, const bf16* V, int pq, int pk, int pv, int q0, int nt, const unsigned long long* maskb, float cfar, f32x16 (&oT)[2], int tid, const LAS float* lut) {
    asm volatile("" : "+v"(tid));
    const int lane = tid & 63, wave = __builtin_amdgcn_readfirstlane(tid >> 6), r32 = lane & 31, hi = lane >> 5;
    const int qw0 = q0 + 32 * wave, mylimit = (qw0 >> 6) + 1, NT = nt;
    constexpr int SLOTB = 8192, LDS_V = 3 * SLOTB;
    const unsigned koff = (unsigned)(lane * pk + wave * 8) * 2u, voff = (unsigned)((16 * (wave & 3) + (lane >> 2)) * pv + (wave >> 2) * 32 + (lane & 3) * 8) * 2u;
    const unsigned kdst_u = (unsigned)(unsigned long)(lds + wave * 1024), vdst_u = (unsigned)(unsigned long)(lds + LDS_V + wave * 1024);
#define DMA_K(t, slot) glds16s(K + (size_t)(t) * 64 * pk, koff, (unsigned)__builtin_amdgcn_readfirstlane((int)(kdst_u + (unsigned)(slot))))
#define DMA_V(t, slot) glds16s(V + (size_t)(t) * 64 * pv, voff, (unsigned)__builtin_amdgcn_readfirstlane((int)(vdst_u + (unsigned)(slot))))
#define WAIT_BAR(N) asm volatile("s_waitcnt vmcnt(" #N ") lgkmcnt(0)\n\ts_barrier" ::: "memory")
    const LAS unsigned char* vp0 = lds + LDS_V + ((lane >> 4) & 1) * 32 + (lane & 3) * 8 + (4 * hi + ((lane & 15) >> 2)) * 64;
    const LAS unsigned char* kp0 = lds + hi * 1024 + r32 * 16;
    const unsigned moff = (unsigned)(qw0 + r32) * 512u + 4u * (unsigned)hi;
    const unsigned mdst_u = (unsigned)(unsigned long)(lds + 49152 + wave * 512);
    const LAS unsigned* mrd = (const LAS unsigned*)(lds + 49152 + wave * 512) + r32;
#define DMA_M(t) glds4s(maskb + (t), moff, (unsigned)__builtin_amdgcn_readfirstlane((int)(mdst_u + 256u * ((unsigned)(t) & 1u))))
#define MREAD(t) do { const LAS unsigned* p_ = mrd + 64 * ((t) & 1); mwc = (unsigned long long)p_[0] | ((unsigned long long)p_[32] << 32); } while (0)
    unsigned long long mwc = ~0ull;
    DMA_K(0, 0); DMA_V(0, 0); DMA_K(1, SLOTB);
    if (MASK) DMA_M(0);
    bf16x8 qf[4];
#pragma unroll
    for (int d0 = 0; d0 < KS; ++d0) qf[d0] = *(const bf16x8*)(Q + (size_t)(qw0 + r32) * pq + 16 * d0 + 8 * hi);
    float m_ref = 0.f, l_reg = 0.f, fsc = 1.f; bool resc = false;
    const short one_hi0 = hi == 0 ? (short)0x3F80 : (short)0;
    const bf16x8 kx = {one_hi0, one_hi0, one_hi0, 0, 0, 0, 0, 0};
    bf16x8 qx;
#define SET_QX() do { const float c_ = cfar - m_ref; const unsigned b1_ = cvtpk(c_, 0.f) & 0xffffu; const float r1_ = c_ - __uint_as_float(b1_ << 16); const unsigned b2_ = cvtpk(r1_, 0.f) & 0xffffu; \
        const float r2_ = r1_ - __uint_as_float(b2_ << 16); const unsigned b3_ = cvtpk(r2_, 0.f) & 0xffffu; \
        qx = (bf16x8){(short)(hi == 0 ? b1_ : 0u), (short)(hi == 0 ? b2_ : 0u), (short)(hi == 0 ? b3_ : 0u), 0, 0, 0, 0, 0}; } while (0)
    SET_QX();
    oT[0] = (f32x16){}; oT[1] = (f32x16){};
    f32x16 pA0, pA1, pB0, pB1; bf16x8 kf[8]; s16x4 vlo[4], vhi[4]; u32x4 pw0, pw1, pw2, pw3;
    int sl_prev = 0, sl_cur = 0, sl_next = SLOTB;
#define ROT() do { sl_prev = sl_cur; sl_cur = sl_next; sl_next = (sl_next == 2 * SLOTB) ? 0 : sl_next + SLOTB; } while (0)
#define KLOAD2(kp, d0) do { kf[2 * (d0)] = *(const LAS bf16x8*)((kp) + (d0) * 2048); kf[2 * (d0) + 1] = *(const LAS bf16x8*)((kp) + (d0) * 2048 + 512); } while (0)
#define MX3(a, b, c) fmaxf(fmaxf((a), (b)), (c))
#define ROWMAX(p0, p1, out) do { float a_ = MX3(p0[0], p0[1], p1[0]), b_ = MX3(p0[2], p0[3], p1[1]); a_ = MX3(a_, p1[2], p1[3]); \
        _Pragma("unroll") for (int r = 4; r < 16; r += 4) { a_ = MX3(a_, p0[r], p0[r + 1]); b_ = MX3(b_, p0[r + 2], p0[r + 3]); a_ = MX3(a_, p1[r], p1[r + 1]); b_ = MX3(b_, p1[r + 2], p1[r + 3]); } \
        out = halfswap_max(fmaxf(a_, b_)); } while (0)
#define MBIT(mw_, cc) __builtin_amdgcn_sbfe((int)(mw_), (cc), 1)
#define CROW(r) (((r) & 3) + 8 * ((r) >> 2))
#define EXM(X, i, mw_) do { X[i] = __builtin_amdgcn_exp2f(X[i]); if (MASK) X[i] = __int_as_float(__float_as_int(X[i]) & MBIT(mw_, CROW(i))); } while (0)
#define BIASADD(C0, C1, t) do { if (BIAS) { const int relb = (t) * 64 - qw0; if (relb + 63 > -91) { const LAS float* lb = lut + (relb + 192 - r32 + 4 * hi); \
        _Pragma("unroll") for (int r = 0; r < 16; ++r) { C0[r] += lb[CROW(r)]; C1[r] += lb[CROW(r) + 32]; } } } } while (0)
    DMA_K(2, 2 * SLOTB);
    WAIT_BAR(3);
    if (MASK) MREAD(0);
#pragma unroll
    for (int d0 = 0; d0 < KS; ++d0) KLOAD2(kp0, d0);
    pA0 = MFMA32(kx, qx, (f32x16){}); pA1 = MFMA32(kx, qx, (f32x16){});
#pragma unroll
    for (int d0 = 0; d0 < KS; ++d0) { pA0 = MFMA32(kf[2 * d0], qf[d0], pA0); pA1 = MFMA32(kf[2 * d0 + 1], qf[d0], pA1); }
    BIASADD(pA0, pA1, 0);
    { float rm; ROWMAX(pA0, pA1, rm); m_ref = rm;
      const unsigned mlo0 = (unsigned)mwc >> (4 * hi), mhi0 = (unsigned)(mwc >> 32) >> (4 * hi);
#pragma unroll
      for (int r = 0; r < 16; ++r) { pA0[r] -= rm; pA1[r] -= rm; EXM(pA0, r, mlo0); EXM(pA1, r, mhi0); } }
    SET_QX();
    if (MASK) DMA_M(1);
    WAIT_BAR(0);
    DMA_K(3, 0); DMA_V(1, SLOTB); ROT();
#pragma unroll
    for (int d0 = 0; d0 < KS; ++d0) KLOAD2(kp0 + sl_cur, d0);
    WAIT_BAR(2);
#define PKW(P, i) cvtpk(P[i], P[i + 1])
#define PAF(k) __builtin_bit_cast(bf16x8, pw##k)
#define VFR(j) (bf16x8){vlo[(j) & 3][0], vlo[(j) & 3][1], vlo[(j) & 3][2], vlo[(j) & 3][3], vhi[(j) & 3][0], vhi[(j) & 3][1], vhi[(j) & 3][2], vhi[(j) & 3][3]}
#define VRD(j) do { vlo[(j) & 3] = vtr(vp_ + (((j) & 1) * 4096 + ((j) >> 1) * 1024)); vhi[(j) & 3] = vtr(vp_ + (((j) & 1) * 4096 + ((j) >> 1) * 1024 + 512)); } while (0)
#define KRD(G, d0) do { if ((G) && (d0) < KS) { KLOAD2(kp0 + sl_next, d0); H64_SBAR(); } } while (0)
#define GAPA(MF, a0, a1, a2, a3, W0, W1, PW) do { MF; sacc += a0; sacc += a1; sacc += a2; sacc += a3; W0; W1; H64_PIN(PW); H64_PIN(sacc); H64_SBAR(); } while (0)
#define GAPB(MF, X, i, mw_) do { MF; EXM(X, i, mw_); EXM(X, (i) + 1, mw_); EXM(X, (i) + 2, mw_); EXM(X, (i) + 3, mw_); H64_PIN(X); H64_SBAR(); } while (0)
#define QKA(C0, C1, g) (KS == 4 ? ((g) & 1 ? (C1 = MFMA32(kf[g], qf[(g) >> 1], C1)) : (C0 = MFMA32(kf[g], qf[(g) >> 1], C0))) \
                                : ((g) < 2 ? ((g) & 1 ? (C1 = MFMA32(kx, qx, (f32x16){})) : (C0 = MFMA32(kx, qx, (f32x16){}))) \
                                           : ((g) & 1 ? (C1 = MFMA32(kf[(g) - 2], qf[((g) - 2) >> 1], C1)) : (C0 = MFMA32(kf[(g) - 2], qf[((g) - 2) >> 1], C0)))))
#define STEP(C0, C1, P0, P1, t, BAND, GK, GV, GL) do { H64_SBAR(); \
    if (MASK) { MREAD(t); if (GV) DMA_M((t) + 1); } \
    const LAS unsigned char* vp_ = vp0 + sl_prev; \
    if (KS == 4) { C0 = MFMA32(kx, qx, (f32x16){}); C1 = MFMA32(kx, qx, (f32x16){}); H64_SBAR(); } \
    VRD(0); H64_SBAR(); float sacc = P0[0] + P0[1]; \
                        GAPA(QKA(C0, C1, 0), P0[2], P0[3], P0[4], P0[5],     pw0[0] = PKW(P0, 0),  pw0[1] = PKW(P0, 2),  pw0); \
    VRD(1); H64_SBAR(); GAPA(QKA(C0, C1, 1), P0[6], P0[7], P0[8], P0[9],     pw0[2] = PKW(P0, 4),  pw0[3] = PKW(P0, 6),  pw0); \
    VRD(2); H64_SBAR(); GAPA(QKA(C0, C1, 2), P0[10], P0[11], P0[12], P0[13], pw1[0] = PKW(P0, 8),  pw1[1] = PKW(P0, 10), pw1); \
    VRD(3); H64_SBAR(); GAPA(QKA(C0, C1, 3), P0[14], P0[15], P1[0], P1[1],   pw1[2] = PKW(P0, 12), pw1[3] = PKW(P0, 14), pw1); \
                        GAPA(QKA(C0, C1, 4), P1[2], P1[3], P1[4], P1[5],     pw2[0] = PKW(P1, 0),  pw2[1] = PKW(P1, 2),  pw2); \
                        GAPA(QKA(C0, C1, 5), P1[6], P1[7], P1[8], P1[9],     pw2[2] = PKW(P1, 4),  pw2[3] = PKW(P1, 6),  pw2); \
                        GAPA(QKA(C0, C1, 6), P1[10], P1[11], P1[12], P1[13], pw3[0] = PKW(P1, 8),  pw3[1] = PKW(P1, 10), pw3); \
                        GAPA(QKA(C0, C1, 7), P1[14], P1[15], 0.f, 0.f,       pw3[2] = PKW(P1, 12), pw3[3] = PKW(P1, 14), pw3); \
    l_reg += sacc; \
    if (GK) DMA_K((t) + 3, sl_cur); if (GV) DMA_V((t) + 1, sl_next); \
    if (BAND) { if ((t) >= mylimit) { _Pragma("unroll") for (int r = 0; r < 16; ++r) { C0[r] = -INFINITY; C1[r] = -INFINITY; } } } \
    BIASADD(C0, C1, t); \
    { float rm; ROWMAX(C0, C1, rm); resc = false; \
      if (__builtin_expect(__any(rm > 8.f), 0)) { const float dl = fmaxf(rm, 0.f); m_ref += dl; fsc = __builtin_amdgcn_exp2f(-dl); l_reg *= fsc; resc = true; SET_QX(); \
          _Pragma("unroll") for (int r = 0; r < 16; ++r) { C0[r] -= dl; C1[r] -= dl; } } } \
    const unsigned mlo_ = (unsigned)mwc >> (4 * hi), mhi_ = (unsigned)(mwc >> 32) >> (4 * hi); H64_SBAR(); \
    GAPB(oT[0] = MFMA32(VFR(0), PAF(0), oT[0]), C0, 0, mlo_);  VRD(4); H64_SBAR(); GAPB(oT[1] = MFMA32(VFR(1), PAF(0), oT[1]), C0, 4, mlo_);  VRD(5); H64_SBAR(); \
    KRD(GL, 0); GAPB(oT[0] = MFMA32(VFR(2), PAF(1), oT[0]), C0, 8, mlo_);  VRD(6); H64_SBAR(); KRD(GL, 1); GAPB(oT[1] = MFMA32(VFR(3), PAF(1), oT[1]), C0, 12, mlo_); VRD(7); H64_SBAR(); \
    KRD(GL, 2); GAPB(oT[0] = MFMA32(VFR(4), PAF(2), oT[0]), C1, 0, mhi_);  KRD(GL, 3); GAPB(oT[1] = MFMA32(VFR(5), PAF(2), oT[1]), C1, 4, mhi_); \
    GAPB(oT[0] = MFMA32(VFR(6), PAF(3), oT[0]), C1, 8, mhi_);              GAPB(oT[1] = MFMA32(VFR(7), PAF(3), oT[1]), C1, 12, mhi_); \
    } while (0)
#define RESC() do { if (resc) { _Pragma("unroll") for (int r = 0; r < 16; ++r) { oT[0][r] *= fsc; oT[1][r] *= fsc; } } } while (0)
    int t = 1;
    for (; t + 5 < NT; t += 2) {
        STEP(pB0, pB1, pA0, pA1, t, false, true, true, true);     WAIT_BAR(2); RESC(); ROT();
        STEP(pA0, pA1, pB0, pB1, t + 1, false, true, true, true); WAIT_BAR(2); RESC(); ROT();
    }
#define ENDW(tt) do { if ((tt) + 3 < NT) { WAIT_BAR(2); } else if ((tt) + 2 < NT) { WAIT_BAR(1); } else { WAIT_BAR(0); } } while (0)
    for (; t + 1 < NT; t += 2) {
        STEP(pB0, pB1, pA0, pA1, t, true, (t + 3 < NT), (t + 1 < NT), (t + 1 < NT));         ENDW(t);     RESC(); ROT();
        STEP(pA0, pA1, pB0, pB1, t + 1, true, (t + 4 < NT), (t + 2 < NT), (t + 2 < NT));     ENDW(t + 1); RESC(); ROT();
    }
    STEP(pB0, pB1, pA0, pA1, NT - 1, true, false, false, false); RESC();
    { float sacc = pB0[0] + pB0[1];
#pragma unroll
      for (int r = 2; r < 16; ++r) sacc += pB0[r];
#pragma unroll
      for (int r = 0; r < 16; ++r) sacc += pB1[r];
      l_reg += sacc;
      pw0 = (u32x4){PKW(pB0, 0), PKW(pB0, 2), PKW(pB0, 4), PKW(pB0, 6)}; pw1 = (u32x4){PKW(pB0, 8), PKW(pB0, 10), PKW(pB0, 12), PKW(pB0, 14)};
      pw2 = (u32x4){PKW(pB1, 0), PKW(pB1, 2), PKW(pB1, 4), PKW(pB1, 6)}; pw3 = (u32x4){PKW(pB1, 8), PKW(pB1, 10), PKW(pB1, 12), PKW(pB1, 14)};
      const LAS unsigned char* vp_ = vp0 + sl_cur;
      VRD(0); VRD(1); VRD(2); VRD(3);
      oT[0] = MFMA32(VFR(0), PAF(0), oT[0]); oT[1] = MFMA32(VFR(1), PAF(0), oT[1]); oT[0] = MFMA32(VFR(2), PAF(1), oT[0]); oT[1] = MFMA32(VFR(3), PAF(1), oT[1]); H64_SBAR();
      VRD(4); VRD(5); VRD(6); VRD(7);
      oT[0] = MFMA32(VFR(4), PAF(2), oT[0]); oT[1] = MFMA32(VFR(5), PAF(2), oT[1]); oT[0] = MFMA32(VFR(6), PAF(3), oT[0]); oT[1] = MFMA32(VFR(7), PAF(3), oT[1]); }
    const float inv = 1.f / halfswap_sum(l_reg);
#pragma unroll
    for (int d = 0; d < 2; ++d)
#pragma unroll
        for (int r = 0; r < 16; ++r) oT[d][r] *= inv;
    asm volatile("s_waitcnt lgkmcnt(0)\n\ts_barrier" ::: "memory");
#undef DMA_M
#undef MREAD
#undef DMA_K
#undef DMA_V
#undef WAIT_BAR
#undef SET_QX
#undef ROT
#undef KLOAD2
#undef MX3
#undef ROWMAX
#undef MBIT
#undef CROW
#undef EXM
#undef BIASADD
#undef PKW
#undef PAF
#undef VFR
#undef VRD
#undef KRD
#undef GAPA
#undef GAPB
#undef QKA
#undef STEP
#undef RESC
#undef ENDW
}

template <bool BIAS, bool PRE, bool NEXT>
DI void attn_pass_h128(LAS unsigned char* lds, const bf16* Q, const bf16* K, const bf16* V, int pq, int pk, int pv, int q0, int nt, const unsigned long long* maskb, float cfar, f32x16 (&oT)[4], int tid, const LAS float* lut,
                       const bf16* Qn, const bf16* Kn, int& s0, bf16x8 (&qf)[4]) {
    constexpr bool MASK = false; constexpr int KS = 4;
    asm volatile("" : "+v"(tid));
    const int lane = tid & 63, wave = __builtin_amdgcn_readfirstlane(tid >> 6), r32 = lane & 31, hi = lane >> 5;
    const int qw0 = q0 + 32 * wave, mylimit = (qw0 >> 6) + 1, NT = nt;
    constexpr int SLOTB = 8192, VSLOTB = 16384, LDS_V = 3 * SLOTB;
    const unsigned koff = (unsigned)(lane * pk + wave * 8) * 2u, voff = (unsigned)((16 * (wave & 3) + (lane >> 2)) * pv + (wave >> 2) * 32 + (lane & 3) * 8) * 2u;
    const unsigned kdst_u = (unsigned)(unsigned long)(lds + wave * 1024), vdst_u = (unsigned)(unsigned long)(lds + LDS_V + wave * 1024);
#define DMA_K(t, slot) glds16s(K + (size_t)(t) * 64 * pk, koff, (unsigned)__builtin_amdgcn_readfirstlane((int)(kdst_u + (unsigned)(slot))))
#define DMA_KN(t, slot) glds16s(Kn + (size_t)(t) * 64 * pk, koff, (unsigned)__builtin_amdgcn_readfirstlane((int)(kdst_u + (unsigned)(slot))))
#define DMA_V(t, slot) do { glds16s(V + (size_t)(t) * 64 * pv, voff, (unsigned)__builtin_amdgcn_readfirstlane((int)(vdst_u + 2u * (unsigned)(slot)))); \
        glds16s(V + (size_t)(t) * 64 * pv + 64, voff, (unsigned)__builtin_amdgcn_readfirstlane((int)(vdst_u + 2u * (unsigned)(slot) + 8192u))); } while (0)
#define WAIT_BAR(N) do { if (MASK) asm volatile("s_waitcnt vmcnt(" #N ") lgkmcnt(0)\n\ts_barrier" : "+v"(mwc), "+v"(mwn) :: "memory"); else asm volatile("s_waitcnt vmcnt(" #N ") lgkmcnt(0)\n\ts_barrier" ::: "memory"); } while (0)
    const LAS unsigned char* vp0 = lds + LDS_V + ((lane >> 4) & 1) * 32 + (lane & 3) * 8 + (4 * hi + ((lane & 15) >> 2)) * 64;
    const LAS unsigned char* kp0 = lds + hi * 1024 + r32 * 16;
    const unsigned moff = (unsigned)(qw0 + r32) * 512u;
#define MLOAD(dst, t) gld64s(dst, maskb + (t), moff)
    unsigned long long mwc = ~0ull, mwn = ~0ull;
#define NXS(x) ((x) == 2 * SLOTB ? 0 : (x) + SLOTB)
    const int b0 = PRE ? s0 : 0, b1 = NXS(b0), b2 = NXS(b1);
    if (!PRE) { DMA_K(0, b0); DMA_V(0, b0); DMA_K(1, b1); }
    if (!PRE) {
#pragma unroll
        for (int d0 = 0; d0 < KS; ++d0) qf[d0] = *(const bf16x8*)(Q + (size_t)(qw0 + r32) * pq + 16 * d0 + 8 * hi);
    }
    float m_ref = 0.f, l_reg = 0.f, fsc = 1.f; bool resc = false;
    const short one_hi0 = hi == 0 ? (short)0x3F80 : (short)0;
    const bf16x8 kx = {one_hi0, one_hi0, one_hi0, 0, 0, 0, 0, 0};
    bf16x8 qx;
#define SET_QX() do { const float c_ = cfar - m_ref; const unsigned b1_ = cvtpk(c_, 0.f) & 0xffffu; const float r1_ = c_ - __uint_as_float(b1_ << 16); const unsigned b2_ = cvtpk(r1_, 0.f) & 0xffffu; \
        const float r2_ = r1_ - __uint_as_float(b2_ << 16); const unsigned b3_ = cvtpk(r2_, 0.f) & 0xffffu; \
        qx = (bf16x8){(short)(hi == 0 ? b1_ : 0u), (short)(hi == 0 ? b2_ : 0u), (short)(hi == 0 ? b3_ : 0u), 0, 0, 0, 0, 0}; } while (0)
    SET_QX();
    oT[0] = (f32x16){}; oT[1] = (f32x16){}; oT[2] = (f32x16){}; oT[3] = (f32x16){};
    f32x16 C0, C1; bf16x8 kf[8]; s16x4 vlo[4], vhi[4]; u32x4 pw0, pw1, pw2, pw3;
    int sl_prev = b0, sl_cur = b0, sl_next = b1;
#define ROT() do { sl_prev = sl_cur; sl_cur = sl_next; sl_next = (sl_next == 2 * SLOTB) ? 0 : sl_next + SLOTB; } while (0)
#define KLOAD2(kp, d0) do { kf[2 * (d0)] = *(const LAS bf16x8*)((kp) + (d0) * 2048); kf[2 * (d0) + 1] = *(const LAS bf16x8*)((kp) + (d0) * 2048 + 512); } while (0)
#define MX3(a, b, c) fmaxf(fmaxf((a), (b)), (c))
#define ROWMAX(p0, p1, out) do { float a_ = MX3(p0[0], p0[1], p1[0]), b_ = MX3(p0[2], p0[3], p1[1]); a_ = MX3(a_, p1[2], p1[3]); \
        _Pragma("unroll") for (int r = 4; r < 16; r += 4) { a_ = MX3(a_, p0[r], p0[r + 1]); b_ = MX3(b_, p0[r + 2], p0[r + 3]); a_ = MX3(a_, p1[r], p1[r + 1]); b_ = MX3(b_, p1[r + 2], p1[r + 3]); } \
        out = halfswap_max(fmaxf(a_, b_)); } while (0)
#define MBIT(mw_, cc) ((int)((mw_) << (31 - (cc))) >> 31)
#define CROW(r) (((r) & 3) + 8 * ((r) >> 2))
#define EXM(X, i, mw_) do { X[i] = __builtin_amdgcn_exp2f(X[i]); if (MASK) X[i] = __int_as_float(__float_as_int(X[i]) & MBIT(mw_, CROW(i))); } while (0)
#define BIASADD(C0, C1, t) do { if (BIAS) { const int relb = (t) * 64 - qw0; if (relb + 63 > -91) { const LAS float* lb = lut + (relb + 192 - r32 + 4 * hi); \
        _Pragma("unroll") for (int r = 0; r < 16; ++r) { C0[r] += lb[CROW(r)]; C1[r] += lb[CROW(r) + 32]; } } } } while (0)
    if (!PRE) DMA_K(2, b2);
    WAIT_BAR(4);
#pragma unroll
    for (int d0 = 0; d0 < KS; ++d0) KLOAD2(kp0 + b0, d0);
    C0 = MFMA32(kx, qx, (f32x16){}); C1 = MFMA32(kx, qx, (f32x16){});
#pragma unroll
    for (int d0 = 0; d0 < KS; ++d0) { C0 = MFMA32(kf[2 * d0], qf[d0], C0); C1 = MFMA32(kf[2 * d0 + 1], qf[d0], C1); }
    BIASADD(C0, C1, 0);
    { float rm; ROWMAX(C0, C1, rm); m_ref = rm; float sacc = 0.f;
#pragma unroll
      for (int r = 0; r < 16; ++r) { C0[r] = __builtin_amdgcn_exp2f(C0[r] - rm); C1[r] = __builtin_amdgcn_exp2f(C1[r] - rm); sacc += C0[r] + C1[r]; }
      l_reg = sacc;
      pw0 = (u32x4){cvtpk(C0[0], C0[1]), cvtpk(C0[2], C0[3]), cvtpk(C0[4], C0[5]), cvtpk(C0[6], C0[7])}; pw1 = (u32x4){cvtpk(C0[8], C0[9]), cvtpk(C0[10], C0[11]), cvtpk(C0[12], C0[13]), cvtpk(C0[14], C0[15])};
      pw2 = (u32x4){cvtpk(C1[0], C1[1]), cvtpk(C1[2], C1[3]), cvtpk(C1[4], C1[5]), cvtpk(C1[6], C1[7])}; pw3 = (u32x4){cvtpk(C1[8], C1[9]), cvtpk(C1[10], C1[11]), cvtpk(C1[12], C1[13]), cvtpk(C1[14], C1[15])}; }
    SET_QX();
    if (MASK) MLOAD(mwn, 1);
    WAIT_BAR(0);
    if (MASK) mwc = mwn;
    DMA_K(3, b0); DMA_V(1, b1); ROT();
#pragma unroll
    for (int d0 = 0; d0 < KS; ++d0) KLOAD2(kp0 + sl_cur, d0);
    WAIT_BAR(3);
#define PKW(P, i) cvtpk(P[i], P[i + 1])
#define PAF(k) __builtin_bit_cast(bf16x8, pw##k)
#define VFR(i) (bf16x8){vlo[i][0], vlo[i][1], vlo[i][2], vlo[i][3], vhi[i][0], vhi[i][1], vhi[i][2], vhi[i][3]}
#define VRD(i) do { vlo[(i) & 3] = vtr(vp_ + (((i) & 3) * 4096 + ((i) >> 2) * 1024)); vhi[(i) & 3] = vtr(vp_ + (((i) & 3) * 4096 + ((i) >> 2) * 1024 + 512)); } while (0)
#define KRD(G, d0) do { if ((G) && (d0) < KS) { KLOAD2(kp0 + sl_next, d0); H64_SBAR(); } } while (0)
#define GAPA(MF, a0, a1, a2, a3, W0, W1, PW) do { MF; sacc += a0; sacc += a1; sacc += a2; sacc += a3; W0; W1; H64_PIN(PW); H64_PIN(sacc); H64_SBAR(); } while (0)
#define GAPB2(MF, X, i) do { MF; X[i] = __builtin_amdgcn_exp2f(X[i]); X[(i) + 1] = __builtin_amdgcn_exp2f(X[(i) + 1]); H64_PIN(X); H64_SBAR(); } while (0)
#define GAPB(MF, X, i, mw_) do { MF; EXM(X, i, mw_); EXM(X, (i) + 1, mw_); EXM(X, (i) + 2, mw_); EXM(X, (i) + 3, mw_); H64_PIN(X); H64_SBAR(); } while (0)
#define STEP(t, BAND, GK, GV, GL, GQ) do { H64_SBAR(); \
    const LAS unsigned char* vp_ = vp0 + 2 * sl_prev; \
    C0 = MFMA32(kx, qx, (f32x16){}); C1 = MFMA32(kx, qx, (f32x16){}); H64_SBAR(); \
    VRD(0); H64_SBAR(); C0 = MFMA32(kf[0], qf[0], C0); H64_SBAR(); VRD(1); H64_SBAR(); C1 = MFMA32(kf[1], qf[0], C1); H64_SBAR(); \
    VRD(2); H64_SBAR(); C0 = MFMA32(kf[2], qf[1], C0); H64_SBAR(); VRD(3); H64_SBAR(); C1 = MFMA32(kf[3], qf[1], C1); H64_SBAR(); \
    C0 = MFMA32(kf[4], qf[2], C0); H64_SBAR(); C1 = MFMA32(kf[5], qf[2], C1); H64_SBAR(); \
    C0 = MFMA32(kf[6], qf[3], C0); H64_SBAR(); C1 = MFMA32(kf[7], qf[3], C1); H64_SBAR(); \
    if (GK) DMA_K((t) + 3, sl_cur); if (GV) DMA_V((t) + 1, sl_next); \
    if (NEXT && (GQ)) { _Pragma("unroll") for (int d0 = 0; d0 < KS; ++d0) qf[d0] = *(const bf16x8*)(Qn + (size_t)(qw0 + r32) * pq + 16 * d0 + 8 * hi); } \
    if (BAND) { if ((t) >= mylimit) { _Pragma("unroll") for (int r = 0; r < 16; ++r) { C0[r] = -INFINITY; C1[r] = -INFINITY; } } } \
    BIASADD(C0, C1, t); \
    { float rm; ROWMAX(C0, C1, rm); resc = false; \
      if (__builtin_expect(__any(rm > 8.f), 0)) { const float dl = fmaxf(rm, 0.f); m_ref += dl; fsc = __builtin_amdgcn_exp2f(-dl); l_reg *= fsc; resc = true; SET_QX(); \
          _Pragma("unroll") for (int r = 0; r < 16; ++r) { C0[r] -= dl; C1[r] -= dl; } } } \
    float sacc = 0.f; H64_SBAR(); \
    oT[0] = MFMA32(VFR(0), PAF(0), oT[0]); C0[0] = __builtin_amdgcn_exp2f(C0[0]); C0[1] = __builtin_amdgcn_exp2f(C0[1]); C0[2] = __builtin_amdgcn_exp2f(C0[2]); H64_PIN(C0); H64_SBAR(); VRD(4); H64_SBAR(); \
    oT[1] = MFMA32(VFR(1), PAF(0), oT[1]); C0[3] = __builtin_amdgcn_exp2f(C0[3]); C0[4] = __builtin_amdgcn_exp2f(C0[4]); C0[5] = __builtin_amdgcn_exp2f(C0[5]); sacc += C0[0]; sacc += C0[1]; H64_PIN(C0); H64_PIN(sacc); H64_SBAR(); VRD(5); H64_SBAR(); \
    oT[2] = MFMA32(VFR(2), PAF(0), oT[2]); C0[6] = __builtin_amdgcn_exp2f(C0[6]); C0[7] = __builtin_amdgcn_exp2f(C0[7]); C0[8] = __builtin_amdgcn_exp2f(C0[8]); sacc += C0[2]; sacc += C0[3]; H64_PIN(C0); H64_PIN(sacc); H64_SBAR(); VRD(6); H64_SBAR(); \
    oT[3] = MFMA32(VFR(3), PAF(0), oT[3]); C0[9] = __builtin_amdgcn_exp2f(C0[9]); C0[10] = __builtin_amdgcn_exp2f(C0[10]); C0[11] = __builtin_amdgcn_exp2f(C0[11]); sacc += C0[4]; sacc += C0[5]; H64_PIN(C0); H64_PIN(sacc); H64_SBAR(); VRD(7); H64_SBAR(); \
    oT[0] = MFMA32(VFR(0), PAF(1), oT[0]); C0[12] = __builtin_amdgcn_exp2f(C0[12]); C0[13] = __builtin_amdgcn_exp2f(C0[13]); C0[14] = __builtin_amdgcn_exp2f(C0[14]); sacc += C0[6]; sacc += C0[7]; pw0[0] = cvtpk(C0[0], C0[1]); H64_PIN(C0); H64_PIN(pw0); H64_PIN(sacc); H64_SBAR(); VRD(8); H64_SBAR(); \
    oT[1] = MFMA32(VFR(1), PAF(1), oT[1]); C0[15] = __builtin_amdgcn_exp2f(C0[15]); C1[0] = __builtin_amdgcn_exp2f(C1[0]); C1[1] = __builtin_amdgcn_exp2f(C1[1]); sacc += C0[8]; sacc += C0[9]; pw0[1] = cvtpk(C0[2], C0[3]); H64_PIN(C0); H64_PIN(C1); H64_PIN(pw0); H64_PIN(sacc); H64_SBAR(); VRD(9); H64_SBAR(); \
    oT[2] = MFMA32(VFR(2), PAF(1), oT[2]); C1[2] = __builtin_amdgcn_exp2f(C1[2]); C1[3] = __builtin_amdgcn_exp2f(C1[3]); C1[4] = __builtin_amdgcn_exp2f(C1[4]); sacc += C0[10]; sacc += C0[11]; pw0[2] = cvtpk(C0[4], C0[5]); H64_PIN(C1); H64_PIN(pw0); H64_PIN(sacc); H64_SBAR(); VRD(10); H64_SBAR(); \
    oT[3] = MFMA32(VFR(3), PAF(1), oT[3]); C1[5] = __builtin_amdgcn_exp2f(C1[5]); C1[6] = __builtin_amdgcn_exp2f(C1[6]); C1[7] = __builtin_amdgcn_exp2f(C1[7]); sacc += C0[12]; sacc += C0[13]; pw0[3] = cvtpk(C0[6], C0[7]); H64_PIN(C1); H64_PIN(pw0); H64_PIN(sacc); H64_SBAR(); VRD(11); H64_SBAR(); \
    KRD(GL, 0); oT[0] = MFMA32(VFR(0), PAF(2), oT[0]); C1[8] = __builtin_amdgcn_exp2f(C1[8]); C1[9] = __builtin_amdgcn_exp2f(C1[9]); C1[10] = __builtin_amdgcn_exp2f(C1[10]); sacc += C0[14]; sacc += C0[15]; pw1[0] = cvtpk(C0[8], C0[9]); H64_PIN(C1); H64_PIN(pw1); H64_PIN(sacc); H64_SBAR(); VRD(12); H64_SBAR(); \
    oT[1] = MFMA32(VFR(1), PAF(2), oT[1]); C1[11] = __builtin_amdgcn_exp2f(C1[11]); C1[12] = __builtin_amdgcn_exp2f(C1[12]); C1[13] = __builtin_amdgcn_exp2f(C1[13]); sacc += C1[0]; sacc += C1[1]; pw1[1] = cvtpk(C0[10], C0[11]); H64_PIN(C1); H64_PIN(pw1); H64_PIN(sacc); H64_SBAR(); VRD(13); H64_SBAR(); \
    KRD(GL, 1); oT[2] = MFMA32(VFR(2), PAF(2), oT[2]); C1[14] = __builtin_amdgcn_exp2f(C1[14]); C1[15] = __builtin_amdgcn_exp2f(C1[15]); sacc += C1[2]; sacc += C1[3]; pw1[2] = cvtpk(C0[12], C0[13]); H64_PIN(C1); H64_PIN(pw1); H64_PIN(sacc); H64_SBAR(); VRD(14); H64_SBAR(); \
    oT[3] = MFMA32(VFR(3), PAF(2), oT[3]); sacc += C1[4]; sacc += C1[5]; pw1[3] = cvtpk(C0[14], C0[15]); H64_PIN(pw1); H64_PIN(sacc); H64_SBAR(); VRD(15); H64_SBAR(); \
    KRD(GL, 2); oT[0] = MFMA32(VFR(0), PAF(3), oT[0]); sacc += C1[6]; sacc += C1[7]; pw2[0] = cvtpk(C1[0], C1[1]); H64_PIN(pw2); H64_PIN(sacc); H64_SBAR(); \
    oT[1] = MFMA32(VFR(1), PAF(3), oT[1]); sacc += C1[8]; sacc += C1[9]; pw2[1] = cvtpk(C1[2], C1[3]); H64_PIN(pw2); H64_PIN(sacc); H64_SBAR(); \
    KRD(GL, 3); oT[2] = MFMA32(VFR(2), PAF(3), oT[2]); sacc += C1[10]; sacc += C1[11]; pw2[2] = cvtpk(C1[4], C1[5]); H64_PIN(pw2); H64_PIN(sacc); H64_SBAR(); \
    oT[3] = MFMA32(VFR(3), PAF(3), oT[3]); sacc += C1[12]; sacc += C1[13]; pw2[3] = cvtpk(C1[6], C1[7]); H64_PIN(pw2); H64_PIN(sacc); H64_SBAR(); \
    sacc += C1[14]; sacc += C1[15]; l_reg += sacc; \
    pw3[0] = cvtpk(C1[8], C1[9]); pw3[1] = cvtpk(C1[10], C1[11]); pw3[2] = cvtpk(C1[12], C1[13]); pw3[3] = cvtpk(C1[14], C1[15]); \
    } while (0)
#define RESC() do { if (resc) { _Pragma("unroll") for (int r = 0; r < 16; ++r) { oT[0][r] *= fsc; oT[1][r] *= fsc; oT[2][r] *= fsc; oT[3][r] *= fsc; } } } while (0)
    int t = 1;
    for (; t + 4 < NT; ++t) { STEP(t, false, true, true, true, false); WAIT_BAR(3); RESC(); ROT(); }
#define ENDW(tt) do { if ((tt) + 3 < NT) { WAIT_BAR(3); } else if ((tt) + 2 < NT) { WAIT_BAR(2); } else { WAIT_BAR(0); } } while (0)
    for (; t + 1 < NT; ++t) { STEP(t, true, (t + 3 < NT), (t + 1 < NT), (t + 1 < NT), false); ENDW(t); RESC(); ROT(); }
    if (NEXT) { const int n0 = sl_next, n1 = NXS(n0), n2 = NXS(n1); DMA_KN(0, n0); DMA_V(0, n0); DMA_KN(1, n1); DMA_KN(2, n2); s0 = n0; }
    STEP(NT - 1, true, false, false, false, true); RESC();
    { const LAS unsigned char* vp_ = vp0 + 2 * sl_cur;
      VRD(0); VRD(1); VRD(2); VRD(3);
      oT[0] = MFMA32(VFR(0), PAF(0), oT[0]); oT[1] = MFMA32(VFR(1), PAF(0), oT[1]); oT[2] = MFMA32(VFR(2), PAF(0), oT[2]); oT[3] = MFMA32(VFR(3), PAF(0), oT[3]); H64_SBAR();
      VRD(4); VRD(5); VRD(6); VRD(7);
      oT[0] = MFMA32(VFR(0), PAF(1), oT[0]); oT[1] = MFMA32(VFR(1), PAF(1), oT[1]); oT[2] = MFMA32(VFR(2), PAF(1), oT[2]); oT[3] = MFMA32(VFR(3), PAF(1), oT[3]); H64_SBAR();
      VRD(8); VRD(9); VRD(10); VRD(11);
      oT[0] = MFMA32(VFR(0), PAF(2), oT[0]); oT[1] = MFMA32(VFR(1), PAF(2), oT[1]); oT[2] = MFMA32(VFR(2), PAF(2), oT[2]); oT[3] = MFMA32(VFR(3), PAF(2), oT[3]); H64_SBAR();
      VRD(12); VRD(13); VRD(14); VRD(15);
      oT[0] = MFMA32(VFR(0), PAF(3), oT[0]); oT[1] = MFMA32(VFR(1), PAF(3), oT[1]); oT[2] = MFMA32(VFR(2), PAF(3), oT[2]); oT[3] = MFMA32(VFR(3), PAF(3), oT[3]); H64_SBAR();
    }
    const float inv = 1.f / halfswap_sum(l_reg);
#pragma unroll
    for (int d = 0; d < 4; ++d)
#pragma unroll
        for (int r = 0; r < 16; ++r) oT[d][r] *= inv;
    asm volatile("s_waitcnt lgkmcnt(0)\n\ts_barrier" ::: "memory");
#undef MLOAD
#undef DMA_K
#undef DMA_V
#undef DMA_KN
#undef NXS
#undef WAIT_BAR
#undef SET_QX
#undef ROT
#undef KLOAD2
#undef MX3
#undef ROWMAX
#undef MBIT
#undef CROW
#undef EXM
#undef BIASADD
#undef PKW
#undef PAF
#undef VFR
#undef VRD
#undef KRD
#undef GAPA
#undef GAPB
#undef GAPB2
#undef STEP
#undef RESC
#undef ENDW
}

template <int ND>
DI void store_oT(bf16* orow, const f32x16 (&oT)[ND], int hi) {
#pragma unroll
    for (int d = 0; d < ND; ++d)
#pragma unroll
        for (int g = 0; g < 4; ++g) st4(orow + 32 * d + 8 * g + 4 * hi, oT[d][4 * g], oT[d][4 * g + 1], oT[d][4 * g + 2], oT[d][4 * g + 3]);
}

DI void attn_phase(const bf16* Z, const bf16* MLA, bf16* MIX, const unsigned long long* MASK, unsigned* O0, const float* par, const float* subln, int layer, gu32* qctr,
                   const float* w_gate, const float* w_up, const float* w_down, unsigned char* WGU, unsigned char* WD, LAS unsigned char* lds, int tid) {
    const int lane = tid & 63, wave = __builtin_amdgcn_readfirstlane(tid >> 6), r32 = lane & 31, hi = lane >> 5;
    volatile LAS int* slot = (volatile LAS int*)(lds + AUX_OFF + 2048);
    LAS float* lutall = (LAS float*)(lds + 73728);
    LAS float* gain = (LAS float*)(lds + AUX_OFF + 1024);
    const float lam = par[layer], omli = par[2 + layer];
    for (int i = tid; i < 2048; i += NTHR) lutall[i] = par[(PAR_LUT / 4) + i] - par[(PAR_LUT / 4) + (i & ~255)];
    if (tid < 128) gain[tid] = subln[layer * 128 + tid] * omli;
    __syncthreads();
    for (;;) {
        if (tid == 0) *slot = (int)__hip_atomic_fetch_add(qctr, 1u, RLX_AGENT);
        __syncthreads();
        const int uq = *slot;
        if (uq >= 2304) break;
        if (uq % 3 == 2) {
            const int grp = uq / 3;
            moe_convert_items<4>(w_gate, w_up, w_down, WGU, WD, (LAS float*)(lds + wave * 8448), grp * 32 + wave * 4, lane);
            __syncthreads();
            continue;
        }
        const int u = (uq / 3) * 2 + (uq % 3);
        const unsigned ue = ((const unsigned*)par)[(PAR_ORD / 4) + u];
        const int type = (int)(ue >> 16), qb = (int)((ue >> 8) & 0xffu), bh = (int)(ue & 0xffu), b = bh >> 2, h = bh & 3;
        const int q0 = qb * 256, nt = 4 * qb + 4; const size_t rb = (size_t)b * SEQ;
        const float cfar = type < 2 ? par[(PAR_LUT / 4) + (type * 4 + h) * 256] : 0.f;
        if (type == 0) {
            bf16* orow = MIX + (rb + q0 + 32 * wave + r32) * DM;
            f32x16 oT[4]; bf16x8 qfx[4]; int s0 = 0;
#define O0L(j) (*(LAS u32x4*)(lds + ((j) < 6 ? PARK_A + (j) * 8192 : PARK_B + ((j) - 6) * 8192) + tid * 16))
            const bf16* Vp = Z + rb * ZP + Z_AV + h * 128;
            attn_pass_h128<true, false, true>(lds, Z + rb * ZP + Z_AQ + (h * 2) * 64, Z + rb * ZP + Z_AK + (h * 2) * 64, Vp, ZP, ZP, ZP, q0, nt, nullptr, cfar, oT, tid, lutall + (type * 4 + h) * 256,
                                              Z + rb * ZP + Z_AQ + (h * 2 + 1) * 64, Z + rb * ZP + Z_AK + (h * 2 + 1) * 64, s0, qfx);
#pragma unroll
            for (int d = 0; d < 4; ++d)
#pragma unroll
                for (int i = 0; i < 2; ++i) O0L(d * 2 + i) = (u32x4){cvtpk(oT[d][8 * i], oT[d][8 * i + 1]), cvtpk(oT[d][8 * i + 2], oT[d][8 * i + 3]), cvtpk(oT[d][8 * i + 4], oT[d][8 * i + 5]), cvtpk(oT[d][8 * i + 6], oT[d][8 * i + 7])};
            attn_pass_h128<true, true, false>(lds, Z + rb * ZP + Z_AQ + (h * 2 + 1) * 64, Z + rb * ZP + Z_AK + (h * 2 + 1) * 64, Vp, ZP, ZP, ZP, q0, nt, nullptr, cfar, oT, tid, lutall + (type * 4 + h) * 256,
                                              nullptr, nullptr, s0, qfx);
            float ss = 0.f;
#pragma unroll
            for (int d = 0; d < 4; ++d)
#pragma unroll
                for (int i = 0; i < 2; ++i) { const u32x4 pk = O0L(d * 2 + i);
#pragma unroll
                    for (int e = 0; e < 4; ++e) { const unsigned p = pk[e]; const float a = __uint_as_float(p << 16) - lam * oT[d][8 * i + 2 * e], c2 = __uint_as_float(p & 0xffff0000u) - lam * oT[d][8 * i + 2 * e + 1];
                        oT[d][8 * i + 2 * e] = a; oT[d][8 * i + 2 * e + 1] = c2; ss += a * a + c2 * c2; } }
            const float rstd = rsqrtf(halfswap_sum(ss) * (1.f / 128.f) + EPS);
#pragma unroll
            for (int d = 0; d < 4; ++d)
#pragma unroll
                for (int rr = 0; rr < 16; ++rr) oT[d][rr] *= rstd * gain[32 * d + (rr & 3) + 8 * (rr >> 2) + 4 * hi];
            store_oT<4>(orow + h * 128, oT, hi);
        } else if (type == 1) {
            f32x16 oT[2];
            attn_pass_h64<true, true, 4>(lds, Z + rb * ZP + Z_BQ + h * 64, Z + rb * ZP + Z_BK + h * 64, Z + rb * ZP + Z_BV + h * 64, ZP, ZP, ZP, q0, nt, MASK + rb * 64, cfar, oT, tid, lutall + (type * 4 + h) * 256);
            store_oT<2>(MIX + (rb + q0 + 32 * wave + r32) * DM + 512 + h * 64, oT, hi);
        } else {
            f32x16 oT[2];
            attn_pass_h64<false, false, 3>(lds, MLA + rb * MLAP + h * 64, MLA + rb * MLAP + 256 + h * 64, MLA + rb * MLAP + 512 + h * 64, MLAP, MLAP, MLAP, q0, nt, nullptr, cfar, oT, tid, lutall + (type * 4 + h) * 256);
            store_oT<2>(MIX + (rb + q0 + 32 * wave + r32) * DM + 768 + h * 64, oT, hi);
        }
    }
}


DI void router_unit(const bf16* XA, const bf16* WRl  , const float* bg, const float* be, int* rt_e, float* rt_g, float* rstd_g, int* cnt_g, LAS unsigned char* lds, int unit, int tid) {
    const int lane = tid & 63, wave = __builtin_amdgcn_readfirstlane(tid >> 6), r32 = lane & 31, hi = lane >> 5;
    LAS int* hist = (LAS int*)(lds + AUX_OFF + 4096);
    LAS float* xch = (LAS float*)lds;
    if (tid < 32) hist[tid] = 0;
    f32x16 a0[4], a1[4]; float ss[4];
#pragma unroll
    for (int tb = 0; tb < 4; ++tb) { a0[tb] = (f32x16){}; a1[tb] = (f32x16){}; ss[tb] = 0.f; }
    const bf16* xg = XA + (size_t)(unit * 128 + r32) * DM + wave * 128 + 32 * hi;
    const bf16* wg = WRl + (size_t)r32 * 1024 + wave * 128 + 32 * hi;
    const bf16* wg2 = WRl + (size_t)(32 + (r32 < 4 ? r32 : 4)) * 1024 + wave * 128 + 32 * hi;
    u32x4 X[2][4]; bf16x8 W[2][4];
#define RT_LD(s, S) do { const int o_ = 64 * ((s) >> 2) + 8 * ((s) & 3); _Pragma("unroll") for (int tb = 0; tb < 4; ++tb) X[S][tb] = *(const u32x4*)(xg + (size_t)tb * 32 * DM + o_); \
        W[S][0] = *(const bf16x8*)(wg + o_); W[S][1] = *(const bf16x8*)(wg + 64 * 1024 + o_); W[S][2] = *(const bf16x8*)(wg2 + o_); W[S][3] = *(const bf16x8*)(wg2 + 64 * 1024 + o_); } while (0)
#define RT_CP(S) do { _Pragma("unroll") for (int tb = 0; tb < 4; ++tb) { \
            const f32x4 xa = {__uint_as_float(X[S][tb].x << 16), __uint_as_float(X[S][tb].x & 0xffff0000u), __uint_as_float(X[S][tb].y << 16), __uint_as_float(X[S][tb].y & 0xffff0000u)}, \
                        xb = {__uint_as_float(X[S][tb].z << 16), __uint_as_float(X[S][tb].z & 0xffff0000u), __uint_as_float(X[S][tb].w << 16), __uint_as_float(X[S][tb].w & 0xffff0000u)}; \
            ss[tb] += (xa[0] * xa[0] + xa[1] * xa[1]) + (xa[2] * xa[2] + xa[3] * xa[3]) + (xb[0] * xb[0] + xb[1] * xb[1]) + (xb[2] * xb[2] + xb[3] * xb[3]); \
            const bf16x8 xh = __builtin_bit_cast(bf16x8, X[S][tb]); \
            a0[tb] = MFMA32(W[S][0], xh, a0[tb]); a0[tb] = MFMA32(W[S][1], xh, a0[tb]); a1[tb] = MFMA32(W[S][2], xh, a1[tb]); a1[tb] = MFMA32(W[S][3], xh, a1[tb]); } } while (0)
    RT_LD(0, 0);
    for (int s = 0; s < 8; s += 2) {
        RT_LD(s + 1, 1);
        RT_CP(0);
        { const int sn = s + 2 < 8 ? s + 2 : 7; RT_LD(sn, 0); }
        RT_CP(1);
    }
#undef RT_LD
#undef RT_CP
#pragma unroll
    for (int r = 4; r >= 1; r >>= 1) {
        if (wave >= r && wave < 2 * r) { LAS float* o = xch + (wave - r) * (84 * 64) + lane;
#pragma unroll
            for (int tb = 0; tb < 4; ++tb) {
#pragma unroll
                for (int i = 0; i < 16; ++i) o[(tb * 21 + i) * 64] = a0[tb][i];
#pragma unroll
                for (int i = 0; i < 4; ++i) o[(tb * 21 + 16 + i) * 64] = a1[tb][i];
                o[(tb * 21 + 20) * 64] = ss[tb]; } }
        __syncthreads();
        if (wave < r) { const LAS float* o = xch + wave * (84 * 64) + lane;
#pragma unroll
            for (int tb = 0; tb < 4; ++tb) {
#pragma unroll
                for (int i = 0; i < 16; ++i) a0[tb][i] += o[(tb * 21 + i) * 64];
#pragma unroll
                for (int i = 0; i < 4; ++i) a1[tb][i] += o[(tb * 21 + 16 + i) * 64];
                ss[tb] += o[(tb * 21 + 20) * 64]; } }
        __syncthreads();
    }
    if (wave == 0) {
#pragma unroll
        for (int tb = 0; tb < 4; ++tb) {
            const int row = unit * 128 + tb * 32 + r32;
            const f32x16 acc0 = a0[tb], acc1 = a1[tb];
            const float rstd = rsqrtf(halfswap_sum(ss[tb]) * (1.f / DM) + EPS);
            float g[4];
#pragma unroll
            for (int r = 0; r < 4; ++r) { const float v = acc1[r] * rstd; const float o2 = __shfl_xor(v, 32); g[r] = (hi ? o2 : v) + bg[r]; }
            int gsel = 0; float gmax = g[0];
#pragma unroll
            for (int r = 1; r < 4; ++r) if (g[r] > gmax) { gmax = g[r]; gsel = r; }
            float gsum = 0.f;
#pragma unroll
            for (int r = 0; r < 4; ++r) gsum += expf(g[r] - gmax);
            const float gpb = 1.f / gsum;
            float part[4], e[8];
#pragma unroll
            for (int k = 0; k < 4; ++k) part[k] = (gsel == 0 ? acc0[k] : (gsel == 1 ? acc0[4 + k] : (gsel == 2 ? acc0[8 + k] : acc0[12 + k]))) * rstd;
#pragma unroll
            for (int k = 0; k < 4; ++k) { const float o2 = __shfl_xor(part[k], 32); e[k] = hi ? o2 : part[k]; e[4 + k] = hi ? part[k] : o2; }
#pragma unroll
            for (int i = 0; i < 8; ++i) e[i] += be[8 * gsel + i];
            int i1 = 0; float e1 = e[0];
#pragma unroll
            for (int i = 1; i < 8; ++i) if (e[i] > e1) { e1 = e[i]; i1 = i; }
            int i2 = -1; float e2 = -INFINITY;
#pragma unroll
            for (int i = 0; i < 8; ++i) if (i != i1 && e[i] > e2) { e2 = e[i]; i2 = i; }
            const float p2 = expf(e2 - e1), den = 1.f / (1.f + p2);
            if (hi == 0) {
                const int ea = 8 * gsel + i1, eb = 8 * gsel + i2;
                rt_e[2 * row] = ea; rt_e[2 * row + 1] = eb; rt_g[2 * row] = gpb * den; rt_g[2 * row + 1] = gpb * p2 * den; rstd_g[row] = rstd;
                atomicAdd((int*)&hist[ea], 1); atomicAdd((int*)&hist[eb], 1);
            }
        }
    }
    __syncthreads();
    if (tid < 32) cnt_g[unit * 32 + tid] = hist[tid];
    __syncthreads();
}

DI void sort_unit(const int* rt_e, int* rt_d, const float* rstd_g, const int* cnt_g, int* blk_e, int* nblk, int* src, float* rs_sorted, LAS unsigned char* lds, int unit, int tid) {
    const int lane = tid & 63, wave = __builtin_amdgcn_readfirstlane(tid >> 6);
    LAS int* pt = (LAS int*)lds; LAS int* pp = pt + 512; LAS int* tot = pp + 512; LAS int* pre = tot + 32; LAS int* base = pre + 32; LAS int* wc = base + 32; LAS int* est = wc + 128;
    { const int e = tid & 31, grp = tid >> 5; int t = 0, p = 0;
#pragma unroll 4
      for (int i = 0; i < 16; ++i) { const int c = grp * 16 + i; const int v = cnt_g[c * 32 + e]; t += v; p += (c < unit) ? v : 0; }
      pt[tid] = t; pp[tid] = p; }
    int ea = -1;
    if (tid < 256) ea = rt_e[unit * 256 + tid];
    __syncthreads();
    if (tid < 32) { int t = 0, p = 0;
#pragma unroll
        for (int g = 0; g < 16; ++g) { t += pt[g * 32 + tid]; p += pp[g * 32 + tid]; }
        tot[tid] = t; pre[tid] = p; }
    int myrank = 0;
    if (wave < 4) { int mycnt = 0;
        for (int e = 0; e < 32; ++e) { const unsigned long long m = __builtin_amdgcn_ballot_w64(ea == e);
            if (ea == e) myrank = __builtin_popcountll(m & ((1ull << lane) - 1ull));
            if (lane == e) mycnt = __builtin_popcountll(m); }
        if (lane < 32) wc[wave * 32 + lane] = mycnt; }
    __syncthreads();
    if (tid == 0) { int s = 0; for (int e = 0; e < 32; ++e) { const int padded = (tot[e] + 255) & ~255; base[e] = s + pre[e]; est[e] = s;
            if (unit == 0) for (int j = s >> 8; j < ((s + padded) >> 8); ++j) blk_e[j] = e;
            s += padded; }
        if (unit == 0) *nblk = s >> 8; }
    __syncthreads();
    if (tid < 256) { int d = base[ea] + myrank; for (int w = 0; w < wave; ++w) d += wc[w * 32 + ea];
        const int tok = unit * 128 + (tid >> 1);
        rt_d[unit * 256 + tid] = d; src[d] = tok; rs_sorted[d] = rstd_g[tok]; }
    if (unit < 32) { const int e = unit, first = est[e] + tot[e], npad = ((tot[e] + 255) & ~255) - tot[e];
        for (int i = tid; i < npad; i += NTHR) { src[first + i] = 0; rs_sorted[first + i] = 0.f; } }
    __syncthreads();
}

constexpr int NPH = 20;
struct Args { In in; float* out; unsigned char* ws; int ph_lo, ph_hi, li, pad; };
__global__ void __launch_bounds__(NTHR, 2) fwd(Args args) {
    extern __shared__ __attribute__((aligned(16))) unsigned char lds_raw[];
    LAS unsigned char* lds = (LAS unsigned char*)lds_raw;
    const int tid0 = threadIdx.x;
    const int wave0 = __builtin_amdgcn_readfirstlane(tid0 >> 6);
    const int G = gridDim.x;
    unsigned char* ws0 = args.ws; const In& I = args.in;
    gu32* ctl = (gu32*)(ws0 + WS_CTL);
    volatile LAS unsigned* MISC = (volatile LAS unsigned*)(lds + MISC_OFF);
    if (tid0 < 64) MISC[tid0] = 0u;
    __syncthreads();
    XcdBarrier bar = xcd_barrier_post((unsigned*)(ctl + CW_BAR) + args.li * XCD_BAR_WORDS, MISC + 8);
    const int lo = args.ph_lo, hi_ph = args.ph_hi;
#ifndef PHMASK
#define PHMASK 0xFFFFF
#endif
#define IN(k) (lo <= (k) && (k) < hi_ph)
#define EN(j) ((PHMASK >> (j)) & 1)
#ifndef REPMASK
#define REPMASK 0
#endif
#define NREP(j) (1 + ((REPMASK >> (j)) & 1))
#define SEAM(k) do { if (IN(k) && IN((k) + 1)) xcd_barrier(bar); } while (0)
#define PHASE_ENV \
    int tid = wave0 * 64 + (int)__builtin_amdgcn_mbcnt_hi(~0u, __builtin_amdgcn_mbcnt_lo(~0u, 0u)); asm volatile("" : "+v"(tid)); GAS unsigned char* wsg_ = (GAS unsigned char*)ws0; asm volatile("" : "+s"(wsg_)); unsigned char* ws = (unsigned char*)wsg_; \
    const int lane = tid & 63, wave = __builtin_amdgcn_readfirstlane(tid >> 6); const int gw = blockIdx.x * NWAVES + wave, NGW = G * NWAVES; \
    bf16* XA = (bf16*)(ws + WS_XA); float* OUT = (float*)(GAS float*)args.out; bf16* XN = (bf16*)(GAS bf16*)args.out; (void)OUT; bf16* Z = (bf16*)(ws + WS_Z); unsigned char* XS = ws + WS_Z; unsigned char* Y = ws + WS_Z; \
    bf16* MLA = (bf16*)(ws + WS_MLA); unsigned char* H = ws + WS_MLA; unsigned long long* MASK = (unsigned long long*)(ws + WS_MASK); \
    unsigned char* WGU = ws + WS_WGU; unsigned char* WD = ws + WS_WD; const float* par = (const float*)(ws + WS_PAR); \
    int* rt_e = (int*)(ws + WS_ROUTE + RT_E); float* rt_g = (float*)(ws + WS_ROUTE + RT_G); int* rt_d = (int*)(ws + WS_ROUTE + RT_D); \
    int* cnt_g = (int*)(ws + WS_ROUTE + RT_CNT); float* rstd_g = (float*)(ws + WS_ROUTE + RT_RSTD); int* blk_e = (int*)(ws + WS_ROUTE + RT_BLK); int* nblk = (int*)(ws + WS_ROUTE + RT_NBLK); \
    (void)lane; (void)gw; (void)NGW; (void)XA; (void)XN; (void)Z; (void)XS; (void)Y; (void)MLA; (void)H; (void)MASK; (void)WGU; (void)WD; (void)par; (void)rt_e; (void)rt_g; (void)rt_d; (void)cnt_g; (void)rstd_g; (void)blk_e; (void)nblk;

    if (EN(0) && IN(0)) { PHASE_ENV for (int rep = 0; rep < NREP(0); ++rep) prologue_phase(I, ws, lds, gw, NGW, lane, wave); }
    if (!(IN(0) && IN(1))) SEAM(0);
    {
        constexpr int l = 0;
        const int pb = 1 + 9 * l;
        if (EN(1) && IN(pb)) { PHASE_ENV
            if (l == 0) { for (int rep = 0; rep < NREP(1); ++rep) norm_phase<0>(I.x, XA, OUT, XN, I.norm_mix, Y, rt_d, rt_g, gw, NGW, lane); }
            else norm_phase<1>(I.x, XA, OUT, XN, I.norm_mix + DM, Y, rt_d, rt_g, gw, NGW, lane);
        }
        SEAM(pb);
        if (EN(2) && IN(pb + 1)) { PHASE_ENV
            pg8::Gemm g{XN, (const bf16*)(ws + WS_WIN) + (size_t)l * ZP * 1024, 1024, 1024}; pg8::StaticOrder S; S.init(M, ZP, G, (int)blockIdx.x); S.rep = NREP(2);
            pg8::EpiZ E{Z, (bf16*)(ws + WS_KIDX)};
            pg8::gemm_phase<pg8::EpiZ, pg8::StaticOrder, true, true>(lds, g, S, E, tid);
        }
        SEAM(pb + 1);
        if (EN(3) && IN(pb + 2)) { PHASE_ENV
            for (int rep = 0; rep < NREP(3); ++rep) {
            if (!((REPMASK >> 12) & 1) || rep == 0) for (int u = gw; u < 2048; u += NGW) mla_prep_unit(Z, (const bf16*)(ws + WS_WUQ) + (size_t)l * 192 * 256, (const bf16*)(ws + WS_WUKV) + (size_t)l * 384 * 128,
                                                               (const float*)(ws + WS_PAR + PAR_COS), (const float*)(ws + WS_PAR + PAR_SIN), MLA, u, lane);
            for (int i = blockIdx.x * NTHR + tid; i < NB * 256 * 4; i += G * NTHR) { const int b = i >> 10, t = (i >> 2) & 255, j = i & 3; MASK[((size_t)b * SEQ + t) * 64 + j] = ~0ull; }
            { const bf16* KX = (const bf16*)(ws + WS_KIDX); DsaOps cur_, nxt_;
              const int R0 = 9 * G <= 3840 ? 9 : 3840 / G, NST = R0 * G;
              gu32* dctr = ctl + CW_QCTR + 64 * (l + 2 * rep) + 32;
              volatile LAS int* dslot = (volatile LAS int*)(lds + MISC_OFF + 128);
              int it = blockIdx.x, r_ = 0;
              if (R0 == 0) { if (tid == 0) *dslot = (int)__hip_atomic_fetch_add(dctr, 1u, RLX_AGENT); __syncthreads(); it = *dslot; __syncthreads(); }
              if (it < 3840) dsa_load_ops(Z, KX, it, wave, lane, cur_);
              while (it < 3840) {
                  int nx;
                  if (++r_ < R0) nx = it + G;
                  else { if (tid == 0) *dslot = NST + (int)__hip_atomic_fetch_add(dctr, 1u, RLX_AGENT); __syncthreads(); nx = *dslot; }
                  dsa_load_ops(Z, KX, nx < 3840 ? nx : it, wave, lane, nxt_); dsa_select_item(Z, KX, MASK, lds, cur_, it, tid); cur_ = nxt_; it = nx; } }
            }
        }
        SEAM(pb + 2);
        if (EN(4) && IN(pb + 3)) { PHASE_ENV for (int rep = 0; rep < NREP(4); ++rep) attn_phase(Z, MLA, XN, MASK, (unsigned*)(ws + WS_O0), par, I.diff_subln, l, ctl + CW_QCTR + 64 * (l + 2 * rep),
                I.w_gate + (size_t)l * NEXP * 1024 * 512, I.w_up + (size_t)l * NEXP * 1024 * 512, I.w_down + (size_t)l * NEXP * 512 * 1024, WGU, WD, lds, tid); }
        SEAM(pb + 3);
        if (EN(5) && IN(pb + 4)) { PHASE_ENV
            pg8::Gemm g{XN, (const bf16*)(ws + WS_WOUT) + (size_t)l * 1024 * 1024, 1024, 1024}; pg8::StaticOrder S; S.init(M, DM, G, (int)blockIdx.x); S.rep = NREP(5);
            pg8::EpiRes<(l != 0)> E{l == 0 ? (const void*)I.x : (const void*)XA, XA, I.norm_ffn + l * DM, ws + WS_XT};
            pg8::gemm_phase<pg8::EpiRes<(l != 0)>, pg8::StaticOrder, true, true>(lds, g, S, E, tid);
        }
        SEAM(pb + 4);
        if (EN(6) && IN(pb + 5)) { PHASE_ENV for (int rep = 0; rep < NREP(6); ++rep) for (int u = blockIdx.x; u < 256; u += G)
            router_unit(XA, (const bf16*)(ws + WS_WR) + (size_t)l * 2 * 64 * 1024, I.b_group + l * 4, I.b_expert + l * 32, rt_e, rt_g, rstd_g, cnt_g, lds, u, tid); }
        SEAM(pb + 5);
        if (EN(7) && IN(pb + 6)) { PHASE_ENV for (int rep = 0; rep < NREP(7); ++rep) for (int u = blockIdx.x; u < 256; u += G) sort_unit(rt_e, rt_d, rstd_g, cnt_g, blk_e, nblk, (int*)(ws + WS_SRC), (float*)(ws + WS_RS), lds, u, tid); }
        SEAM(pb + 6);
        if (EN(8) && IN(pb + 7)) { PHASE_ENV
            pg8::Gemm g{ws + WS_XT, WGU, 1024, 1024}; pg8::MoeOrder S{blk_e, *nblk * 4, G, (int)blockIdx.x, NREP(8), (const int*)(ws + WS_SRC)};
            pg8::EpiGU E{H, (const float*)(ws + WS_RS)};
            pg8::gemm_phase<pg8::EpiGU, pg8::MoeOrder, true, true, 1, true>(lds, g, S, E, tid);
        }
        SEAM(pb + 7);
        if (EN(9) && IN(pb + 8)) { PHASE_ENV
            pg8::Gemm g{H, WD, 512, 512}; pg8::MoeOrder S{blk_e, *nblk * 4, G, (int)blockIdx.x, NREP(9)};
            pg8::EpiF8A E{Y, DM, 16.f / 256.f};
            pg8::gemm_phase<pg8::EpiF8A, pg8::MoeOrder, true, true, 1, false, true>(lds, g, S, E, tid);
        }
        SEAM(pb + 8);
    }
    {
        constexpr int l = 1;
        const int pb = 1 + 9 * l;
        if (EN(1) && IN(pb)) { PHASE_ENV
            if (l == 0) { for (int rep = 0; rep < NREP(1); ++rep) norm_phase<0>(I.x, XA, OUT, XN, I.norm_mix, Y, rt_d, rt_g, gw, NGW, lane); }
            else norm_phase<1>(I.x, XA, OUT, XN, I.norm_mix + DM, Y, rt_d, rt_g, gw, NGW, lane);
        }
        SEAM(pb);
        if (EN(2) && IN(pb + 1)) { PHASE_ENV
            pg8::Gemm g{XN, (const bf16*)(ws + WS_WIN) + (size_t)l * ZP * 1024, 1024, 1024}; pg8::StaticOrder S; S.init(M, ZP, G, (int)blockIdx.x); S.rep = NREP(2);
            pg8::EpiZ E{Z, (bf16*)(ws + WS_KIDX)};
            pg8::gemm_phase<pg8::EpiZ, pg8::StaticOrder, true, true>(lds, g, S, E, tid);
        }
        SEAM(pb + 1);
        if (EN(3) && IN(pb + 2)) { PHASE_ENV
            for (int rep = 0; rep < NREP(3); ++rep) {
            if (!((REPMASK >> 12) & 1) || rep == 0) for (int u = gw; u < 2048; u += NGW) mla_prep_unit(Z, (const bf16*)(ws + WS_WUQ) + (size_t)l * 192 * 256, (const bf16*)(ws + WS_WUKV) + (size_t)l * 384 * 128,
                                                               (const float*)(ws + WS_PAR + PAR_COS), (const float*)(ws + WS_PAR + PAR_SIN), MLA, u, lane);
            for (int i = blockIdx.x * NTHR + tid; i < NB * 256 * 4; i += G * NTHR) { const int b = i >> 10, t = (i >> 2) & 255, j = i & 3; MASK[((size_t)b * SEQ + t) * 64 + j] = ~0ull; }
            { const bf16* KX = (const bf16*)(ws + WS_KIDX); DsaOps cur_, nxt_;
              const int R0 = 9 * G <= 3840 ? 9 : 3840 / G, NST = R0 * G;
              gu32* dctr = ctl + CW_QCTR + 64 * (l + 2 * rep) + 32;
              volatile LAS int* dslot = (volatile LAS int*)(lds + MISC_OFF + 128);
              int it = blockIdx.x, r_ = 0;
              if (R0 == 0) { if (tid == 0) *dslot = (int)__hip_atomic_fetch_add(dctr, 1u, RLX_AGENT); __syncthreads(); it = *dslot; __syncthreads(); }
              if (it < 3840) dsa_load_ops(Z, KX, it, wave, lane, cur_);
              while (it < 3840) {
                  int nx;
                  if (++r_ < R0) nx = it + G;
                  else { if (tid == 0) *dslot = NST + (int)__hip_atomic_fetch_add(dctr, 1u, RLX_AGENT); __syncthreads(); nx = *dslot; }
                  dsa_load_ops(Z, KX, nx < 3840 ? nx : it, wave, lane, nxt_); dsa_select_item(Z, KX, MASK, lds, cur_, it, tid); cur_ = nxt_; it = nx; } }
            }
        }
        SEAM(pb + 2);
        if (EN(4) && IN(pb + 3)) { PHASE_ENV for (int rep = 0; rep < NREP(4); ++rep) attn_phase(Z, MLA, XN, MASK, (unsigned*)(ws + WS_O0), par, I.diff_subln, l, ctl + CW_QCTR + 64 * (l + 2 * rep),
                I.w_gate + (size_t)l * NEXP * 1024 * 512, I.w_up + (size_t)l * NEXP * 1024 * 512, I.w_down + (size_t)l * NEXP * 512 * 1024, WGU, WD, lds, tid); }
        SEAM(pb + 3);
        if (EN(5) && IN(pb + 4)) { PHASE_ENV
            pg8::Gemm g{XN, (const bf16*)(ws + WS_WOUT) + (size_t)l * 1024 * 1024, 1024, 1024}; pg8::StaticOrder S; S.init(M, DM, G, (int)blockIdx.x); S.rep = NREP(5);
            pg8::EpiRes<(l != 0)> E{l == 0 ? (const void*)I.x : (const void*)XA, XA, I.norm_ffn + l * DM, ws + WS_XT};
            pg8::gemm_phase<pg8::EpiRes<(l != 0)>, pg8::StaticOrder, true, true>(lds, g, S, E, tid);
        }
        SEAM(pb + 4);
        if (EN(6) && IN(pb + 5)) { PHASE_ENV for (int rep = 0; rep < NREP(6); ++rep) for (int u = blockIdx.x; u < 256; u += G)
            router_unit(XA, (const bf16*)(ws + WS_WR) + (size_t)l * 2 * 64 * 1024, I.b_group + l * 4, I.b_expert + l * 32, rt_e, rt_g, rstd_g, cnt_g, lds, u, tid); }
        SEAM(pb + 5);
        if (EN(7) && IN(pb + 6)) { PHASE_ENV for (int rep = 0; rep < NREP(7); ++rep) for (int u = blockIdx.x; u < 256; u += G) sort_unit(rt_e, rt_d, rstd_g, cnt_g, blk_e, nblk, (int*)(ws + WS_SRC), (float*)(ws + WS_RS), lds, u, tid); }
        SEAM(pb + 6);
        if (EN(8) && IN(pb + 7)) { PHASE_ENV
            pg8::Gemm g{ws + WS_XT, WGU, 1024, 1024}; pg8::MoeOrder S{blk_e, *nblk * 4, G, (int)blockIdx.x, NREP(8), (const int*)(ws + WS_SRC)};
            pg8::EpiGU E{H, (const float*)(ws + WS_RS)};
            pg8::gemm_phase<pg8::EpiGU, pg8::MoeOrder, true, true, 1, true>(lds, g, S, E, tid);
        }
        SEAM(pb + 7);
        if (EN(9) && IN(pb + 8)) { PHASE_ENV
            pg8::Gemm g{H, WD, 512, 512}; pg8::MoeOrder S{blk_e, *nblk * 4, G, (int)blockIdx.x, NREP(9)};
            pg8::EpiF8A E{Y, DM, 16.f / 256.f};
            pg8::gemm_phase<pg8::EpiF8A, pg8::MoeOrder, true, true, 1, false, true>(lds, g, S, E, tid);
        }
        SEAM(pb + 8);
    }
    if (EN(10) && IN(19)) { PHASE_ENV norm_phase<2>(I.x, XA, OUT, XN, I.norm_final, Y, rt_d, rt_g, gw, NGW, lane); }
#undef IN
#undef SEAM
}

#ifndef MK_SPLIT
#define MK_SPLIT 0
#endif
extern "C" void kernel_launch(void* const* d_in, const int* in_sizes, int n_in, void* d_out, int out_size, void* d_ws, size_t ws_size, hipStream_t stream) {
    static int grid = 0;
    if (grid == 0) {
        if (n_in != 23 || out_size != M * DM || ws_size < WS_END) { fprintf(stderr, "kernel_launch: unexpected shapes (n_in %d out %d ws %zu)\n", n_in, out_size, ws_size); grid = -1; return; }
        int dev = 0, cus = 0, per_cu = 0;
        if (hipGetDevice(&dev) != hipSuccess || hipDeviceGetAttribute(&cus, hipDeviceAttributeMultiprocessorCount, dev) != hipSuccess) { grid = -1; return; }
        if (hipFuncSetAttribute((const void*)fwd, hipFuncAttributeMaxDynamicSharedMemorySize, LDS_BYTES) != hipSuccess) { fprintf(stderr, "kernel_launch: hipFuncSetAttribute failed\n"); grid = -1; return; }
        if (hipOccupancyMaxActiveBlocksPerMultiprocessor(&per_cu, (const void*)fwd, NTHR, LDS_BYTES) != hipSuccess || per_cu < 1) { fprintf(stderr, "kernel_launch: occupancy query says %d\n", per_cu); }
        (void)hipGetLastError();
        grid = cus;
    }
    if (grid < 0) return;
    (void)hipMemsetAsync((char*)d_ws + WS_CTL, 0, CTL_ZERO_BYTES, stream);
    Args a{};
    const float** ip = (const float**)&a.in;
    for (int i = 0; i < 23; ++i) ip[i] = (const float*)d_in[i];
    a.out = (float*)d_out; a.ws = (unsigned char*)d_ws;
#if MK_SPLIT
    for (int p = 0; p < NPH; ++p) { a.ph_lo = p; a.ph_hi = p + 1; a.li = p; hipLaunchKernelGGL(fwd, dim3(grid), dim3(NTHR), LDS_BYTES, stream, a); }
#else
    a.ph_lo = 0; a.ph_hi = NPH; a.li = 0;
    hipLaunchKernelGGL(fwd, dim3(grid), dim3(NTHR), LDS_BYTES, stream, a);
#endif
}
```

```cpp
#include <hip/hip_runtime.h>
#include <cstdio>
#include <cstdint>

#define GAS __attribute__((address_space(1)))
#define LAS __attribute__((address_space(3)))
typedef unsigned short bf16;
typedef short bf16x8 __attribute__((ext_vector_type(8)));
typedef short s16x4 __attribute__((ext_vector_type(4)));
typedef float f32x2 __attribute__((ext_vector_type(2)));
typedef float f32x4 __attribute__((ext_vector_type(4)));
typedef float f32x16 __attribute__((ext_vector_type(16)));
typedef unsigned u32x2 __attribute__((ext_vector_type(2)));
typedef unsigned u32x4 __attribute__((ext_vector_type(4)));
typedef __bf16 bf16x2_t __attribute__((ext_vector_type(2)));
typedef short v4i16_t __attribute__((ext_vector_type(4)));
typedef GAS unsigned gu32;
#define RLX_AGENT __ATOMIC_RELAXED, __HIP_MEMORY_SCOPE_AGENT
#define DI __device__ __forceinline__

constexpr int NB = 8, SEQ = 4096, DM = 1024, M = NB * SEQ;
constexpr int DIN = 3000, ZP = 3072;
constexpr int Z_AQ = 0, Z_AK = 512, Z_AV = 1024, Z_BQ = 1536, Z_BK = 1792, Z_BV = 2048, Z_IQ = 2304, Z_IK = 2560, Z_IW = 2592, Z_CQ = 2600, Z_CKV = 2856, Z_CKR = 2984;
constexpr int NEXP = 32, DEXP = 512, MAXROWS = 2 * M + NEXP * 256;
constexpr int MLAP = 768;
constexpr float EPS = 1e-6f, LOG2E = 1.4426950408889634f;
constexpr int NWAVES = 8, NTHR = 512;

constexpr size_t MiB = 1u << 20;
constexpr size_t WS_CTL = 0, CTL_ZERO_BYTES = 1 * MiB;
constexpr size_t WS_PAR = 1 * MiB;
constexpr size_t WS_WIN = 2 * MiB;
constexpr size_t WS_WOUT = 14 * MiB;
constexpr size_t WS_WUQ = 18 * MiB;
constexpr size_t WS_WUKV = WS_WUQ + 256 * 1024;
constexpr size_t WS_WR = WS_WUQ + 512 * 1024;
constexpr size_t WS_ROUTE = 19 * MiB;
constexpr size_t WS_WGU = 20 * MiB;
constexpr size_t WS_WD = 84 * MiB;
constexpr size_t WS_XA = 116 * MiB;
constexpr size_t WS_XN = 116 * MiB;
constexpr size_t WS_Z = 180 * MiB;
constexpr size_t WS_MLA = 372 * MiB;
constexpr size_t WS_MASK = 444 * MiB;
constexpr size_t WS_KIDX = 460 * MiB;
constexpr size_t WS_O0 = 462 * MiB;
constexpr size_t WS_XT = WS_Z + 128 * MiB;
constexpr size_t WS_SRC = WS_Z + 176 * MiB;
constexpr size_t WS_RS = WS_Z + 177 * MiB;
constexpr size_t WS_END = 478 * MiB;
constexpr size_t PAR_LAM = 0, PAR_LUT = 256, PAR_ORD = 8704, PAR_COS = 16384, PAR_SIN = 16384 + 131072;
constexpr size_t RT_E = 0, RT_G = 262144, RT_D = 524288, RT_CNT = 786432, RT_BLK = 786432 + 32768, RT_NBLK = 786432 + 36864, RT_RSTD = 786432 + 65536;
constexpr int CW_BAR = 4096;
constexpr int CW_QCTR = 200000;
constexpr int RING_BYTES = 131072, AUX_OFF = RING_BYTES, AUX_BYTES = 8192, MISC_OFF = AUX_OFF + AUX_BYTES, PARK_A = 81920, PARK_B = MISC_OFF + 256, LDS_BYTES = PARK_B + 16384;

DI float bf2f(bf16 v) { return __builtin_bit_cast(float, (unsigned)v << 16); }
DI unsigned cvtpk(float lo, float hi) { f32x2 v = {lo, hi}; bf16x2_t b = __builtin_convertvector(v, bf16x2_t); return __builtin_bit_cast(unsigned, b); }
DI bf16 f2bf(float f) { return (bf16)(cvtpk(f, 0.f) & 0xffffu); }
DI float wave_sum(float v) {
#pragma unroll
    for (int o = 1; o < 64; o <<= 1) v += __shfl_xor(v, o);
    return v;
}
DI float halfswap_max(float m) { auto rr = __builtin_amdgcn_permlane32_swap(__float_as_uint(m), __float_as_uint(m), false, false); return fmaxf(__uint_as_float(rr[0]), __uint_as_float(rr[1])); }
DI float halfswap_sum(float m) { auto rr = __builtin_amdgcn_permlane32_swap(__float_as_uint(m), __float_as_uint(m), false, false); return __uint_as_float(rr[0]) + __uint_as_float(rr[1]); }
#define MFMA32(a, b, c) __builtin_amdgcn_mfma_f32_32x32x16_bf16((a), (b), (c), 0, 0, 0)
namespace pg8 {
#define PG8_LAS __attribute__((address_space(3)))
typedef unsigned short bf16_t;
constexpr int BM = 256, BK = 64, HALF = 128, HTB = HALF * BK * 2  , STAGE_BYTES = 8 * HTB, NXCD = 8, WGM = 8;

__host__ __device__ __forceinline__ int lds_byte(int r, int c) { const int st = (r >> 4) * 2 + (c >> 5), rr = r & 15, cc = c & 31, ob = rr * 64 + cc * 2; return st * 1024 + (ob ^ (((ob >> 9) & 1) << 5)); }
__host__ __device__ __forceinline__ void stage_rc(int b, int& R, int& C) { const int st = b / 1024, sb = b % 1024, swz = sb ^ (((sb >> 9) & 1) << 5); R = (st >> 1) * 16 + swz / 64; C = (st & 1) * 32 + (swz % 64) / 2; }
__host__ __device__ __forceinline__ int perm32(int rho) { const int n = rho >> 4, i = rho & 15; return 8 * (i >> 2) + 4 * n + (i & 3); }

struct Unit { int pm, pn, pb; };
struct Gemm { const void* A; const void* Bt; int lda, K; };

struct StaticOrder {
    static constexpr const int* src = nullptr;
    int nM, nN, nwg, G, c, rep = 1;
    __host__ __device__ void init(int M_, int N_, int G_, int c_) { nM = M_ / BM; nN = N_ / BM; nwg = nM * nN; G = G_; c = c_; }
    __host__ __device__ bool next(int i, Unit& u) const {
        if (rep > 1) { const int cntU = c < nwg ? (nwg - c + G - 1) / G : 0; if (i >= cntU * rep) return false; i %= cntU; }
        const long L = (long)i * G + c; if (L >= nwg) return false;
        int wgid = (int)L; { const int q = nwg / NXCD, r = nwg % NXCD, xcd = wgid % NXCD, off = wgid / NXCD; wgid = (xcd < r ? xcd * (q + 1) : r * (q + 1) + (xcd - r) * q) + off; }
        const int nig = WGM * nN, gid = wgid / nig, fm = gid * WGM, gsz = (nM - fm) < WGM ? (nM - fm) : WGM;
        u.pm = fm + ((wgid % nig) % gsz); u.pn = (wgid % nig) / gsz; u.pb = u.pn; return true;
    }
    __device__ __forceinline__ void a_ready(const Unit&) const {}
    __device__ __forceinline__ void done(const Unit&) const {}
};
struct MoeOrder {
    const int* blk_e; int nunits, G, c, rep = 1; const int* src = nullptr;
    __device__ __forceinline__ bool next(int i, Unit& u) const {
        if (rep > 1) { const int cntU = c < nunits ? (nunits - c + G - 1) / G : 0; if (i >= cntU * rep) return false; i %= cntU; }
        int pm, pn;
        if ((G & 31) == 0) { const int x = c & 7, j = c >> 3, rpx = G >> 5; pm = i * (G >> 2) + x * rpx + (j >> 2); pn = j & 3; }
        else { const int L = i * G + c; pm = L >> 2; pn = L & 3; }
        if (pm * 4 >= nunits) return false;
        u.pm = pm; u.pn = pn; u.pb = blk_e[pm] * 4 + pn; return true;
    }
    __device__ __forceinline__ void a_ready(const Unit&) const {}
    __device__ __forceinline__ void done(const Unit&) const {}
};

struct EpiBf16 {
    static constexpr bool PERM = true, AFTER_DRAIN = false;
    bf16_t* O; int ldc; float scale = 1.f;
    __device__ __forceinline__ void operator()(const f32x4 (&acc)[2][2][4][2], const Unit& u, int wr, int wc, int fr, int fq) const {
        const int row0 = u.pm * BM + wr * 64 + fr, col0 = u.pn * BM + wc * 32 + 8 * fq;
#pragma unroll
        for (int ai = 0; ai < 2; ++ai)
#pragma unroll
            for (int m = 0; m < 4; ++m) { bf16_t* rowp = O + (size_t)(row0 + ai * HALF + m * 16) * ldc + col0;
#pragma unroll
                for (int bj = 0; bj < 2; ++bj) { const f32x4 v0 = acc[ai][bj][m][0] * scale, v1 = acc[ai][bj][m][1] * scale;
                    u32x4 w; w.x = cvtpk(v0[0], v0[1]); w.y = cvtpk(v0[2], v0[3]); w.z = cvtpk(v1[0], v1[1]); w.w = cvtpk(v1[2], v1[3]);
                    *(u32x4*)(rowp + bj * HALF) = w; } }
    }
};
struct EpiF8 {
    static constexpr bool PERM = true, AFTER_DRAIN = false;
    unsigned char* O; int ldc; float scale;
    __device__ __forceinline__ void operator()(const f32x4 (&acc)[2][2][4][2], const Unit& u, int wr, int wc, int fr, int fq) const {
        const int row0 = u.pm * BM + wr * 64 + fr, col0 = u.pn * BM + wc * 32 + 8 * fq;
#pragma unroll
        for (int ai = 0; ai < 2; ++ai)
#pragma unroll
            for (int m = 0; m < 4; ++m) { unsigned char* rowp = O + (size_t)(row0 + ai * HALF + m * 16) * ldc + col0;
#pragma unroll
                for (int bj = 0; bj < 2; ++bj) { float h[8];
#pragma unroll
                    for (int n = 0; n < 2; ++n)
#pragma unroll
                        for (int e = 0; e < 4; ++e) h[4 * n + e] = __builtin_amdgcn_fmed3f(acc[ai][bj][m][n][e] * scale, -448.f, 448.f);
                    int w0 = 0, w1 = 0;
                    w0 = __builtin_amdgcn_cvt_pk_fp8_f32(h[0], h[1], w0, false); w0 = __builtin_amdgcn_cvt_pk_fp8_f32(h[2], h[3], w0, true);
                    w1 = __builtin_amdgcn_cvt_pk_fp8_f32(h[4], h[5], w1, false); w1 = __builtin_amdgcn_cvt_pk_fp8_f32(h[6], h[7], w1, true);
                    u32x2 w; w.x = (unsigned)w0; w.y = (unsigned)w1; *(u32x2*)(rowp + bj * HALF) = w; } }
    }
};
struct EpiF8A {
    static constexpr bool PERM = true, AFTER_DRAIN = false;
    unsigned char* O; int ldc; float scale;
    __device__ __forceinline__ void operator()(const f32x4 (&acc)[2][2][4][2], const Unit& u, int wr, int wc, int fr, int fq) const {
        const int row0 = u.pm * BM + wr * 64 + fr, col0 = u.pn * BM + wc * 64 + 16 * fq;
#pragma unroll
        for (int ai = 0; ai < 2; ++ai)
#pragma unroll
            for (int m = 0; m < 4; ++m) { unsigned char* rowp = O + (size_t)(row0 + ai * HALF + m * 16) * ldc + col0; u32x4 w;
#pragma unroll
                for (int bj = 0; bj < 2; ++bj) { float h[8];
#pragma unroll
                    for (int n = 0; n < 2; ++n)
#pragma unroll
                        for (int e = 0; e < 4; ++e) h[4 * n + e] = __builtin_amdgcn_fmed3f(acc[ai][bj][m][n][e] * scale, -448.f, 448.f);
                    int w0 = 0, w1 = 0;
                    w0 = __builtin_amdgcn_cvt_pk_fp8_f32(h[0], h[1], w0, false); w0 = __builtin_amdgcn_cvt_pk_fp8_f32(h[2], h[3], w0, true);
                    w1 = __builtin_amdgcn_cvt_pk_fp8_f32(h[4], h[5], w1, false); w1 = __builtin_amdgcn_cvt_pk_fp8_f32(h[6], h[7], w1, true);
                    w[2 * bj] = (unsigned)w0; w[2 * bj + 1] = (unsigned)w1; }
                *(u32x4*)rowp = w; }
    }
};
struct EpiZ {
    static constexpr bool PERM = true, AFTER_DRAIN = false;
    bf16_t* O; bf16_t* KIDX;
    __device__ __forceinline__ void operator()(const f32x4 (&acc)[2][2][4][2], const Unit& u, int wr, int wc, int fr, int fq) const {
        const int row0 = u.pm * BM + wr * 64 + fr, col0 = u.pn * BM + wc * 32 + 8 * fq;
        const bool kx = (u.pn == 10) && (wc == 0);
#pragma unroll
        for (int ai = 0; ai < 2; ++ai)
#pragma unroll
            for (int m = 0; m < 4; ++m) { const int row = row0 + ai * HALF + m * 16; bf16_t* rowp = O + (size_t)row * 3072 + col0;
#pragma unroll
                for (int bj = 0; bj < 2; ++bj) { const f32x4 v0 = acc[ai][bj][m][0], v1 = acc[ai][bj][m][1];
                    u32x4 w; w.x = cvtpk(v0[0], v0[1]); w.y = cvtpk(v0[2], v0[3]); w.z = cvtpk(v1[0], v1[1]); w.w = cvtpk(v1[2], v1[3]);
                    *(u32x4*)(rowp + bj * HALF) = w;
                    if (bj == 0 && kx) *(u32x4*)(KIDX + (size_t)row * 32 + 8 * fq) = w; } }
    }
};
template <bool BASE16>
struct EpiRes {
    static constexpr bool PERM = true, AFTER_DRAIN = false;
    const void* base; bf16_t* out; const float* gain; unsigned char* XT;
    __device__ __forceinline__ void operator()(const f32x4 (&acc)[2][2][4][2], const Unit& u, int wr, int wc, int fr, int fq) const {
        const int row0 = u.pm * BM + wr * 64 + fr, col0 = u.pn * BM + wc * 32 + 8 * fq;
        f32x4 gn[2][2];
#pragma unroll
        for (int bj = 0; bj < 2; ++bj) { gn[bj][0] = *(const f32x4*)(gain + col0 + bj * HALF); gn[bj][1] = *(const f32x4*)(gain + col0 + bj * HALF + 4); }
#pragma unroll
        for (int ai = 0; ai < 2; ++ai)
#pragma unroll
            for (int m = 0; m < 4; ++m) { const size_t off = (size_t)(row0 + ai * HALF + m * 16) * 1024 + col0;
#pragma unroll
                for (int bj = 0; bj < 2; ++bj) { f32x4 b0, b1;
                    if constexpr (BASE16) { const u32x4 bw = *(const u32x4*)((const bf16_t*)base + off + bj * HALF);
                        b0 = (f32x4){__uint_as_float(bw.x << 16), __uint_as_float(bw.x & 0xffff0000u), __uint_as_float(bw.y << 16), __uint_as_float(bw.y & 0xffff0000u)};
                        b1 = (f32x4){__uint_as_float(bw.z << 16), __uint_as_float(bw.z & 0xffff0000u), __uint_as_float(bw.w << 16), __uint_as_float(bw.w & 0xffff0000u)}; }
                    else { b0 = *(const f32x4*)((const float*)base + off + bj * HALF); b1 = *(const f32x4*)((const float*)base + off + bj * HALF + 4); }
                    const f32x4 o0 = b0 + acc[ai][bj][m][0], o1 = b1 + acc[ai][bj][m][1];
                    { u32x4 ow; ow.x = cvtpk(o0[0], o0[1]); ow.y = cvtpk(o0[2], o0[3]); ow.z = cvtpk(o1[0], o1[1]); ow.w = cvtpk(o1[2], o1[3]); *(u32x4*)(out + off + bj * HALF) = ow; }
                    const f32x4 t0 = o0 * gn[bj][0], t1 = o1 * gn[bj][1]; int w0 = 0, w1 = 0;
                    w0 = __builtin_amdgcn_cvt_pk_fp8_f32(t0[0], t0[1], w0, false); w0 = __builtin_amdgcn_cvt_pk_fp8_f32(t0[2], t0[3], w0, true);
                    w1 = __builtin_amdgcn_cvt_pk_fp8_f32(t1[0], t1[1], w1, false); w1 = __builtin_amdgcn_cvt_pk_fp8_f32(t1[2], t1[3], w1, true);
                    u32x2 w8; w8.x = (unsigned)w0; w8.y = (unsigned)w1; *(u32x2*)(XT + off + bj * HALF) = w8; } }
    }
};
struct EpiGU {
    static constexpr bool PERM = true, AFTER_DRAIN = false;
    unsigned char* H; const float* RS;
    __device__ __forceinline__ void operator()(const f32x4 (&acc)[2][2][4][2], const Unit& u, int wr, int wc, int fr, int fq) const {
        const int row0 = u.pm * BM + wr * 64 + fr, col0 = u.pn * HALF + wc * 32 + 8 * fq;
        float rs[2][4];
#pragma unroll
        for (int ai = 0; ai < 2; ++ai)
#pragma unroll
            for (int m = 0; m < 4; ++m) rs[ai][m] = RS[row0 + ai * HALF + m * 16] * 0.03125f;
#pragma unroll
        for (int ai = 0; ai < 2; ++ai)
#pragma unroll
            for (int m = 0; m < 4; ++m) { unsigned char* rowp = H + (size_t)(row0 + ai * HALF + m * 16) * 512 + col0;
                float h[8];
#pragma unroll
                for (int n = 0; n < 2; ++n)
#pragma unroll
                    for (int e = 0; e < 4; ++e) { const float g = acc[ai][0][m][n][e] * rs[ai][m], up = acc[ai][1][m][n][e] * rs[ai][m];
                        const float hv = 8.f * g * __builtin_amdgcn_rcpf(1.f + __builtin_amdgcn_exp2f(-g * 1.4426950408889634f)) * up;
                        h[4 * n + e] = __builtin_amdgcn_fmed3f(hv, -448.f, 448.f); }
                int w0 = 0, w1 = 0;
                w0 = __builtin_amdgcn_cvt_pk_fp8_f32(h[0], h[1], w0, false); w0 = __builtin_amdgcn_cvt_pk_fp8_f32(h[2], h[3], w0, true);
                w1 = __builtin_amdgcn_cvt_pk_fp8_f32(h[4], h[5], w1, false); w1 = __builtin_amdgcn_cvt_pk_fp8_f32(h[6], h[7], w1, true);
                u32x2 w; w.x = (unsigned)w0; w.y = (unsigned)w1; *(u32x2*)rowp = w; }
    }
};

template <class Epi, class Sched, bool ALIGN_EPI = false, bool SP2 = false, int ESZ = 2  ,
          bool GATHER = false  ,
          bool BADJ = false  >
__device__ __forceinline__ void gemm_phase(PG8_LAS unsigned char* lds, const Gemm g, const Sched& S, const Epi& E, const int tid) {
    const int wid = __builtin_amdgcn_readfirstlane(tid >> 6), lane = tid & 63, wr = wid >> 2, wc = wid & 3, fr = lane & 15, fq = lane >> 4;
    const int K = g.K, nt = K * ESZ / (BK * 2);
    unsigned voffA[2], voffB[2], colA[2]; int rowA[2];
#pragma unroll
    for (int i = 0; i < 2; ++i) { int R, C; stage_rc(tid * 16 + i * 8192, R, C); const int c32_ = perm32(R & 31);
        const int Rb = BADJ ? (64 * (R >> 5) + 16 * (c32_ >> 3) + (c32_ & 7)) : (Epi::PERM ? ((R & ~31) + c32_) : R);
        voffA[i] = (unsigned)(R * g.lda * ESZ + C * 2); voffB[i] = (unsigned)(Rb * K * ESZ + C * 2); rowA[i] = R; colA[i] = (unsigned)(C * 2); }
    unsigned vgc[2][2], vgn[2][2];
#define PG8_SRC(u, vg) do { _Pragma("unroll") for (int h_ = 0; h_ < 2; ++h_) _Pragma("unroll") for (int i_ = 0; i_ < 2; ++i_) \
        vg[h_][i_] = (unsigned)S.src[(u).pm * BM + h_ * HALF + rowA[i_]] * (unsigned)(g.lda * ESZ) + colA[i_]; } while (0)
#define PG8_STAGE_A(bufoff, gbase, h, VG) do { if constexpr (GATHER) PG8_STAGE(bufoff, gbase, VG[h]); else PG8_STAGE(bufoff, (gbase) + (h) * hstepA, voffA); } while (0)
    const size_t kstep = (size_t)(BK * 2);
    const size_t hstepA = (size_t)HALF * g.lda * ESZ, hstepB = (size_t)(BADJ ? 8 : HALF) * K * ESZ;
    const size_t tstepA = 2 * hstepA, tstepB = (size_t)BM * K * ESZ;
    const unsigned ldsw = (unsigned)wid * 1024u;
    const int aoff = lds_byte(wr * 64 + fr, fq * 8), boff = lds_byte(wc * 32 + fr, fq * 8);
#define PG8_SA(b, h) (((b) * 2 + (h)) * HTB)
#define PG8_SB(b, h) ((4 + (b) * 2 + (h)) * HTB)
#define PG8_STAGE(bufoff, gbase, voff) do { _Pragma("unroll") for (int _i = 0; _i < 2; ++_i) \
        __builtin_amdgcn_global_load_lds((const unsigned*)((const char*)(gbase) + (voff)[_i]), (PG8_LAS unsigned*)(lds + (bufoff) + ldsw + _i * 8192), 16, 0, 0); } while (0)
#define PG8_LDA(dst, b, h) do { _Pragma("unroll") for (int m = 0; m < 4; ++m) { if constexpr (ESZ == 2) { _Pragma("unroll") for (int k = 0; k < 2; ++k) dst[m][k] = *(const PG8_LAS bf16x8*)(lds + PG8_SA(b, h) + aoff + m * 2048 + k * 1024); } \
        else { const u32x4 lo_ = *(const PG8_LAS u32x4*)(lds + PG8_SA(b, h) + aoff + m * 2048), hi_ = *(const PG8_LAS u32x4*)(lds + PG8_SA(b, h) + aoff + m * 2048 + 1024); dst##8[m] = __builtin_shufflevector(lo_, hi_, 0, 1, 2, 3, 4, 5, 6, 7); } } } while (0)
#define PG8_LDB(dst, b, h) do { _Pragma("unroll") for (int n = 0; n < 2; ++n) { if constexpr (ESZ == 2) { _Pragma("unroll") for (int k = 0; k < 2; ++k) dst[n][k] = *(const PG8_LAS bf16x8*)(lds + PG8_SB(b, h) + boff + n * 2048 + k * 1024); } \
        else { const u32x4 lo_ = *(const PG8_LAS u32x4*)(lds + PG8_SB(b, h) + boff + n * 2048), hi_ = *(const PG8_LAS u32x4*)(lds + PG8_SB(b, h) + boff + n * 2048 + 1024); dst##8[n] = __builtin_shufflevector(lo_, hi_, 0, 1, 2, 3, 4, 5, 6, 7); } } } while (0)
#define PG8_MMA(ai, bj, At, Bt) do { __builtin_amdgcn_s_setprio(1); _Pragma("unroll") for (int m = 0; m < 4; ++m) _Pragma("unroll") for (int n = 0; n < 2; ++n) { \
        if constexpr (ESZ == 2) { _Pragma("unroll") for (int k = 0; k < 2; ++k) acc[ai][bj][m][n] = __builtin_amdgcn_mfma_f32_16x16x32_bf16(Bt[n][k], At[m][k], acc[ai][bj][m][n], 0, 0, 0); } \
        else acc[ai][bj][m][n] = __builtin_amdgcn_mfma_scale_f32_16x16x128_f8f6f4(__builtin_bit_cast(v8i_t, Bt##8[n]), __builtin_bit_cast(v8i_t, At##8[m]), acc[ai][bj][m][n], 0, 0, 0, 0, 0, 0); } \
        __builtin_amdgcn_s_setprio(0); if constexpr (ESZ == 1) { _Pragma("unroll") for (int m = 0; m < 4; ++m) _Pragma("unroll") for (int n = 0; n < 2; ++n) asm volatile("" : "+v"(acc[ai][bj][m][n])); } } while (0)
#define PG8_WAIT_V(n) asm volatile("s_waitcnt vmcnt(" #n ")" ::: "memory")
#define PG8_WAIT_L(n) asm volatile("s_waitcnt lgkmcnt(" #n ")" ::: "memory")
#define PG8_BAR __builtin_amdgcn_s_barrier()
#define PG8_SCHED __builtin_amdgcn_sched_barrier(0)
    Unit cur, nxt; int ui = 0;
    if (!S.next(0, cur)) return;
    f32x4 acc[2][2][4][2];
#pragma unroll
    for (int a = 0; a < 2; ++a)
#pragma unroll
        for (int b = 0; b < 2; ++b)
#pragma unroll
            for (int m = 0; m < 4; ++m)
#pragma unroll
                for (int n = 0; n < 2; ++n) acc[a][b][m][n] = (f32x4){0.f, 0.f, 0.f, 0.f};
    typedef int v8i_t __attribute__((ext_vector_type(8))); typedef unsigned u32x8_t __attribute__((ext_vector_type(8)));
    bf16x8 At[4][2], B0[2][2], B1[2][2]; u32x8_t At8[4], B08[2], B18[2];
    const char* cA = (const char*)g.A + (GATHER ? (size_t)0 : (size_t)cur.pm * tstepA); const char* cB = (const char*)g.Bt + (size_t)cur.pb * tstepB;
    if constexpr (GATHER) PG8_SRC(cur, vgc);
    S.a_ready(cur);
    if constexpr (SP2) {
        PG8_STAGE(PG8_SB(0, 0), cB, voffB); PG8_STAGE(PG8_SB(0, 1), cB + hstepB, voffB); PG8_STAGE_A(PG8_SA(0, 0), cA, 0, vgc); PG8_STAGE_A(PG8_SA(0, 1), cA, 1, vgc);
        if (wr == 1) PG8_BAR;
        PG8_WAIT_V(2); PG8_BAR;
        PG8_STAGE(PG8_SB(1, 0), cB + kstep, voffB); PG8_STAGE_A(PG8_SA(1, 0), cA + kstep, 0, vgc); PG8_STAGE(PG8_SB(1, 1), cB + hstepB + kstep, voffB);
        PG8_WAIT_V(6); PG8_BAR;
    } else {
        PG8_STAGE(PG8_SB(0, 0), cB, voffB); PG8_STAGE(PG8_SA(0, 0), cA, voffA); PG8_STAGE(PG8_SB(0, 1), cB + hstepB, voffB); PG8_STAGE(PG8_SA(0, 1), cA + hstepA, voffA);
        if (wr == 1) PG8_BAR;
        PG8_WAIT_V(4); PG8_BAR;
        PG8_STAGE(PG8_SB(1, 0), cB + kstep, voffB); PG8_STAGE(PG8_SA(1, 0), cA + kstep, voffA); PG8_STAGE(PG8_SB(1, 1), cB + hstepB + kstep, voffB);
        PG8_WAIT_V(6); PG8_BAR;
    }
    for (;;) {
        const bool has_next = S.next(ui + 1, nxt);
        const char* nA = (has_next && !GATHER) ? (const char*)g.A + (size_t)nxt.pm * tstepA : cA; const char* nB = has_next ? (const char*)g.Bt + (size_t)nxt.pb * tstepB : cB;
        if constexpr (GATHER) { static_assert(!GATHER || SP2, "GATHER is wired into the SP2 loop only"); if (has_next) PG8_SRC(nxt, vgn); else { _Pragma("unroll") for (int h_ = 0; h_ < 2; ++h_) _Pragma("unroll") for (int i_ = 0; i_ < 2; ++i_) vgn[h_][i_] = vgc[h_][i_]; } }
#pragma unroll 1
        for (int t = 0; t < nt; t += 2) {
            const bool last = (t == nt - 2);
            const char* a1 = cA + (size_t)(t + 1) * kstep;
            const char* a2 = last ? nA : cA + (size_t)(t + 2) * kstep; const char* b2 = last ? nB : cB + (size_t)(t + 2) * kstep;
            const char* a3 = a2 + kstep; const char* b3 = b2 + kstep;
            if (last && has_next) S.a_ready(nxt);
            unsigned vg2[2][2];
            if constexpr (GATHER) { _Pragma("unroll") for (int h_ = 0; h_ < 2; ++h_) _Pragma("unroll") for (int i_ = 0; i_ < 2; ++i_) vg2[h_][i_] = last ? vgn[h_][i_] : vgc[h_][i_]; }
            if constexpr (SP2) {
            PG8_LDB(B0, 0, 0); PG8_LDB(B1, 0, 1); PG8_SCHED; PG8_LDA(At, 0, 0); PG8_STAGE_A(PG8_SA(1, 1), a1, 1, vgc);
            PG8_WAIT_V(8); PG8_WAIT_L(0); PG8_BAR; PG8_MMA(0, 0, At, B0); PG8_MMA(0, 1, At, B1); PG8_BAR; PG8_SCHED;
            PG8_LDA(At, 0, 1); PG8_STAGE(PG8_SB(0, 0), b2, voffB); PG8_STAGE(PG8_SB(0, 1), b2 + hstepB, voffB); PG8_STAGE_A(PG8_SA(0, 0), a2, 0, vg2);
            PG8_WAIT_V(8); PG8_WAIT_L(0); PG8_BAR; PG8_MMA(1, 0, At, B0); PG8_MMA(1, 1, At, B1); PG8_BAR; PG8_SCHED;
            PG8_LDB(B0, 1, 0); PG8_LDB(B1, 1, 1); PG8_SCHED; PG8_LDA(At, 1, 0); PG8_STAGE_A(PG8_SA(0, 1), a2, 1, vg2);
            PG8_WAIT_V(8); PG8_WAIT_L(0); PG8_BAR; PG8_MMA(0, 0, At, B0); PG8_MMA(0, 1, At, B1); PG8_BAR; PG8_SCHED;
            PG8_LDA(At, 1, 1); PG8_STAGE(PG8_SB(1, 0), b3, voffB); PG8_STAGE(PG8_SB(1, 1), b3 + hstepB, voffB); PG8_STAGE_A(PG8_SA(1, 0), a3, 0, vg2);
            PG8_WAIT_V(8); PG8_WAIT_L(0); PG8_BAR; PG8_MMA(1, 0, At, B0); PG8_MMA(1, 1, At, B1); PG8_BAR; PG8_SCHED;
            } else {
            PG8_LDB(B0, 0, 0); PG8_SCHED; PG8_LDA(At, 0, 0); PG8_STAGE(PG8_SA(1, 1), a1 + hstepA, voffA);
            PG8_WAIT_L(8); PG8_BAR; PG8_WAIT_L(0); PG8_MMA(0, 0, At, B0); PG8_BAR; PG8_SCHED;
            PG8_LDB(B1, 0, 1); PG8_STAGE(PG8_SB(0, 0), b2, voffB);
            PG8_BAR; PG8_WAIT_L(0); PG8_MMA(0, 1, At, B1); PG8_BAR;
            PG8_LDA(At, 0, 1); PG8_STAGE(PG8_SA(0, 0), a2, voffA);
            PG8_BAR; PG8_WAIT_L(0); PG8_MMA(1, 0, At, B0); PG8_BAR; PG8_SCHED;
            PG8_STAGE(PG8_SB(0, 1), b2 + hstepB, voffB);
            PG8_WAIT_V(6); PG8_BAR; PG8_MMA(1, 1, At, B1); PG8_BAR;
            PG8_LDB(B0, 1, 0); PG8_SCHED; PG8_LDA(At, 1, 0); PG8_STAGE(PG8_SA(0, 1), a2 + hstepA, voffA);
            PG8_WAIT_L(8); PG8_BAR; PG8_WAIT_L(0); PG8_MMA(0, 0, At, B0); PG8_BAR; PG8_SCHED;
            PG8_LDB(B1, 1, 1); PG8_STAGE(PG8_SB(1, 0), b3, voffB);
            PG8_BAR; PG8_WAIT_L(0); PG8_MMA(0, 1, At, B1); PG8_BAR;
            PG8_LDA(At, 1, 1); PG8_STAGE(PG8_SA(1, 0), a3, voffA);
            PG8_BAR; PG8_WAIT_L(0); PG8_MMA(1, 0, At, B0); PG8_BAR; PG8_SCHED;
            PG8_STAGE(PG8_SB(1, 1), b3 + hstepB, voffB);
            PG8_WAIT_V(6); PG8_BAR; PG8_MMA(1, 1, At, B1); PG8_BAR;
            }
        }
        if constexpr (ALIGN_EPI) { if (wr == 0) PG8_BAR; }
        if constexpr (!Epi::AFTER_DRAIN) { E(acc, cur, wr, wc, fr, fq); S.done(cur); }
        if (!has_next) break;
#pragma unroll
        for (int a = 0; a < 2; ++a)
#pragma unroll
            for (int b = 0; b < 2; ++b)
#pragma unroll
                for (int m = 0; m < 4; ++m)
#pragma unroll
                    for (int n = 0; n < 2; ++n) acc[a][b][m][n] = (f32x4){0.f, 0.f, 0.f, 0.f};
        cur = nxt; cA = nA; cB = nB; ++ui;
        if constexpr (GATHER) { _Pragma("unroll") for (int h_ = 0; h_ < 2; ++h_) _Pragma("unroll") for (int i_ = 0; i_ < 2; ++i_) vgc[h_][i_] = vgn[h_][i_]; }
        if constexpr (ALIGN_EPI) { if (wr == 1) PG8_BAR; }
    }
    PG8_WAIT_V(0);
    if constexpr (!ALIGN_EPI) { if (wr == 0) PG8_BAR; }
    PG8_BAR;
    if constexpr (Epi::AFTER_DRAIN) { E.fused(acc, cur, wr, wc, fr, fq, lds, wid, lane); S.done(cur); }
#undef PG8_SA
#undef PG8_SB
#undef PG8_STAGE
#undef PG8_STAGE_A
#undef PG8_SRC
#undef PG8_LDA
#undef PG8_LDB
#undef PG8_MMA
#undef PG8_WAIT_V
#undef PG8_WAIT_L
#undef PG8_BAR
#undef PG8_SCHED
}
}

#define XB_TMO      128
#define XB_XCNT(j)  (256  + 64 * (j))
#define XB_XSUB(j)  (1280 + 64 * (j))
#define XB_XGEN(j)  (2304 + 64 * (j))
#define XB_TOP      3328
#define XB_TOPGEN   3392
#define XCD_BAR_WORDS 3456
#define XB_SPIN_CAP (1u << 18)

__device__ __forceinline__ unsigned xb_ld(unsigned* p)              { return __hip_atomic_load(p, __ATOMIC_RELAXED, __HIP_MEMORY_SCOPE_AGENT); }
__device__ __forceinline__ unsigned xb_add(unsigned* p, unsigned v) { return __hip_atomic_fetch_add(p, v, __ATOMIC_RELAXED, __HIP_MEMORY_SCOPE_AGENT); }
__device__ __forceinline__ unsigned xb_xcc_id() { return (unsigned)__builtin_amdgcn_s_getreg((3 << 11) | 20) & 0xFu; }
#define XB_SPIN(cond, bar) do { unsigned _sp = 0; while (cond) { __builtin_amdgcn_s_sleep(1); \
    if ((++_sp & 255u) == 0u) { if (xb_ld(&(bar)[XB_TMO])) break; if (_sp > XB_SPIN_CAP) { atomicAdd(&(bar)[XB_TMO], 1u); break; } } } } while (0)

struct XcdBarrier {
    unsigned* bar; unsigned x;
    volatile LAS unsigned* st;
};

__device__ __forceinline__ XcdBarrier xcd_barrier_post(unsigned* bar, volatile LAS unsigned* st) {
    XcdBarrier b; b.bar = bar; b.x = xb_xcc_id(); b.st = st;
    if (threadIdx.x == 0) (void)xb_add(&bar[XB_XCNT(b.x)], 1u);
    return b;
}
__device__ __forceinline__ void xcd_barrier_complete(unsigned* bar, unsigned x, unsigned& nloc, unsigned& nx) {
    const unsigned G = gridDim.x * gridDim.y * gridDim.z;
    unsigned sum, cnt, mine, sp = 0u;
    for (;;) {
        sum = 0u; cnt = 0u; mine = 0u;
#pragma unroll
        for (unsigned j = 0; j < 16; ++j) { const unsigned c = xb_ld(&bar[XB_XCNT(j)]); sum += c; cnt += (c > 0u) ? 1u : 0u; mine = (j == x) ? c : mine; }
        if (sum == G) break;
        __builtin_amdgcn_s_sleep(1);
        if ((++sp & 255u) == 0u) { if (xb_ld(&bar[XB_TMO])) break; if (sp > XB_SPIN_CAP) { atomicAdd(&bar[XB_TMO], 1u); break; } }
    }
    nloc = mine > 0u ? mine : 1u; nx = cnt > 0u ? cnt : 1u;
}

__device__ __forceinline__ void xcd_barrier(const XcdBarrier& b) {
    asm volatile("s_waitcnt vmcnt(0)" ::: "memory");
    __syncthreads();
    if (threadIdx.x == 0) {
        unsigned* bar = b.bar;
        __builtin_amdgcn_s_waitcnt(0);
        unsigned nloc = b.st[0], nx = b.st[1];
        if (nloc == 0u) { xcd_barrier_complete(bar, b.x, nloc, nx); b.st[0] = nloc; b.st[1] = nx; }
        const unsigned old = xb_add(&bar[XB_XSUB(b.x)], 1u);
        const unsigned gen = old / nloc;
        if (old + 1u == (gen + 1u) * nloc) {
            __builtin_amdgcn_fence(__ATOMIC_RELEASE, "agent");
            asm volatile("s_waitcnt vmcnt(0)" ::: "memory");
            const unsigned og = xb_add(&bar[XB_TOP], 1u);
            const unsigned tg = og / nx;
            if (og + 1u == (tg + 1u) * nx) xb_add(&bar[XB_TOPGEN], 1u);
            else XB_SPIN(xb_ld(&bar[XB_TOPGEN]) == tg, bar);
            __builtin_amdgcn_fence(__ATOMIC_ACQUIRE, "agent");
            xb_add(&bar[XB_XGEN(b.x)], 1u);
            asm volatile("s_waitcnt vmcnt(0)" ::: "memory");
        } else {
            XB_SPIN(xb_ld(&bar[XB_XGEN(b.x)]) == gen, bar);
            __builtin_amdgcn_fence(__ATOMIC_ACQUIRE, "agent");
            asm volatile("s_waitcnt vmcnt(0)" ::: "memory");
        }
    }
    __syncthreads();
}

template <class Fetch, class Dst>
DI void tr_item(LAS float* scr, int k0, int n0, int lane, const Fetch& fetch, const Dst& dst) {
#pragma unroll 8
    for (int i = 0; i < 32; ++i) { const int kk = 2 * i + (lane >> 5); scr[kk * 33 + (lane & 31)] = fetch(k0 + kk, n0 + (lane & 31)); }
    asm volatile("s_waitcnt lgkmcnt(0)" ::: "memory");
    const int c = lane & 7;
#pragma unroll
    for (int j = 0; j < 4; ++j) { const int n = (lane >> 3) + 8 * j; const LAS float* s = scr + (8 * c) * 33 + n;
        u32x4 o; o.x = cvtpk(s[0], s[33]); o.y = cvtpk(s[66], s[99]); o.z = cvtpk(s[132], s[165]); o.w = cvtpk(s[198], s[231]);
        *(u32x4*)(dst(n0 + n) + k0 + 8 * c) = o; }
    asm volatile("s_waitcnt lgkmcnt(0)" ::: "memory");
}

DI int t5_bucket(int rel) {
    const int n = rel < 0 ? -rel : rel; const int ret = rel > 0 ? 16 : 0;
    int v;
    if (n < 8) v = n; else if (n < 12) v = 8; else if (n < 16) v = 9; else if (n < 23) v = 10; else if (n < 32) v = 11; else if (n < 46) v = 12; else if (n < 64) v = 13; else if (n < 91) v = 14; else v = 15;
    return ret + v;
}

struct MoeItem { const float* src; unsigned char* dst; int ns, kd; };
DI MoeItem moe_item_of(const float* w_gate, const float* w_up, const float* w_down, unsigned char* WGU, unsigned char* WD, int it) {
    constexpr int I_GU = NEXP * 16 * 16 * 2;
    MoeItem m;
    if (it < I_GU) { const int up = it & 1, r = it >> 1, nb = r & 15, kb = (r >> 4) & 15, e = r >> 8; const int n0 = nb * 32;
        m.src = (up ? w_up : w_gate) + (size_t)e * 1024 * 512 + (size_t)(kb * 64) * 512 + n0; m.ns = 512; m.kd = 1024;
        m.dst = WGU + (size_t)e * 1024 * 1024 + (size_t)((up ? 128 : 0) + ((n0 >> 7) << 8) + (n0 & 127)) * 1024 + kb * 64;
    } else { const int r = it - I_GU, nb = r & 31, kb = (r >> 5) & 7, e = r >> 8;
        m.src = w_down + (size_t)e * 512 * 1024 + (size_t)(kb * 64) * 1024 + nb * 32; m.ns = 1024; m.kd = 512;
        m.dst = WD + (size_t)e * 1024 * 512 + (size_t)(nb * 32) * 512 + kb * 64; }
    return m;
}
DI void moe_item_load(const MoeItem& m, f32x4 (&r)[8], int lane) {
#pragma unroll
    for (int i = 0; i < 8; ++i) r[i] = __builtin_nontemporal_load((const f32x4*)(m.src + (size_t)(8 * i + (lane >> 3)) * m.ns + 4 * (lane & 7)));
}
DI void moe_item_store(const MoeItem& m, const f32x4 (&r)[8], LAS float* scr, int lane) {
#pragma unroll
    for (int i = 0; i < 8; ++i) { LAS float* p = scr + (8 * i + (lane >> 3)) * 33 + 4 * (lane & 7); p[0] = r[i][0]; p[1] = r[i][1]; p[2] = r[i][2]; p[3] = r[i][3]; }
    asm volatile("s_waitcnt lgkmcnt(0)" ::: "memory");
    const int c = lane & 3;
#pragma unroll
    for (int j = 0; j < 2; ++j) { const int n = (lane >> 2) + 16 * j; const LAS float* s = scr + (16 * c) * 33 + n;
        u32x4 o;
#pragma unroll
        for (int q = 0; q < 4; ++q) { int w = 0;
            w = __builtin_amdgcn_cvt_pk_fp8_f32(s[(4 * q) * 33] * 32.f, s[(4 * q + 1) * 33] * 32.f, w, false);
            w = __builtin_amdgcn_cvt_pk_fp8_f32(s[(4 * q + 2) * 33] * 32.f, s[(4 * q + 3) * 33] * 32.f, w, true); o[q] = (unsigned)w; }
        *(u32x4*)(m.dst + (size_t)n * m.kd + 16 * c) = o; }
    asm volatile("s_waitcnt lgkmcnt(0)" ::: "memory");
}
template <int NI>
DI void moe_convert_items(const float* w_gate, const float* w_up, const float* w_down, unsigned char* WGU, unsigned char* WD, LAS float* scr, int it0, int lane) {
    f32x4 ra[NI][8]; MoeItem ma[NI];
#pragma unroll
    for (int i = 0; i < NI; ++i) { ma[i] = moe_item_of(w_gate, w_up, w_down, WGU, WD, it0 + i); moe_item_load(ma[i], ra[i], lane); }
#pragma unroll
    for (int i = 0; i < NI; ++i) moe_item_store(ma[i], ra[i], scr, lane);
}
constexpr int MOE_CONV_ITEMS = NEXP * 16 * 16 * 2 + NEXP * 8 * 32;

struct In {
    const float *x, *w_in, *w_out, *norm_mix, *norm_ffn, *rel_bias, *lam_q1, *lam_k1, *lam_q2, *lam_k2, *diff_subln, *mla_q_norm, *mla_kv_norm, *w_uq, *w_ukv,
                *w_group, *b_group, *w_expert, *b_expert, *w_gate, *w_up, *w_down, *norm_final;
};

DI void prologue_phase(const In& I, unsigned char* ws, LAS unsigned char* lds, int gw, int NGW, int lane, int wave) {
    LAS float* scr = (LAS float*)(lds + wave * 16384);
    bf16* WinT = (bf16*)(ws + WS_WIN); bf16* WoT = (bf16*)(ws + WS_WOUT); bf16* WuqT = (bf16*)(ws + WS_WUQ); bf16* WukvT = (bf16*)(ws + WS_WUKV); bf16* WR = (bf16*)(ws + WS_WR);
    constexpr int I1 = 2 * 16 * 96, I2 = 2 * 16 * 32, I3 = 2 * 4 * 6, I4 = 2 * 2 * 12, I5 = 2 * 2 * 16 * 2;
    for (int it = gw; it < I1 + I2 + I3 + I4 + I5; it += NGW) {
        int r = it;
        if (r < I1) { const int l = r / 1536, q = r % 1536, kb = q / 96, nb = q % 96; const float* W = I.w_in + (size_t)l * 1024 * DIN; bf16* D = WinT + (size_t)l * ZP * 1024;
            tr_item(scr, kb * 64, nb * 32, lane, [=](int k, int n) { if (n >= DIN) return 0.f; float s = 1.f; if (n < 512 || (n >= Z_BQ && n < Z_BK)) s = 0.125f * LOG2E; else if (n >= Z_IW && n < Z_CQ) s = 0.0625f; return W[(size_t)k * DIN + n] * s; },
                    [=](int n) { return D + (size_t)n * 1024; }); continue; }
        r -= I1;
        if (r < I2) { const int l = r / 512, q = r % 512, kb = q / 32, nb = q % 32; const float* W = I.w_out + (size_t)l * 1024 * 1024; bf16* D = WoT + (size_t)l * 1024 * 1024;
            tr_item(scr, kb * 64, nb * 32, lane, [=](int k, int n) { return W[(size_t)k * 1024 + n]; }, [=](int n) { return D + (size_t)n * 1024; }); continue; }
        r -= I2;
        if (r < I3) { const int l = r / 24, q = r % 24, kb = q / 6, nb = q % 6; const float* W = I.w_uq + (size_t)l * 256 * 192; const float* g = I.mla_q_norm + l * 256; bf16* D = WuqT + (size_t)l * 192 * 256;
            const float qs = 0.14433756729740643f * LOG2E;
            tr_item(scr, kb * 64, nb * 32, lane, [=](int k, int n) { const int o = n < 128 ? (n >> 5) * 48 + (n & 31) : ((n - 128) >> 4) * 48 + 32 + ((n - 128) & 15); return W[(size_t)k * 192 + o] * g[k] * qs; },
                    [=](int n) { return D + (size_t)n * 256; }); continue; }
        r -= I3;
        if (r < I4) { const int l = r / 24, q = r % 24, kb = q / 12, nb = q % 12; const float* W = I.w_ukv + (size_t)l * 128 * 384; const float* g = I.mla_kv_norm + l * 128; bf16* D = WukvT + (size_t)l * 384 * 128;
            tr_item(scr, kb * 64, nb * 32, lane, [=](int k, int n) { const int o = n < 128 ? (n >> 5) * 96 + (n & 31) : ((n - 128) >> 6) * 96 + 32 + ((n - 128) & 63); return W[(size_t)k * 384 + o] * g[k]; },
                    [=](int n) { return D + (size_t)n * 128; }); continue; }
        r -= I4;
        { const int lo = r & 1, q = r >> 1, nb = q & 1, kb = (q >> 1) & 15, l = q >> 5; const float* We = I.w_expert + (size_t)l * 1024 * 32; const float* Wg = I.w_group + (size_t)l * 1024 * 4; const float* gf = I.norm_ffn + (size_t)l * DM;
          bf16* D = WR + ((size_t)(l * 2 + lo) * 64) * 1024;
          tr_item(scr, kb * 64, nb * 32, lane, [=](int k, int n) { float w = (n < 32 ? We[(size_t)k * 32 + n] : (n < 36 ? Wg[(size_t)k * 4 + (n - 32)] : 0.f)) * gf[k]; if (lo) w = w - bf2f(f2bf(w)); return w; },
                  [=](int n) { return D + (size_t)n * 1024; }); }
    }
    float* par = (float*)(ws + WS_PAR);
    const int gt = gw * 64 + lane, NGT = NGW * 64;
    for (int i = gt; i < SEQ * 8; i += NGT) { const int t = i >> 3, f = i & 7; const float inv = powf(10000.f, -(float)(2 * f) / 16.f); const float ang = (float)t * inv;
        ((float*)(ws + WS_PAR + PAR_COS))[i] = cosf(ang); ((float*)(ws + WS_PAR + PAR_SIN))[i] = sinf(ang); }
    for (int i = gt; i < 8 * 256; i += NGT) { const int hh = i >> 8, rel = (i & 255) - 192; ((float*)(ws + WS_PAR + PAR_LUT))[i] = I.rel_bias[t5_bucket(rel) * 8 + hh] * LOG2E; }
    if (gw == 2 && lane == 0) {
        unsigned* ord = (unsigned*)(ws + WS_PAR + PAR_ORD); int n = 0;
        for (int c = 32; c >= 1; --c) {
            if (c % 2 == 0 && c / 2 - 1 <= 15) for (int bh = 0; bh < 32; ++bh) ord[n++] = (0u << 16) | ((unsigned)(c / 2 - 1) << 8) | (unsigned)bh;
            if (c <= 16) for (int ty = 1; ty < 3; ++ty) for (int bh = 0; bh < 32; ++bh) ord[n++] = ((unsigned)ty << 16) | ((unsigned)(c - 1) << 8) | (unsigned)bh; }
    }
    if (gw < 2) { const int l = gw; const float a = wave_sum(I.lam_q1[l * 64 + lane] * I.lam_k1[l * 64 + lane]), b = wave_sum(I.lam_q2[l * 64 + lane] * I.lam_k2[l * 64 + lane]);
        const float li = 0.8f - 0.6f * expf(-0.3f * (float)l); if (lane == 0) { par[l] = expf(a) - expf(b) + li; par[2 + l] = 1.f - li; } }
}

template <int MODE>
DI void norm_phase(const float* src, bf16* XA, float* OUT, bf16* XN, const float* gain, const unsigned char* Y  , const int* rt_d, const float* rt_g, int gw, int NGW, int lane) {
    f32x4 g4[4];
#pragma unroll
    for (int j = 0; j < 4; ++j) g4[j] = *(const f32x4*)(gain + 4 * lane + 256 * j);
    for (int m = gw; m < M; m += NGW) {
        f32x4 v[4];
        if (MODE == 0) {
#pragma unroll
            for (int j = 0; j < 4; ++j) v[j] = *(const f32x4*)(src + (size_t)m * DM + 4 * lane + 256 * j);
        } else {
#pragma unroll
            for (int j = 0; j < 4; ++j) { const u32x2 w = *(const u32x2*)(XA + (size_t)m * DM + 4 * lane + 256 * j);
                v[j] = (f32x4){__uint_as_float(w.x << 16), __uint_as_float(w.x & 0xffff0000u), __uint_as_float(w.y << 16), __uint_as_float(w.y & 0xffff0000u)}; }
        }
        if (MODE != 0) {
            const int d0 = rt_d[2 * m], d1 = rt_d[2 * m + 1]; const float w0 = rt_g[2 * m] * 0.0625f, w1 = rt_g[2 * m + 1] * 0.0625f;
            const unsigned char* y0 = Y + (size_t)d0 * DM, * y1 = Y + (size_t)d1 * DM;
#pragma unroll
            for (int j = 0; j < 4; ++j) { const int a = *(const int*)(y0 + 4 * lane + 256 * j), b = *(const int*)(y1 + 4 * lane + 256 * j);
                const f32x2 a01 = __builtin_amdgcn_cvt_pk_f32_fp8(a, false), a23 = __builtin_amdgcn_cvt_pk_f32_fp8(a, true), b01 = __builtin_amdgcn_cvt_pk_f32_fp8(b, false), b23 = __builtin_amdgcn_cvt_pk_f32_fp8(b, true);
                v[j][0] += w0 * a01[0] + w1 * b01[0]; v[j][1] += w0 * a01[1] + w1 * b01[1]; v[j][2] += w0 * a23[0] + w1 * b23[0]; v[j][3] += w0 * a23[1] + w1 * b23[1]; }
        }
        float ss = 0.f;
#pragma unroll
        for (int j = 0; j < 4; ++j) ss += (v[j][0] * v[j][0] + v[j][1] * v[j][1]) + (v[j][2] * v[j][2] + v[j][3] * v[j][3]);
        const float rstd = rsqrtf(wave_sum(ss) * (1.f / DM) + EPS);
        if (MODE == 1) {
#pragma unroll
            for (int j = 0; j < 4; ++j) { u32x2 w; w.x = cvtpk(v[j][0], v[j][1]); w.y = cvtpk(v[j][2], v[j][3]); *(u32x2*)(XA + (size_t)m * DM + 4 * lane + 256 * j) = w; }
        }
        if (MODE == 2) {
#pragma unroll
            for (int j = 0; j < 4; ++j) *(f32x4*)(OUT + (size_t)m * DM + 4 * lane + 256 * j) = v[j] * rstd * g4[j];
        } else {
#pragma unroll
            for (int j = 0; j < 4; ++j) { const f32x4 o = v[j] * rstd * g4[j]; u32x2 w; w.x = cvtpk(o[0], o[1]); w.y = cvtpk(o[2], o[3]); *(u32x2*)(XN + (size_t)m * DM + 4 * lane + 256 * j) = w; }
        }
    }
}

DI void st4(bf16* p, float a, float b, float c, float d) { u32x2 w; w.x = cvtpk(a, b); w.y = cvtpk(c, d); *(u32x2*)p = w; }
DI void mla_prep_unit(const bf16* Z, const bf16* WuqT, const bf16* WukvT, const float* cosT, const float* sinT, bf16* MLA, int unit, int lane) {
    const int slice = unit >> 1, part = unit & 1, r32 = lane & 31, hi = lane >> 5;
    const int row = slice * 32 + r32, t = row & (SEQ - 1);
    const bf16* zr = Z + (size_t)row * ZP; bf16* orow = MLA + (size_t)row * MLAP;
    const f32x4 cs = *(const f32x4*)(cosT + t * 8 + 4 * hi), sn = *(const f32x4*)(sinT + t * 8 + 4 * hi);
    const u32x4 zero4 = {0u, 0u, 0u, 0u};
    if (part == 0) {
        bf16x8 bq[16]; float ss = 0.f;
#pragma unroll
        for (int s = 0; s < 16; ++s) { bq[s] = *(const bf16x8*)(zr + Z_CQ + 16 * s + 8 * hi);
#pragma unroll
            for (int j = 0; j < 8; ++j) { const float f = bf2f((bf16)bq[s][j]); ss += f * f; } }
        const float rstd = rsqrtf(halfswap_sum(ss) * (1.f / 256.f) + EPS);
        auto epi_q = [&](const int nb, const f32x16& acc) __attribute__((always_inline)) {
            if (nb < 4) {
#pragma unroll
                for (int g = 0; g < 4; ++g) st4(orow + nb * 64 + 8 * g + 4 * hi, acc[4 * g] * rstd, acc[4 * g + 1] * rstd, acc[4 * g + 2] * rstd, acc[4 * g + 3] * rstd);
            } else {
#pragma unroll
                for (int hb = 0; hb < 2; ++hb) { const int head = 2 * (nb - 4) + hb; float o1[4], o2[4];
#pragma unroll
                    for (int j = 0; j < 4; ++j) { const float x1 = acc[8 * hb + j] * rstd, x2 = acc[8 * hb + 4 + j] * rstd; o1[j] = x1 * cs[j] - x2 * sn[j]; o2[j] = x1 * sn[j] + x2 * cs[j]; }
                    st4(orow + head * 64 + 32 + 4 * hi, o1[0], o1[1], o1[2], o1[3]); st4(orow + head * 64 + 40 + 4 * hi, o2[0], o2[1], o2[2], o2[3]);
                    *(u32x4*)(orow + head * 64 + 48 + 8 * hi) = zero4; }
            }
        };
        bf16x8 wA[16], wB[16];
#define MLA_WLOAD(W, nbx) do { const bf16* wp_ = WuqT + (size_t)((nbx) * 32 + r32) * 256 + 8 * hi; _Pragma("unroll") for (int s = 0; s < 16; ++s) W[s] = *(const bf16x8*)(wp_ + 16 * s); } while (0)
        MLA_WLOAD(wA, 0);
#pragma unroll 1
        for (int nb = 0; nb < 6; nb += 2) {
            MLA_WLOAD(wB, nb + 1);
            { f32x16 acc = {};
#pragma unroll
              for (int s = 0; s < 16; ++s) acc = MFMA32(wA[s], bq[s], acc);
              epi_q(nb, acc); }
            MLA_WLOAD(wA, nb + 2 < 6 ? nb + 2 : 5);
            { f32x16 acc = {};
#pragma unroll
              for (int s = 0; s < 16; ++s) acc = MFMA32(wB[s], bq[s], acc);
              epi_q(nb + 1, acc); }
        }
#undef MLA_WLOAD
    } else {
        bf16x8 bk[8]; float ss = 0.f;
#pragma unroll
        for (int s = 0; s < 8; ++s) { bk[s] = *(const bf16x8*)(zr + Z_CKV + 16 * s + 8 * hi);
#pragma unroll
            for (int j = 0; j < 8; ++j) { const float f = bf2f((bf16)bk[s][j]); ss += f * f; } }
        const float rstd = rsqrtf(halfswap_sum(ss) * (1.f / 128.f) + EPS);
        auto epi_kv = [&](const int nb, const f32x16& acc) __attribute__((always_inline)) {
            bf16* o = nb < 4 ? orow + 256 + nb * 64 : orow + 512 + ((nb - 4) >> 1) * 64 + ((nb - 4) & 1) * 32;
#pragma unroll
            for (int g = 0; g < 4; ++g) st4(o + 8 * g + 4 * hi, acc[4 * g] * rstd, acc[4 * g + 1] * rstd, acc[4 * g + 2] * rstd, acc[4 * g + 3] * rstd);
        };
        bf16x8 wA[8], wB[8];
#define MLA_WLOAD(W, nbx) do { const bf16* wp_ = WukvT + (size_t)((nbx) * 32 + r32) * 128 + 8 * hi; _Pragma("unroll") for (int s = 0; s < 8; ++s) W[s] = *(const bf16x8*)(wp_ + 16 * s); } while (0)
        MLA_WLOAD(wA, 0);
#pragma unroll 1
        for (int nb = 0; nb < 12; nb += 2) {
            MLA_WLOAD(wB, nb + 1);
            { f32x16 acc = {};
#pragma unroll
              for (int s = 0; s < 8; ++s) acc = MFMA32(wA[s], bk[s], acc);
              epi_kv(nb, acc); }
            MLA_WLOAD(wA, nb + 2 < 12 ? nb + 2 : 11);
            { f32x16 acc = {};
#pragma unroll
              for (int s = 0; s < 8; ++s) acc = MFMA32(wB[s], bk[s], acc);
              epi_kv(nb + 1, acc); }
        }
#undef MLA_WLOAD
        const u32x2 a = *(const u32x2*)(zr + Z_CKR + 4 * hi), b = *(const u32x2*)(zr + Z_CKR + 8 + 4 * hi);
        const float x1[4] = {__uint_as_float(a.x << 16), __uint_as_float(a.x & 0xffff0000u), __uint_as_float(a.y << 16), __uint_as_float(a.y & 0xffff0000u)};
        const float x2[4] = {__uint_as_float(b.x << 16), __uint_as_float(b.x & 0xffff0000u), __uint_as_float(b.y << 16), __uint_as_float(b.y & 0xffff0000u)};
        float o1[4], o2[4];
#pragma unroll
        for (int j = 0; j < 4; ++j) { o1[j] = x1[j] * cs[j] - x2[j] * sn[j]; o2[j] = x1[j] * sn[j] + x2[j] * cs[j]; }
#pragma unroll
        for (int h = 0; h < 4; ++h) { st4(orow + 256 + h * 64 + 32 + 4 * hi, o1[0], o1[1], o1[2], o1[3]); st4(orow + 256 + h * 64 + 40 + 4 * hi, o2[0], o2[1], o2[2], o2[3]);
            *(u32x4*)(orow + 256 + h * 64 + 48 + 8 * hi) = zero4; }
    }
}

DI int wave_sum_i(int v) {
    v += __builtin_amdgcn_update_dpp(0, v, 0x111, 0xf, 0xf, false); v += __builtin_amdgcn_update_dpp(0, v, 0x112, 0xf, 0xf, false);
    v += __builtin_amdgcn_update_dpp(0, v, 0x114, 0xf, 0xf, false); v += __builtin_amdgcn_update_dpp(0, v, 0x118, 0xf, 0xf, false);
    return __builtin_amdgcn_readlane(v, 15) + __builtin_amdgcn_readlane(v, 31) + __builtin_amdgcn_readlane(v, 47) + __builtin_amdgcn_readlane(v, 63);
}
DI float wave_max_f(float f) {
    const int ninf = (int)0xff800000u; int v = __float_as_int(f);
#define WMX(ctrl) v = __float_as_int(fmaxf(__int_as_float(v), __int_as_float(__builtin_amdgcn_update_dpp(ninf, v, ctrl, 0xf, 0xf, false))))
    WMX(0x111); WMX(0x112); WMX(0x114); WMX(0x118);
#undef WMX
    return fmaxf(fmaxf(__int_as_float(__builtin_amdgcn_readlane(v, 15)), __int_as_float(__builtin_amdgcn_readlane(v, 31))), fmaxf(__int_as_float(__builtin_amdgcn_readlane(v, 47)), __int_as_float(__builtin_amdgcn_readlane(v, 63))));
}
DI float relu_i(float x) { const int i = __float_as_int(x); return __int_as_float(i > 0 ? i : 0); }
DI unsigned fkey(float f) { const unsigned u = __float_as_uint(f); return (u & 0x80000000u) ? ~u : (u | 0x80000000u); }

struct DsaOps { bf16x8 af[2][2]; bf16x8 w8[2][2]; bf16x8 cb[2][2]; };
DI void dsa_load_ops(const bf16* Z, const bf16* KIDX, int item, int wave, int lane, DsaOps& o) {
    const int r32 = lane & 31, hi = lane >> 5;
    const int c = 63 - (item >> 6), rem = item & 63, b = rem >> 3, sg = rem & 7;
    const int n = 64 * (c + 1), t0 = 64 * c + 8 * sg; const size_t rowbase = (size_t)b * SEQ;
    const int ql = ((r32 >> 4) & 1) * 2 + ((r32 >> 2) & 1), hh = ((r32 >> 3) & 1) * 4 + (r32 & 3);
#pragma unroll
    for (int rb = 0; rb < 2; ++rb) {
#pragma unroll
        for (int s = 0; s < 2; ++s) o.af[rb][s] = *(const bf16x8*)(Z + (rowbase + t0 + 4 * rb + ql) * ZP + Z_IQ + hh * 32 + 16 * s + 8 * hi);
#pragma unroll
        for (int q2 = 0; q2 < 2; ++q2) o.w8[rb][q2] = *(const bf16x8*)(Z + (rowbase + t0 + 4 * rb + 2 * q2 + hi) * ZP + Z_IW);
    }
    const int nkb = n >> 5;
    const bf16* kp0 = KIDX + (rowbase + r32) * 32 + 8 * hi;
#pragma unroll
    for (int u = 0; u < 2; ++u) { const int k2 = wave + 8 * u; const int kk = k2 < nkb ? k2 : wave; const bf16* kp = kp0 + (size_t)(32 * kk) * 32; o.cb[u][0] = *(const bf16x8*)kp; o.cb[u][1] = *(const bf16x8*)(kp + 16); }
}
DI void dsa_select_item(const bf16* Z, const bf16* KIDX, unsigned long long* MASK, LAS unsigned char* lds, const DsaOps& ops, int item, int tid) {
    const int lane = tid & 63, wave = __builtin_amdgcn_readfirstlane(tid >> 6), r32 = lane & 31, hi = lane >> 5;
    const int c = 63 - (item >> 6), rem = item & 63, b = rem >> 3, sg = rem & 7;
    const int n = 64 * (c + 1), t0 = 64 * c + 8 * sg; const size_t rowbase = (size_t)b * SEQ;
    LAS float* sc = (LAS float*)lds;
    bf16x8 af[2][2]; float wv[2][16];
#pragma unroll
    for (int rb = 0; rb < 2; ++rb) {
#pragma unroll
        for (int s = 0; s < 2; ++s) af[rb][s] = ops.af[rb][s];
#pragma unroll
        for (int q2 = 0; q2 < 2; ++q2) {
#pragma unroll
            for (int j = 0; j < 8; ++j) wv[rb][8 * q2 + j] = bf2f((bf16)ops.w8[rb][q2][j]); }
    }
    {
        const int nkb = n >> 5;
        const bf16* kp0 = KIDX + (rowbase + r32) * 32 + 8 * hi;
        bf16x8 cb[2][2], nb[2][2];
#pragma unroll
        for (int u = 0; u < 2; ++u) { cb[u][0] = ops.cb[u][0]; cb[u][1] = ops.cb[u][1]; }
        for (int kb = wave; kb < nkb; kb += 2 * NWAVES) {
#pragma unroll
            for (int u = 0; u < 2; ++u) { const int k2 = kb + 16 + 8 * u; const int kk = k2 < nkb ? k2 : wave; const bf16* kp = kp0 + (size_t)(32 * kk) * 32; nb[u][0] = *(const bf16x8*)kp; nb[u][1] = *(const bf16x8*)(kp + 16); }
#pragma unroll
            for (int u = 0; u < 2; ++u) if (kb + 8 * u < nkb) {
                const int key = 32 * (kb + 8 * u) + r32;
#pragma unroll
                for (int rb = 0; rb < 2; ++rb) {
                    f32x16 acc = {};
                    acc = MFMA32(af[rb][0], cb[u][0], acc); acc = MFMA32(af[rb][1], cb[u][1], acc);
                    float s0 = 0.f, s1 = 0.f;
#pragma unroll
                    for (int r = 0; r < 8; ++r) { s0 = fmaf(wv[rb][r], relu_i(acc[r]), s0); s1 = fmaf(wv[rb][8 + r], relu_i(acc[8 + r]), s1); }
                    sc[(4 * rb + hi) * n + key] = s0; sc[(4 * rb + 2 + hi) * n + key] = s1;
                }
            }
#pragma unroll
            for (int u = 0; u < 2; ++u) { cb[u][0] = nb[u][0]; cb[u][1] = nb[u][1]; }
        }
    }
    __syncthreads();
    {
        const int nreg = c + 1, ngrp = (nreg + 7) >> 3;
        float v[64];
#pragma unroll
        for (int g = 0; g < 8; ++g) {
#pragma unroll
            for (int jj = 0; jj < 8; ++jj) v[8 * g + jj] = -INFINITY;
            if (g < ngrp) {
#pragma unroll
                for (int jj = 0; jj < 8; ++jj) { const int j = 8 * g + jj; if (j < nreg) v[j] = sc[wave * n + 64 * j + lane]; } } }
        float mxl = v[0], mnl = fminf(fminf(v[0], v[1]), fminf(v[2], v[3]));
#pragma unroll
        for (int g = 0; g < 8; ++g) if (g < ngrp) {
#pragma unroll
            for (int jj = 0; jj < 8; ++jj) mxl = fmaxf(mxl, v[8 * g + jj]);
            if (8 * g + 8 <= nreg) {
#pragma unroll
                for (int jj = 0; jj < 8; ++jj) mnl = fminf(mnl, v[8 * g + jj]); } }
        const float mx = wave_max_f(mxl), mn = -wave_max_f(-mnl);
        unsigned T = 0u; bool haveT = false; int c_hi = 0, neq = -1;
        if (mx > mn) {
            const float scale = 126.5f / (mx - mn);
            unsigned w[16];
#pragma unroll
            for (int q = 0; q < 16; ++q) { unsigned x = 0x80808080u;
                if (q < 2 * ngrp) {
#pragma unroll
                    for (int k = 0; k < 4; ++k) { const unsigned cc = (unsigned)((v[4 * q + k] - mn) * scale); x |= cc << (8 * k); } }
                w[q] = x; }
            unsigned p = 0u;
#pragma unroll
            for (int bit = 6; bit >= 0; --bit) { const unsigned cand = p | (1u << bit), rep = cand * 0x01010101u; int cl = 0;
#pragma unroll
                for (int g = 0; g < 8; ++g) if (g < ngrp) { cl += __builtin_popcount((w[2 * g] - rep) & 0x80808080u); cl += __builtin_popcount((w[2 * g + 1] - rep) & 0x80808080u); }
                const int cnt = wave_sum_i(cl);
                if (cnt >= 256) p = cand; else c_hi = cnt; }
            LAS unsigned* cand_l = (LAS unsigned*)(lds + AUX_OFF + wave * 512);
            int off = 0;
#pragma unroll
            for (int g = 0; g < 8; ++g) if (g < ngrp) {
#pragma unroll
                for (int jj = 0; jj < 8; ++jj) { const int j = 8 * g + jj; const bool isc = ((w[j >> 2] >> (8 * (j & 3))) & 0xffu) == (p | 0x80u); const unsigned long long bal = __builtin_amdgcn_ballot_w64(isc);
                    if (bal) { const int pos = off + (int)__builtin_amdgcn_mbcnt_hi((unsigned)(bal >> 32), __builtin_amdgcn_mbcnt_lo((unsigned)bal, 0u));
                        if (isc && pos < 128) cand_l[pos] = fkey(v[j]);
                        off += __builtin_popcountll(bal); } } }
            const int need = 256 - c_hi;
            if (off <= 128) {
                const unsigned ck0 = lane < off ? cand_l[lane] : 0u, ck1 = lane + 64 < off ? cand_l[lane + 64] : 0u;
                unsigned prefix = 0u;
                for (int bit = 31; bit >= 0; --bit) { const unsigned cd = prefix | (1u << bit);
                    const int cnt = __builtin_popcountll(__builtin_amdgcn_ballot_w64(ck0 >= cd)) + __builtin_popcountll(__builtin_amdgcn_ballot_w64(ck1 >= cd));
                    if (cnt >= need) prefix = cd; }
                T = prefix; haveT = true;
                c_hi += __builtin_popcountll(__builtin_amdgcn_ballot_w64(ck0 > T)) + __builtin_popcountll(__builtin_amdgcn_ballot_w64(ck1 > T));
                neq = __builtin_popcountll(__builtin_amdgcn_ballot_w64(ck0 == T)) + __builtin_popcountll(__builtin_amdgcn_ballot_w64(ck1 == T));
            }
        }
        if (!haveT) {
            unsigned prefix = 0u;
            for (int bit = 31; bit >= 0; --bit) { const unsigned cd = prefix | (1u << bit); int cnt = 0;
#pragma unroll
                for (int g = 0; g < 8; ++g) if (g < ngrp) {
#pragma unroll
                    for (int jj = 0; jj < 8; ++jj) cnt += __builtin_popcountll(__builtin_amdgcn_ballot_w64(fkey(v[8 * g + jj]) >= cd)); }
                if (cnt >= 256) prefix = cd; }
            T = prefix; c_hi = 0;
#pragma unroll
            for (int g = 0; g < 8; ++g) if (g < ngrp) {
#pragma unroll
                for (int jj = 0; jj < 8; ++jj) c_hi += __builtin_popcountll(__builtin_amdgcn_ballot_w64(fkey(v[8 * g + jj]) > T)); }
        }
        int remn = 256 - c_hi; unsigned mlo = 0u, mhi = 0u;
        if (neq == remn) {
            const float Tf = __uint_as_float((T & 0x80000000u) ? (T & 0x7fffffffu) : ~T);
#pragma unroll
            for (int g = 0; g < 8; ++g) if (g < ngrp) {
#pragma unroll
                for (int jj = 0; jj < 8; ++jj) { const int j = 8 * g + jj; const unsigned long long ww = __builtin_amdgcn_ballot_w64(v[j] >= Tf); const unsigned wl = (unsigned)ww, wh2 = (unsigned)(ww >> 32);
                    asm volatile("s_nop 4\n\tv_writelane_b32 %0, %1, %2" : "+v"(mlo) : "s"(wl), "n"(j));
                    asm volatile("v_writelane_b32 %0, %1, %2" : "+v"(mhi) : "s"(wh2), "n"(j)); } }
        } else {
#pragma unroll
            for (int g = 0; g < 8; ++g) if (g < ngrp) {
#pragma unroll
                for (int jj = 0; jj < 8; ++jj) { const int j = 8 * g + jj;
                    const unsigned kj = fkey(v[j]);
                    const unsigned long long gt = __builtin_amdgcn_ballot_w64(kj > T); unsigned long long eq = __builtin_amdgcn_ballot_w64(kj == T);
                    if (eq) { const int ne = __builtin_popcountll(eq);
                        if (ne > remn) { unsigned long long tk = 0ull; for (int i = 0; i < remn; ++i) { const unsigned long long lb = eq & (0ull - eq); tk |= lb; eq ^= lb; } eq = tk; remn = 0; }
                        else remn -= ne; }
                    const unsigned long long ww = gt | eq; const unsigned wl = (unsigned)ww, wh2 = (unsigned)(ww >> 32);
                    asm volatile("s_nop 4\n\tv_writelane_b32 %0, %1, %2" : "+v"(mlo) : "s"(wl), "n"(j));
                    asm volatile("v_writelane_b32 %0, %1, %2" : "+v"(mhi) : "s"(wh2), "n"(j)); } }
        }
        if (lane < nreg) MASK[(rowbase + t0 + wave) * 64 + lane] = ((unsigned long long)mhi << 32) | mlo;
    }
    __syncthreads();
}

DI s16x4 vtr(const LAS unsigned char* p) { return __builtin_bit_cast(s16x4, __builtin_amdgcn_ds_read_tr16_b64_v4i16((LAS v4i16_t*)p)); }

template <int DV, bool BIAS, bool MASK, int KS = 4  >
DI void attn_pass(LAS unsigned char* lds, const bf16* Q, const bf16* K, const bf16* V, int pq, int pk, int pv, int q0, int nt, const unsigned long long* maskb, float cfar, f32x16 (&oT)[DV / 32], int tid) {
    constexpr int ND = DV / 32, NV = DV / 64;
    asm volatile("" : "+v"(tid));
    const int lane = tid & 63, wave = __builtin_amdgcn_readfirstlane(tid >> 6), r32 = lane & 31, hi = lane >> 5;
    const int qw0 = q0 + 32 * wave, mylimit = (qw0 >> 6) + 1;
    const LAS float* lut = (const LAS float*)(lds + AUX_OFF);
    float m_ref = -64.f;
    constexpr bool LMF = (DV == 64);
    f32x16 lacc = {}; float l_run = 0.f;
    const short one_hi0 = hi == 0 ? (short)0x3F80 : (short)0;
    const bf16x8 kx = {one_hi0, one_hi0, one_hi0, 0, 0, 0, 0, 0};
    bf16x8 qx;
#define SET_QX() do { const float c_ = cfar - m_ref; const unsigned b1_ = cvtpk(c_, 0.f) & 0xffffu; const float r1_ = c_ - __uint_as_float(b1_ << 16); const unsigned b2_ = cvtpk(r1_, 0.f) & 0xffffu; \
        const float r2_ = r1_ - __uint_as_float(b2_ << 16); const unsigned b3_ = cvtpk(r2_, 0.f) & 0xffffu; \
        qx = (bf16x8){(short)(hi == 0 ? b1_ : 0u), (short)(hi == 0 ? b2_ : 0u), (short)(hi == 0 ? b3_ : 0u), 0, 0, 0, 0, 0}; } while (0)
    SET_QX();
    const bf16x8 ones = {0x3F80, 0x3F80, 0x3F80, 0x3F80, 0x3F80, 0x3F80, 0x3F80, 0x3F80};
#pragma unroll
    for (int d = 0; d < ND; ++d) oT[d] = (f32x16){};
    bf16x8 qf[4];
#pragma unroll
    for (int d0 = 0; d0 < 4; ++d0) qf[d0] = *(const bf16x8*)(Q + (size_t)(qw0 + r32) * pq + 16 * d0 + 8 * hi);
    LAS bf16x8* qpark = (LAS bf16x8*)(lds + 49152 + wave * 4096) + lane;
    if constexpr (ND == 4) {
#pragma unroll
        for (int d0 = 0; d0 < 4; ++d0) qpark[d0 * 64] = qf[d0];
    }
    const bf16* ksrc = K + (size_t)lane * pk + wave * 8;
    const bf16* vsrc[NV];
#pragma unroll
    for (int i = 0; i < NV; ++i) { const int p = wave + 8 * i, dh = p >> 2, rg = p & 3; vsrc[i] = V + (size_t)(rg * 16 + (lane >> 2)) * pv + dh * 32 + (lane & 3) * 8; }
    LAS unsigned char* kdst = lds + wave * 1024 + lane * 16;
    LAS unsigned char* vdst = lds + 16384 + wave * 1024 + lane * 16;
    const LAS unsigned char* kfr = lds + hi * 1024 + r32 * 16;
    const LAS unsigned char* vfr = lds + 16384 + ((lane >> 4) & 1) * 32 + (lane & 3) * 8 + (4 * hi + ((lane & 15) >> 2)) * 64;
    u32x4 kA, vA[NV], kB, vB[NV];
#define AT_LOAD(t, KR, VR) do { KR = *(const u32x4*)(ksrc + (size_t)(t) * 64 * pk); _Pragma("unroll") for (int i = 0; i < NV; ++i) VR[i] = *(const u32x4*)(vsrc[i] + (size_t)(t) * 64 * pv); } while (0)
#define AT_STORE(buf, KR, VR) do { *(LAS u32x4*)(kdst + (buf) * 8192) = KR; _Pragma("unroll") for (int i = 0; i < NV; ++i) *(LAS u32x4*)(vdst + (buf) * 16384 + i * 8192) = VR[i]; } while (0)
    AT_LOAD(0, kA, vA); AT_LOAD(1, kB, vB);
    AT_STORE(0, kA, vA);
    __syncthreads();
#define SB() __builtin_amdgcn_sched_barrier(0)
#define VFRAG(SET, d) do { _Pragma("unroll") for (int ks = 0; ks < 4; ++ks) { SET[2 * ks] = vtr(vb + (d) * 4096 + ks * 1024); SET[2 * ks + 1] = vtr(vb + (d) * 4096 + ks * 1024 + 512); } } while (0)
#define VMMA(SET, d) do { _Pragma("unroll") for (int ks = 0; ks < 4; ++ks) { const bf16x8 vf = {SET[2 * ks][0], SET[2 * ks][1], SET[2 * ks][2], SET[2 * ks][3], SET[2 * ks + 1][0], SET[2 * ks + 1][1], SET[2 * ks + 1][2], SET[2 * ks + 1][3]}; \
        oT[d] = MFMA32(vf, __builtin_bit_cast(bf16x8, pw[ks]), oT[d]); } } while (0)
    auto compute = [&](const int kt, const int cur) __attribute__((always_inline)) {
        if (kt < mylimit) {
            unsigned long long mw = 0ull;
            if (MASK) mw = maskb[(size_t)(qw0 + r32) * 64 + kt];
            const int relb = kt * 64 - qw0;
            const bool nearb = BIAS && (relb + 63 > -91);
            f32x16 p0, p1;
            const LAS unsigned char* kb = kfr + cur * 8192;
            const LAS unsigned char* vb = vfr + cur * 16384;
            if constexpr (ND == 2) {
                bf16x8 kf[8];
#pragma unroll
                for (int d0 = 0; d0 < KS; ++d0) { kf[2 * d0] = *(const LAS bf16x8*)(kb + d0 * 2048); kf[2 * d0 + 1] = *(const LAS bf16x8*)(kb + d0 * 2048 + 512); }
                SB();
                p0 = MFMA32(kx, qx, (f32x16){}); p1 = MFMA32(kx, qx, (f32x16){});
#pragma unroll
                for (int d0 = 0; d0 < KS; ++d0) { p0 = MFMA32(kf[2 * d0], qf[d0], p0); p1 = MFMA32(kf[2 * d0 + 1], qf[d0], p1); }
            } else {
                bf16x8 kf[4], qh[2];
#pragma unroll
                for (int d0 = 0; d0 < 2; ++d0) { kf[2 * d0] = *(const LAS bf16x8*)(kb + d0 * 2048); kf[2 * d0 + 1] = *(const LAS bf16x8*)(kb + d0 * 2048 + 512); qh[d0] = qpark[d0 * 64]; }
                SB();
                p0 = MFMA32(kx, qx, (f32x16){}); p1 = MFMA32(kx, qx, (f32x16){});
                p0 = MFMA32(kf[0], qh[0], p0); p1 = MFMA32(kf[1], qh[0], p1); p0 = MFMA32(kf[2], qh[1], p0); p1 = MFMA32(kf[3], qh[1], p1);
                SB();
#pragma unroll
                for (int d0 = 0; d0 < 2; ++d0) { kf[2 * d0] = *(const LAS bf16x8*)(kb + (d0 + 2) * 2048); kf[2 * d0 + 1] = *(const LAS bf16x8*)(kb + (d0 + 2) * 2048 + 512); qh[d0] = qpark[(d0 + 2) * 64]; }
                SB();
                p0 = MFMA32(kf[0], qh[0], p0); p1 = MFMA32(kf[1], qh[0], p1); p0 = MFMA32(kf[2], qh[1], p0); p1 = MFMA32(kf[3], qh[1], p1);
            }
            SB();
            s16x4 vs0[8], vs1[8];
            VFRAG(vs0, 0); if constexpr (ND == 2) VFRAG(vs1, 1);
            SB();
            if (BIAS) { if (nearb) { const LAS float* lb = lut + (relb + 192 - r32 + 4 * hi);
#pragma unroll
                for (int r = 0; r < 16; ++r) { const int cc = (r & 3) + 8 * (r >> 2); p0[r] += lb[cc]; p1[r] += lb[cc + 32]; } } }
#pragma unroll
            for (int r = 0; r < 16; ++r) { p0[r] = __builtin_amdgcn_exp2f(p0[r]); p1[r] = __builtin_amdgcn_exp2f(p1[r]); }
            if (MASK) { const unsigned mlo = (unsigned)mw >> (4 * hi), mhi = (unsigned)(mw >> 32) >> (4 * hi);
#pragma unroll
                for (int r = 0; r < 16; ++r) { const int cc = (r & 3) + 8 * (r >> 2);
                    p0[r] = __int_as_float(__float_as_int(p0[r]) & ((int)(mlo << (31 - cc)) >> 31)); p1[r] = __int_as_float(__float_as_int(p1[r]) & ((int)(mhi << (31 - cc)) >> 31)); } }
            float em = fmaxf(p0[0], p1[0]);
#pragma unroll
            for (int r = 1; r < 16; ++r) em = fmaxf(em, fmaxf(p0[r], p1[r]));
            em = halfswap_max(em);
            if (__any(em > 256.f)) {
                const float dl = fmaxf(__builtin_amdgcn_logf(em), 0.f), alpha = __builtin_amdgcn_exp2f(-dl); m_ref += dl; SET_QX();
#pragma unroll
                for (int r = 0; r < 16; ++r) { p0[r] *= alpha; p1[r] *= alpha; if (LMF) lacc[r] *= alpha; }
                l_run *= alpha;
#pragma unroll
                for (int d = 0; d < ND; ++d)
#pragma unroll
                    for (int r = 0; r < 16; ++r) oT[d][r] *= alpha; }
            if (!LMF) {
#pragma unroll
                for (int r = 0; r < 16; ++r) l_run += p0[r] + p1[r]; }
            u32x4 pw[4];
#pragma unroll
            for (int s = 0; s < 2; ++s) { pw[s] = (u32x4){cvtpk(p0[8 * s], p0[8 * s + 1]), cvtpk(p0[8 * s + 2], p0[8 * s + 3]), cvtpk(p0[8 * s + 4], p0[8 * s + 5]), cvtpk(p0[8 * s + 6], p0[8 * s + 7])};
                pw[2 + s] = (u32x4){cvtpk(p1[8 * s], p1[8 * s + 1]), cvtpk(p1[8 * s + 2], p1[8 * s + 3]), cvtpk(p1[8 * s + 4], p1[8 * s + 5]), cvtpk(p1[8 * s + 6], p1[8 * s + 7])}; }
            SB();
            if constexpr (ND == 2) {
                VMMA(vs0, 0); VMMA(vs1, 1);
#pragma unroll
                for (int ks = 0; ks < 4; ++ks) if (LMF) lacc = MFMA32(ones, __builtin_bit_cast(bf16x8, pw[ks]), lacc);
            } else {
                VFRAG(vs1, 1); SB();
                VMMA(vs0, 0); SB();
                VFRAG(vs0, 2); SB();
                VMMA(vs1, 1); SB();
                VFRAG(vs1, 3); SB();
                VMMA(vs0, 2); SB();
                VMMA(vs1, 3);
            }
            SB();
        }
    };
    for (int kt = 0; kt < nt; kt += 2) {
        { const int t2 = kt + 2 < nt ? kt + 2 : nt - 1; AT_LOAD(t2, kA, vA); }
        compute(kt, 0);
        AT_STORE(1, kB, vB);
        __syncthreads();
        { const int t3 = kt + 3 < nt ? kt + 3 : nt - 1; AT_LOAD(t3, kB, vB); }
        compute(kt + 1, 1);
        AT_STORE(0, kA, vA);
        __syncthreads();
    }
#undef SET_QX
#undef AT_LOAD
#undef AT_STORE
#undef SB
#undef VFRAG
#undef VMMA
    const float inv = 1.f / (LMF ? lacc[0] : halfswap_sum(l_run));
#pragma unroll
    for (int d = 0; d < ND; ++d)
#pragma unroll
        for (int r = 0; r < 16; ++r) oT[d][r] *= inv;
}

#define H64_SBAR() __builtin_amdgcn_sched_barrier(0)
DI void glds16s(const void* base, unsigned voff, unsigned lds_base) {
    unsigned sv; asm volatile("s_mov_b32 %0, m0\n\ts_mov_b32 m0, %3\n\ts_nop 0\n\tglobal_load_lds_dwordx4 %1, %2\n\ts_mov_b32 m0, %0" : "=&s"(sv) : "v"(voff), "s"(base), "s"(lds_base) : "memory"); }
DI void glds4s(const void* base, unsigned voff, unsigned lds_base) {
    unsigned sv; asm volatile("s_mov_b32 %0, m0\n\ts_mov_b32 m0, %3\n\ts_nop 0\n\tglobal_load_lds_dword %1, %2\n\ts_mov_b32 m0, %0" : "=&s"(sv) : "v"(voff), "s"(base), "s"(lds_base) : "memory"); }
DI void gld64s(unsigned long long& dst, const void* base, unsigned voff) { asm volatile("global_load_dwordx2 %0, %1, %2" : "=&v"(dst) : "v"(voff), "s"(base) : "memory"); }
#define H64_PIN(x) asm volatile("" : "+v"(x))
template <bool BIAS, bool MASK, int KS>
DI void attn_pass_h64(LAS unsigned char* lds, const bf16* Q, const bf16* K, const bf16* V, int pq, int pk, int pv, int q0, int nt, const unsigned long long* maskb, float cfar, f32x16 (&oT)[2], int tid, const LAS float* lut, gu32* popq, int& popv) {
    asm volatile("" : "+v"(tid));
    const int lane = tid & 63, wave = __builtin_amdgcn_readfirstlane(tid >> 6), r32 = lane & 31, hi = lane >> 5;
    const int qw0 = q0 + 32 * wave, mylimit = (qw0 >> 6) + 1, NT = nt;
    constexpr int SLOTB = 8192, LDS_V = 3 * SLOTB;
    const unsigned koff = (unsigned)(lane * pk + wave * 8) * 2u, voff = (unsigned)((16 * (wave & 3) + (lane >> 2)) * pv + (wave >> 2) * 32 + (lane & 3) * 8) * 2u;
    const unsigned kdst_u = (unsigned)(unsigned long)(lds + wave * 1024), vdst_u = (unsigned)(unsigned long)(lds + LDS_V + wave * 1024);
#define DMA_K(t, slot) glds16s(K + (size_t)(t) * 64 * pk, koff, (unsigned)__builtin_amdgcn_readfirstlane((int)(kdst_u + (unsigned)(slot))))
#define DMA_V(t, slot) glds16s(V + (size_t)(t) * 64 * pv, voff, (unsigned)__builtin_amdgcn_readfirstlane((int)(vdst_u + (unsigned)(slot))))
#define WAIT_BAR(N) asm volatile("s_waitcnt vmcnt(" #N ") lgkmcnt(0)\n\ts_barrier" ::: "memory")
    const LAS unsigned char* vp0 = lds + LDS_V + ((lane >> 4) & 1) * 32 + (lane & 3) * 8 + (4 * hi + ((lane & 15) >> 2)) * 64;
    const LAS unsigned char* kp0 = lds + hi * 1024 + r32 * 16;
    const unsigned moff = (unsigned)(qw0 + r32) * 512u + 4u * (unsigned)hi;
    const unsigned mdst_u = (unsigned)(unsigned long)(lds + 49152 + wave * 512);
    const LAS unsigned* mrd = (const LAS unsigned*)(lds + 49152 + wave * 512) + r32;
#define DMA_M(t) glds4s(maskb + (t), moff, (unsigned)__builtin_amdgcn_readfirstlane((int)(mdst_u + 256u * ((unsigned)(t) & 1u))))
#define MREAD(t) do { const LAS unsigned* p_ = mrd + 64 * ((t) & 1); mwc = (unsigned long long)p_[0] | ((unsigned long long)p_[32] << 32); } while (0)
    unsigned long long mwc = ~0ull;
    DMA_K(0, 0); DMA_V(0, 0); DMA_K(1, SLOTB);
    if (MASK) DMA_M(0);
    bf16x8 qf[4];
#pragma unroll
    for (int d0 = 0; d0 < KS; ++d0) qf[d0] = *(const bf16x8*)(Q + (size_t)(qw0 + r32) * pq + 16 * d0 + 8 * hi);
    float m_ref = 0.f, l_reg = 0.f, fsc = 1.f; bool resc = false;
    const short one_hi0 = hi == 0 ? (short)0x3F80 : (short)0;
    const bf16x8 kx = {one_hi0, one_hi0, one_hi0, 0, 0, 0, 0, 0};
    bf16x8 qx;
#define SET_QX() do { const float c_ = cfar - m_ref; const unsigned b1_ = cvtpk(c_, 0.f) & 0xffffu; const float r1_ = c_ - __uint_as_float(b1_ << 16); const unsigned b2_ = cvtpk(r1_, 0.f) & 0xffffu; \
        const float r2_ = r1_ - __uint_as_float(b2_ << 16); const unsigned b3_ = cvtpk(r2_, 0.f) & 0xffffu; \
        qx = (bf16x8){(short)(hi == 0 ? b1_ : 0u), (short)(hi == 0 ? b2_ : 0u), (short)(hi == 0 ? b3_ : 0u), 0, 0, 0, 0, 0}; } while (0)
    SET_QX();
    oT[0] = (f32x16){}; oT[1] = (f32x16){};
    f32x16 pA0, pA1, pB0, pB1; bf16x8 kf[8]; s16x4 vlo[4], vhi[4]; u32x4 pw0, pw1, pw2, pw3;
    int sl_prev = 0, sl_cur = 0, sl_next = SLOTB;
#define ROT() do { sl_prev = sl_cur; sl_cur = sl_next; sl_next = (sl_next == 2 * SLOTB) ? 0 : sl_next + SLOTB; } while (0)
#define KLOAD2(kp, d0) do { kf[2 * (d0)] = *(const LAS bf16x8*)((kp) + (d0) * 2048); kf[2 * (d0) + 1] = *(const LAS bf16x8*)((kp) + (d0) * 2048 + 512); } while (0)
#define MX3(a, b, c) fmaxf(fmaxf((a), (b)), (c))
#define ROWMAX(p0, p1, out) do { float a_ = MX3(p0[0], p0[1], p1[0]), b_ = MX3(p0[2], p0[3], p1[1]); a_ = MX3(a_, p1[2], p1[3]); \
        _Pragma("unroll") for (int r = 4; r < 16; r += 4) { a_ = MX3(a_, p0[r], p0[r + 1]); b_ = MX3(b_, p0[r + 2], p0[r + 3]); a_ = MX3(a_, p1[r], p1[r + 1]); b_ = MX3(b_, p1[r + 2], p1[r + 3]); } \
        out = halfswap_max(fmaxf(a_, b_)); } while (0)
#define MBIT(mw_, cc) __builtin_amdgcn_sbfe((int)(mw_), (cc), 1)
#define CROW(r) (((r) & 3) + 8 * ((r) >> 2))
#define EXM(X, i, mw_) do { X[i] = __builtin_amdgcn_exp2f(X[i]); if (MASK) X[i] = __int_as_float(__float_as_int(X[i]) & MBIT(mw_, CROW(i))); } while (0)
#define BIASADD(C0, C1, t) do { if (BIAS) { const int relb = (t) * 64 - qw0; if (relb + 63 > -91) { const LAS float* lb = lut + (relb + 192 - r32 + 4 * hi); \
        _Pragma("unroll") for (int r = 0; r < 16; ++r) { C0[r] += lb[CROW(r)]; C1[r] += lb[CROW(r) + 32]; } } } } while (0)
    DMA_K(2, 2 * SLOTB);
    WAIT_BAR(3);
    if (MASK) MREAD(0);
#pragma unroll
    for (int d0 = 0; d0 < KS; ++d0) KLOAD2(kp0, d0);
    pA0 = MFMA32(kx, qx, (f32x16){}); pA1 = MFMA32(kx, qx, (f32x16){});
#pragma unroll
    for (int d0 = 0; d0 < KS; ++d0) { pA0 = MFMA32(kf[2 * d0], qf[d0], pA0); pA1 = MFMA32(kf[2 * d0 + 1], qf[d0], pA1); }
    BIASADD(pA0, pA1, 0);
    { float rm; ROWMAX(pA0, pA1, rm); m_ref = rm;
      const unsigned mlo0 = (unsigned)mwc >> (4 * hi), mhi0 = (unsigned)(mwc >> 32) >> (4 * hi);
#pragma unroll
      for (int r = 0; r < 16; ++r) { pA0[r] -= rm; pA1[r] -= rm; EXM(pA0, r, mlo0); EXM(pA1, r, mhi0); } }
    SET_QX();
    if (MASK) DMA_M(1);
    WAIT_BAR(0);
    DMA_K(3, 0); DMA_V(1, SLOTB); ROT();
#pragma unroll
    for (int d0 = 0; d0 < KS; ++d0) KLOAD2(kp0 + sl_cur, d0);
    WAIT_BAR(2);
#define PKW(P, i) cvtpk(P[i], P[i + 1])
#define PAF(k) __builtin_bit_cast(bf16x8, pw##k)
#define VFR(j) (bf16x8){vlo[(j) & 3][0], vlo[(j) & 3][1], vlo[(j) & 3][2], vlo[(j) & 3][3], vhi[(j) & 3][0], vhi[(j) & 3][1], vhi[(j) & 3][2], vhi[(j) & 3][3]}
#define VRD(j) do { vlo[(j) & 3] = vtr(vp_ + (((j) & 1) * 4096 + ((j) >> 1) * 1024)); vhi[(j) & 3] = vtr(vp_ + (((j) & 1) * 4096 + ((j) >> 1) * 1024 + 512)); } while (0)
#define KRD(G, d0) do { if ((G) && (d0) < KS) { KLOAD2(kp0 + sl_next, d0); H64_SBAR(); } } while (0)
#define GAPA(MF, a0, a1, a2, a3, W0, W1, PW) do { MF; sacc += a0; sacc += a1; sacc += a2; sacc += a3; W0; W1; H64_PIN(PW); H64_PIN(sacc); H64_SBAR(); } while (0)
#define GAPB(MF, X, i, mw_) do { MF; EXM(X, i, mw_); EXM(X, (i) + 1, mw_); EXM(X, (i) + 2, mw_); EXM(X, (i) + 3, mw_); H64_PIN(X); H64_SBAR(); } while (0)
#define QKA(C0, C1, g) (KS == 4 ? ((g) & 1 ? (C1 = MFMA32(kf[g], qf[(g) >> 1], C1)) : (C0 = MFMA32(kf[g], qf[(g) >> 1], C0))) \
                                : ((g) < 2 ? ((g) & 1 ? (C1 = MFMA32(kx, qx, (f32x16){})) : (C0 = MFMA32(kx, qx, (f32x16){}))) \
                                           : ((g) & 1 ? (C1 = MFMA32(kf[(g) - 2], qf[((g) - 2) >> 1], C1)) : (C0 = MFMA32(kf[(g) - 2], qf[((g) - 2) >> 1], C0)))))
#define STEP(C0, C1, P0, P1, t, BAND, GK, GV, GL) do { H64_SBAR(); \
    if (MASK) { MREAD(t); if (GV) DMA_M((t) + 1); } \
    const LAS unsigned char* vp_ = vp0 + sl_prev; \
    if (KS == 4) { C0 = MFMA32(kx, qx, (f32x16){}); C1 = MFMA32(kx, qx, (f32x16){}); H64_SBAR(); } \
    VRD(0); H64_SBAR(); float sacc = P0[0] + P0[1]; \
                        GAPA(QKA(C0, C1, 0), P0[2], P0[3], P0[4], P0[5],     pw0[0] = PKW(P0, 0),  pw0[1] = PKW(P0, 2),  pw0); \
    VRD(1); H64_SBAR(); GAPA(QKA(C0, C1, 1), P0[6], P0[7], P0[8], P0[9],     pw0[2] = PKW(P0, 4),  pw0[3] = PKW(P0, 6),  pw0); \
    VRD(2); H64_SBAR(); GAPA(QKA(C0, C1, 2), P0[10], P0[11], P0[12], P0[13], pw1[0] = PKW(P0, 8),  pw1[1] = PKW(P0, 10), pw1); \
    VRD(3); H64_SBAR(); GAPA(QKA(C0, C1, 3), P0[14], P0[15], P1[0], P1[1],   pw1[2] = PKW(P0, 12), pw1[3] = PKW(P0, 14), pw1); \
                        GAPA(QKA(C0, C1, 4), P1[2], P1[3], P1[4], P1[5],     pw2[0] = PKW(P1, 0),  pw2[1] = PKW(P1, 2),  pw2); \
                        GAPA(QKA(C0, C1, 5), P1[6], P1[7], P1[8], P1[9],     pw2[2] = PKW(P1, 4),  pw2[3] = PKW(P1, 6),  pw2); \
                        GAPA(QKA(C0, C1, 6), P1[10], P1[11], P1[12], P1[13], pw3[0] = PKW(P1, 8),  pw3[1] = PKW(P1, 10), pw3); \
                        GAPA(QKA(C0, C1, 7), P1[14], P1[15], 0.f, 0.f,       pw3[2] = PKW(P1, 12), pw3[3] = PKW(P1, 14), pw3); \
    l_reg += sacc; \
    if (GK) DMA_K((t) + 3, sl_cur); if (GV) DMA_V((t) + 1, sl_next); \
    if (BAND) { if ((t) >= mylimit) { _Pragma("unroll") for (int r = 0; r < 16; ++r) { C0[r] = -INFINITY; C1[r] = -INFINITY; } } } \
    BIASADD(C0, C1, t); \
    { float rm; ROWMAX(C0, C1, rm); resc = false; \
      if (__builtin_expect(__any(rm > 8.f), 0)) { const float dl = fmaxf(rm, 0.f); m_ref += dl; fsc = __builtin_amdgcn_exp2f(-dl); l_reg *= fsc; resc = true; SET_QX(); \
          _Pragma("unroll") for (int r = 0; r < 16; ++r) { C0[r] -= dl; C1[r] -= dl; } } } \
    const unsigned mlo_ = (unsigned)mwc >> (4 * hi), mhi_ = (unsigned)(mwc >> 32) >> (4 * hi); H64_SBAR(); \
    GAPB(oT[0] = MFMA32(VFR(0), PAF(0), oT[0]), C0, 0, mlo_);  VRD(4); H64_SBAR(); GAPB(oT[1] = MFMA32(VFR(1), PAF(0), oT[1]), C0, 4, mlo_);  VRD(5); H64_SBAR(); \
    KRD(GL, 0); GAPB(oT[0] = MFMA32(VFR(2), PAF(1), oT[0]), C0, 8, mlo_);  VRD(6); H64_SBAR(); KRD(GL, 1); GAPB(oT[1] = MFMA32(VFR(3), PAF(1), oT[1]), C0, 12, mlo_); VRD(7); H64_SBAR(); \
    KRD(GL, 2); GAPB(oT[0] = MFMA32(VFR(4), PAF(2), oT[0]), C1, 0, mhi_);  KRD(GL, 3); GAPB(oT[1] = MFMA32(VFR(5), PAF(2), oT[1]), C1, 4, mhi_); \
    GAPB(oT[0] = MFMA32(VFR(6), PAF(3), oT[0]), C1, 8, mhi_);              GAPB(oT[1] = MFMA32(VFR(7), PAF(3), oT[1]), C1, 12, mhi_); \
    } while (0)
#define RESC() do { if (resc) { _Pragma("unroll") for (int r = 0; r < 16; ++r) { oT[0][r] *= fsc; oT[1][r] *= fsc; } } } while (0)
    int t = 1;
    for (; t + 5 < NT; t += 2) {
        STEP(pB0, pB1, pA0, pA1, t, false, true, true, true);     WAIT_BAR(2); RESC(); ROT();
        STEP(pA0, pA1, pB0, pB1, t + 1, false, true, true, true); WAIT_BAR(2); RESC(); ROT();
    }
#define ENDW(tt) do { if ((tt) + 3 < NT) { WAIT_BAR(2); } else if ((tt) + 2 < NT) { WAIT_BAR(1); } else { WAIT_BAR(0); } } while (0)
    for (; t + 1 < NT; t += 2) {
        STEP(pB0, pB1, pA0, pA1, t, true, (t + 3 < NT), (t + 1 < NT), (t + 1 < NT));         ENDW(t);     RESC(); ROT();
        STEP(pA0, pA1, pB0, pB1, t + 1, true, (t + 4 < NT), (t + 2 < NT), (t + 2 < NT));     ENDW(t + 1); RESC(); ROT();
    }
    if (popq != nullptr && tid == 0) popv = (int)__hip_atomic_fetch_add(popq, 1u, RLX_AGENT);
    STEP(pB0, pB1, pA0, pA1, NT - 1, true, false, false, false); RESC();
    { float sacc = pB0[0] + pB0[1];
#pragma unroll
      for (int r = 2; r < 16; ++r) sacc += pB0[r];
#pragma unroll
      for (int r = 0; r < 16; ++r) sacc += pB1[r];
      l_reg += sacc;
      pw0 = (u32x4){PKW(pB0, 0), PKW(pB0, 2), PKW(pB0, 4), PKW(pB0, 6)}; pw1 = (u32x4){PKW(pB0, 8), PKW(pB0, 10), PKW(pB0, 12), PKW(pB0, 14)};
      pw2 = (u32x4){PKW(pB1, 0), PKW(pB1, 2), PKW(pB1, 4), PKW(pB1, 6)}; pw3 = (u32x4){PKW(pB1, 8), PKW(pB1, 10), PKW(pB1, 12), PKW(pB1, 14)};
      const LAS unsigned char* vp_ = vp0 + sl_cur;
      VRD(0); VRD(1); VRD(2); VRD(3);
      oT[0] = MFMA32(VFR(0), PAF(0), oT[0]); oT[1] = MFMA32(VFR(1), PAF(0), oT[1]); oT[0] = MFMA32(VFR(2), PAF(1), oT[0]); oT[1] = MFMA32(VFR(3), PAF(1), oT[1]); H64_SBAR();
      VRD(4); VRD(5); VRD(6); VRD(7);
      oT[0] = MFMA32(VFR(4), PAF(2), oT[0]); oT[1] = MFMA32(VFR(5), PAF(2), oT[1]); oT[0] = MFMA32(VFR(6), PAF(3), oT[0]); oT[1] = MFMA32(VFR(7), PAF(3), oT[1]); }
    const float inv = 1.f / halfswap_sum(l_reg);
#pragma unroll
    for (int d = 0; d < 2; ++d)
#pragma unroll
        for (int r = 0; r < 16; ++r) oT[d][r] *= inv;
    asm volatile("s_waitcnt lgkmcnt(0)\n\ts_barrier" ::: "memory");
#undef DMA_M
#undef MREAD
#undef DMA_K
#undef DMA_V
#undef WAIT_BAR
#undef SET_QX
#undef ROT
#undef KLOAD2
#undef MX3
#undef ROWMAX
#undef MBIT
#undef CROW
#undef EXM
#undef BIASADD
#undef PKW
#undef PAF
#undef VFR
#undef VRD
#undef KRD
#undef GAPA
#undef GAPB
#undef QKA
#undef STEP
#undef RESC
#undef ENDW
}

template <bool BIAS, bool PRE, bool NEXT>
DI void attn_pass_h128(LAS unsigned char* lds, const bf16* Q, const bf16* K, const bf16* V, int pq, int pk, int pv, int q0, int nt, const unsigned long long* maskb, float cfar, f32x16 (&oT)[4], int tid, const LAS float* lut,
                       const bf16* Qn, const bf16* Kn, int& s0, bf16x8 (&qf)[4], gu32* popq, int& popv) {
    constexpr bool MASK = false; constexpr int KS = 4;
    asm volatile("" : "+v"(tid));
    const int lane = tid & 63, wave = __builtin_amdgcn_readfirstlane(tid >> 6), r32 = lane & 31, hi = lane >> 5;
    const int qw0 = q0 + 32 * wave, mylimit = (qw0 >> 6) + 1, NT = nt;
    constexpr int SLOTB = 8192, VSLOTB = 16384, LDS_V = 3 * SLOTB;
    const unsigned koff = (unsigned)(lane * pk + wave * 8) * 2u, voff = (unsigned)((16 * (wave & 3) + (lane >> 2)) * pv + (wave >> 2) * 32 + (lane & 3) * 8) * 2u;
    const unsigned kdst_u = (unsigned)(unsigned long)(lds + wave * 1024), vdst_u = (unsigned)(unsigned long)(lds + LDS_V + wave * 1024);
#define DMA_K(t, slot) glds16s(K + (size_t)(t) * 64 * pk, koff, (unsigned)__builtin_amdgcn_readfirstlane((int)(kdst_u + (unsigned)(slot))))
#define DMA_KN(t, slot) glds16s(Kn + (size_t)(t) * 64 * pk, koff, (unsigned)__builtin_amdgcn_readfirstlane((int)(kdst_u + (unsigned)(slot))))
#define DMA_V(t, slot) do { glds16s(V + (size_t)(t) * 64 * pv, voff, (unsigned)__builtin_amdgcn_readfirstlane((int)(vdst_u + 2u * (unsigned)(slot)))); \
        glds16s(V + (size_t)(t) * 64 * pv + 64, voff, (unsigned)__builtin_amdgcn_readfirstlane((int)(vdst_u + 2u * (unsigned)(slot) + 8192u))); } while (0)
#define WAIT_BAR(N) do { if (MASK) asm volatile("s_waitcnt vmcnt(" #N ") lgkmcnt(0)\n\ts_barrier" : "+v"(mwc), "+v"(mwn) :: "memory"); else asm volatile("s_waitcnt vmcnt(" #N ") lgkmcnt(0)\n\ts_barrier" ::: "memory"); } while (0)
    const LAS unsigned char* vp0 = lds + LDS_V + ((lane >> 4) & 1) * 32 + (lane & 3) * 8 + (4 * hi + ((lane & 15) >> 2)) * 64;
    const LAS unsigned char* kp0 = lds + hi * 1024 + r32 * 16;
    const unsigned moff = (unsigned)(qw0 + r32) * 512u;
#define MLOAD(dst, t) gld64s(dst, maskb + (t), moff)
    unsigned long long mwc = ~0ull, mwn = ~0ull;
#define NXS(x) ((x) == 2 * SLOTB ? 0 : (x) + SLOTB)
    const int b0 = PRE ? s0 : 0, b1 = NXS(b0), b2 = NXS(b1);
    if (!PRE) { DMA_K(0, b0); DMA_V(0, b0); DMA_K(1, b1); }
    if (!PRE) {
#pragma unroll
        for (int d0 = 0; d0 < KS; ++d0) qf[d0] = *(const bf16x8*)(Q + (size_t)(qw0 + r32) * pq + 16 * d0 + 8 * hi);
    }
    float m_ref = 0.f, l_reg = 0.f, fsc = 1.f; bool resc = false;
    const short one_hi0 = hi == 0 ? (short)0x3F80 : (short)0;
    const bf16x8 kx = {one_hi0, one_hi0, one_hi0, 0, 0, 0, 0, 0};
    bf16x8 qx;
#define SET_QX() do { const float c_ = cfar - m_ref; const unsigned b1_ = cvtpk(c_, 0.f) & 0xffffu; const float r1_ = c_ - __uint_as_float(b1_ << 16); const unsigned b2_ = cvtpk(r1_, 0.f) & 0xffffu; \
        const float r2_ = r1_ - __uint_as_float(b2_ << 16); const unsigned b3_ = cvtpk(r2_, 0.f) & 0xffffu; \
        qx = (bf16x8){(short)(hi == 0 ? b1_ : 0u), (short)(hi == 0 ? b2_ : 0u), (short)(hi == 0 ? b3_ : 0u), 0, 0, 0, 0, 0}; } while (0)
    SET_QX();
    oT[0] = (f32x16){}; oT[1] = (f32x16){}; oT[2] = (f32x16){}; oT[3] = (f32x16){};
    f32x16 C0, C1; bf16x8 kf[8]; s16x4 vlo[4], vhi[4]; u32x4 pw0, pw1, pw2, pw3;
    int sl_prev = b0, sl_cur = b0, sl_next = b1;
#define ROT() do { sl_prev = sl_cur; sl_cur = sl_next; sl_next = (sl_next == 2 * SLOTB) ? 0 : sl_next + SLOTB; } while (0)
#define KLOAD2(kp, d0) do { kf[2 * (d0)] = *(const LAS bf16x8*)((kp) + (d0) * 2048); kf[2 * (d0) + 1] = *(const LAS bf16x8*)((kp) + (d0) * 2048 + 512); } while (0)
#define MX3(a, b, c) fmaxf(fmaxf((a), (b)), (c))
#define ROWMAX(p0, p1, out) do { float a_ = MX3(p0[0], p0[1], p1[0]), b_ = MX3(p0[2], p0[3], p1[1]); a_ = MX3(a_, p1[2], p1[3]); \
        _Pragma("unroll") for (int r = 4; r < 16; r += 4) { a_ = MX3(a_, p0[r], p0[r + 1]); b_ = MX3(b_, p0[r + 2], p0[r + 3]); a_ = MX3(a_, p1[r], p1[r + 1]); b_ = MX3(b_, p1[r + 2], p1[r + 3]); } \
        out = halfswap_max(fmaxf(a_, b_)); } while (0)
#define MBIT(mw_, cc) ((int)((mw_) << (31 - (cc))) >> 31)
#define CROW(r) (((r) & 3) + 8 * ((r) >> 2))
#define EXM(X, i, mw_) do { X[i] = __builtin_amdgcn_exp2f(X[i]); if (MASK) X[i] = __int_as_float(__float_as_int(X[i]) & MBIT(mw_, CROW(i))); } while (0)
#define BIASADD(C0, C1, t) do { if (BIAS) { const int relb = (t) * 64 - qw0; if (relb + 63 > -91) { const LAS float* lb = lut + (relb + 192 - r32 + 4 * hi); \
        _Pragma("unroll") for (int r = 0; r < 16; ++r) { C0[r] += lb[CROW(r)]; C1[r] += lb[CROW(r) + 32]; } } } } while (0)
    if (!PRE) DMA_K(2, b2);
    WAIT_BAR(4);
#pragma unroll
    for (int d0 = 0; d0 < KS; ++d0) KLOAD2(kp0 + b0, d0);
    C0 = MFMA32(kx, qx, (f32x16){}); C1 = MFMA32(kx, qx, (f32x16){});
#pragma unroll
    for (int d0 = 0; d0 < KS; ++d0) { C0 = MFMA32(kf[2 * d0], qf[d0], C0); C1 = MFMA32(kf[2 * d0 + 1], qf[d0], C1); }
    BIASADD(C0, C1, 0);
    { float rm; ROWMAX(C0, C1, rm); m_ref = rm; float sacc = 0.f;
#pragma unroll
      for (int r = 0; r < 16; ++r) { C0[r] = __builtin_amdgcn_exp2f(C0[r] - rm); C1[r] = __builtin_amdgcn_exp2f(C1[r] - rm); sacc += C0[r] + C1[r]; }
      l_reg = sacc;
      pw0 = (u32x4){cvtpk(C0[0], C0[1]), cvtpk(C0[2], C0[3]), cvtpk(C0[4], C0[5]), cvtpk(C0[6], C0[7])}; pw1 = (u32x4){cvtpk(C0[8], C0[9]), cvtpk(C0[10], C0[11]), cvtpk(C0[12], C0[13]), cvtpk(C0[14], C0[15])};
      pw2 = (u32x4){cvtpk(C1[0], C1[1]), cvtpk(C1[2], C1[3]), cvtpk(C1[4], C1[5]), cvtpk(C1[6], C1[7])}; pw3 = (u32x4){cvtpk(C1[8], C1[9]), cvtpk(C1[10], C1[11]), cvtpk(C1[12], C1[13]), cvtpk(C1[14], C1[15])}; }
    SET_QX();
    if (MASK) MLOAD(mwn, 1);
    WAIT_BAR(0);
    if (MASK) mwc = mwn;
    DMA_K(3, b0); DMA_V(1, b1); ROT();
#pragma unroll
    for (int d0 = 0; d0 < KS; ++d0) KLOAD2(kp0 + sl_cur, d0);
    WAIT_BAR(3);
#define PKW(P, i) cvtpk(P[i], P[i + 1])
#define PAF(k) __builtin_bit_cast(bf16x8, pw##k)
#define VFR(i) (bf16x8){vlo[i][0], vlo[i][1], vlo[i][2], vlo[i][3], vhi[i][0], vhi[i][1], vhi[i][2], vhi[i][3]}
#define VRD(i) do { vlo[(i) & 3] = vtr(vp_ + (((i) & 3) * 4096 + ((i) >> 2) * 1024)); vhi[(i) & 3] = vtr(vp_ + (((i) & 3) * 4096 + ((i) >> 2) * 1024 + 512)); } while (0)
#define KRD(G, d0) do { if ((G) && (d0) < KS) { KLOAD2(kp0 + sl_next, d0); H64_SBAR(); } } while (0)
#define GAPA(MF, a0, a1, a2, a3, W0, W1, PW) do { MF; sacc += a0; sacc += a1; sacc += a2; sacc += a3; W0; W1; H64_PIN(PW); H64_PIN(sacc); H64_SBAR(); } while (0)
#define GAPB2(MF, X, i) do { MF; X[i] = __builtin_amdgcn_exp2f(X[i]); X[(i) + 1] = __builtin_amdgcn_exp2f(X[(i) + 1]); H64_PIN(X); H64_SBAR(); } while (0)
#define GAPB(MF, X, i, mw_) do { MF; EXM(X, i, mw_); EXM(X, (i) + 1, mw_); EXM(X, (i) + 2, mw_); EXM(X, (i) + 3, mw_); H64_PIN(X); H64_SBAR(); } while (0)
#define STEP(t, BAND, GK, GV, GL, GQ) do { H64_SBAR(); \
    const LAS unsigned char* vp_ = vp0 + 2 * sl_prev; \
    C0 = MFMA32(kx, qx, (f32x16){}); C1 = MFMA32(kx, qx, (f32x16){}); H64_SBAR(); \
    VRD(0); H64_SBAR(); C0 = MFMA32(kf[0], qf[0], C0); H64_SBAR(); VRD(1); H64_SBAR(); C1 = MFMA32(kf[1], qf[0], C1); H64_SBAR(); \
    VRD(2); H64_SBAR(); C0 = MFMA32(kf[2], qf[1], C0); H64_SBAR(); VRD(3); H64_SBAR(); C1 = MFMA32(kf[3], qf[1], C1); H64_SBAR(); \
    C0 = MFMA32(kf[4], qf[2], C0); H64_SBAR(); C1 = MFMA32(kf[5], qf[2], C1); H64_SBAR(); \
    C0 = MFMA32(kf[6], qf[3], C0); H64_SBAR(); C1 = MFMA32(kf[7], qf[3], C1); H64_SBAR(); \
    if (GK) DMA_K((t) + 3, sl_cur); if (GV) DMA_V((t) + 1, sl_next); \
    if (NEXT && (GQ)) { _Pragma("unroll") for (int d0 = 0; d0 < KS; ++d0) qf[d0] = *(const bf16x8*)(Qn + (size_t)(qw0 + r32) * pq + 16 * d0 + 8 * hi); } \
    if (BAND) { if ((t) >= mylimit) { _Pragma("unroll") for (int r = 0; r < 16; ++r) { C0[r] = -INFINITY; C1[r] = -INFINITY; } } } \
    BIASADD(C0, C1, t); \
    { float rm; ROWMAX(C0, C1, rm); resc = false; \
      if (__builtin_expect(__any(rm > 8.f), 0)) { const float dl = fmaxf(rm, 0.f); m_ref += dl; fsc = __builtin_amdgcn_exp2f(-dl); l_reg *= fsc; resc = true; SET_QX(); \
          _Pragma("unroll") for (int r = 0; r < 16; ++r) { C0[r] -= dl; C1[r] -= dl; } } } \
    float sacc = 0.f; H64_SBAR(); \
    oT[0] = MFMA32(VFR(0), PAF(0), oT[0]); C0[0] = __builtin_amdgcn_exp2f(C0[0]); C0[1] = __builtin_amdgcn_exp2f(C0[1]); C0[2] = __builtin_amdgcn_exp2f(C0[2]); H64_PIN(C0); H64_SBAR(); VRD(4); H64_SBAR(); \
    oT[1] = MFMA32(VFR(1), PAF(0), oT[1]); C0[3] = __builtin_amdgcn_exp2f(C0[3]); C0[4] = __builtin_amdgcn_exp2f(C0[4]); C0[5] = __builtin_amdgcn_exp2f(C0[5]); sacc += C0[0]; sacc += C0[1]; H64_PIN(C0); H64_PIN(sacc); H64_SBAR(); VRD(5); H64_SBAR(); \
    oT[2] = MFMA32(VFR(2), PAF(0), oT[2]); C0[6] = __builtin_amdgcn_exp2f(C0[6]); C0[7] = __builtin_amdgcn_exp2f(C0[7]); C0[8] = __builtin_amdgcn_exp2f(C0[8]); sacc += C0[2]; sacc += C0[3]; H64_PIN(C0); H64_PIN(sacc); H64_SBAR(); VRD(6); H64_SBAR(); \
    oT[3] = MFMA32(VFR(3), PAF(0), oT[3]); C0[9] = __builtin_amdgcn_exp2f(C0[9]); C0[10] = __builtin_amdgcn_exp2f(C0[10]); C0[11] = __builtin_amdgcn_exp2f(C0[11]); sacc += C0[4]; sacc += C0[5]; H64_PIN(C0); H64_PIN(sacc); H64_SBAR(); VRD(7); H64_SBAR(); \
    oT[0] = MFMA32(VFR(0), PAF(1), oT[0]); C0[12] = __builtin_amdgcn_exp2f(C0[12]); C0[13] = __builtin_amdgcn_exp2f(C0[13]); C0[14] = __builtin_amdgcn_exp2f(C0[14]); sacc += C0[6]; sacc += C0[7]; pw0[0] = cvtpk(C0[0], C0[1]); H64_PIN(C0); H64_PIN(pw0); H64_PIN(sacc); H64_SBAR(); VRD(8); H64_SBAR(); \
    oT[1] = MFMA32(VFR(1), PAF(1), oT[1]); C0[15] = __builtin_amdgcn_exp2f(C0[15]); C1[0] = __builtin_amdgcn_exp2f(C1[0]); C1[1] = __builtin_amdgcn_exp2f(C1[1]); sacc += C0[8]; sacc += C0[9]; pw0[1] = cvtpk(C0[2], C0[3]); H64_PIN(C0); H64_PIN(C1); H64_PIN(pw0); H64_PIN(sacc); H64_SBAR(); VRD(9); H64_SBAR(); \
    oT[2] = MFMA32(VFR(2), PAF(1), oT[2]); C1[2] = __builtin_amdgcn_exp2f(C1[2]); C1[3] = __builtin_amdgcn_exp2f(C1[3]); C1[4] = __builtin_amdgcn_exp2f(C1[4]); sacc += C0[10]; sacc += C0[11]; pw0[2] = cvtpk(C0[4], C0[5]); H64_PIN(C1); H64_PIN(pw0); H64_PIN(sacc); H64_SBAR(); VRD(10); H64_SBAR(); \
    oT[3] = MFMA32(VFR(3), PAF(1), oT[3]); C1[5] = __builtin_amdgcn_exp2f(C1[5]); C1[6] = __builtin_amdgcn_exp2f(C1[6]); C1[7] = __builtin_amdgcn_exp2f(C1[7]); sacc += C0[12]; sacc += C0[13]; pw0[3] = cvtpk(C0[6], C0[7]); H64_PIN(C1); H64_PIN(pw0); H64_PIN(sacc); H64_SBAR(); VRD(11); H64_SBAR(); \
    KRD(GL, 0); oT[0] = MFMA32(VFR(0), PAF(2), oT[0]); C1[8] = __builtin_amdgcn_exp2f(C1[8]); C1[9] = __builtin_amdgcn_exp2f(C1[9]); C1[10] = __builtin_amdgcn_exp2f(C1[10]); sacc += C0[14]; sacc += C0[15]; pw1[0] = cvtpk(C0[8], C0[9]); H64_PIN(C1); H64_PIN(pw1); H64_PIN(sacc); H64_SBAR(); VRD(12); H64_SBAR(); \
    oT[1] = MFMA32(VFR(1), PAF(2), oT[1]); C1[11] = __builtin_amdgcn_exp2f(C1[11]); C1[12] = __builtin_amdgcn_exp2f(C1[12]); C1[13] = __builtin_amdgcn_exp2f(C1[13]); sacc += C1[0]; sacc += C1[1]; pw1[1] = cvtpk(C0[10], C0[11]); H64_PIN(C1); H64_PIN(pw1); H64_PIN(sacc); H64_SBAR(); VRD(13); H64_SBAR(); \
    KRD(GL, 1); oT[2] = MFMA32(VFR(2), PAF(2), oT[2]); C1[14] = __builtin_amdgcn_exp2f(C1[14]); C1[15] = __builtin_amdgcn_exp2f(C1[15]); sacc += C1[2]; sacc += C1[3]; pw1[2] = cvtpk(C0[12], C0[13]); H64_PIN(C1); H64_PIN(pw1); H64_PIN(sacc); H64_SBAR(); VRD(14); H64_SBAR(); \
    oT[3] = MFMA32(VFR(3), PAF(2), oT[3]); sacc += C1[4]; sacc += C1[5]; pw1[3] = cvtpk(C0[14], C0[15]); H64_PIN(pw1); H64_PIN(sacc); H64_SBAR(); VRD(15); H64_SBAR(); \
    KRD(GL, 2); oT[0] = MFMA32(VFR(0), PAF(3), oT[0]); sacc += C1[6]; sacc += C1[7]; pw2[0] = cvtpk(C1[0], C1[1]); H64_PIN(pw2); H64_PIN(sacc); H64_SBAR(); \
    oT[1] = MFMA32(VFR(1), PAF(3), oT[1]); sacc += C1[8]; sacc += C1[9]; pw2[1] = cvtpk(C1[2], C1[3]); H64_PIN(pw2); H64_PIN(sacc); H64_SBAR(); \
    KRD(GL, 3); oT[2] = MFMA32(VFR(2), PAF(3), oT[2]); sacc += C1[10]; sacc += C1[11]; pw2[2] = cvtpk(C1[4], C1[5]); H64_PIN(pw2); H64_PIN(sacc); H64_SBAR(); \
    oT[3] = MFMA32(VFR(3), PAF(3), oT[3]); sacc += C1[12]; sacc += C1[13]; pw2[3] = cvtpk(C1[6], C1[7]); H64_PIN(pw2); H64_PIN(sacc); H64_SBAR(); \
    sacc += C1[14]; sacc += C1[15]; l_reg += sacc; \
    pw3[0] = cvtpk(C1[8], C1[9]); pw3[1] = cvtpk(C1[10], C1[11]); pw3[2] = cvtpk(C1[12], C1[13]); pw3[3] = cvtpk(C1[14], C1[15]); \
    } while (0)
#define RESC() do { if (resc) { _Pragma("unroll") for (int r = 0; r < 16; ++r) { oT[0][r] *= fsc; oT[1][r] *= fsc; oT[2][r] *= fsc; oT[3][r] *= fsc; } } } while (0)
    int t = 1;
    for (; t + 4 < NT; ++t) { STEP(t, false, true, true, true, false); WAIT_BAR(3); RESC(); ROT(); }
#define ENDW(tt) do { if ((tt) + 3 < NT) { WAIT_BAR(3); } else if ((tt) + 2 < NT) { WAIT_BAR(2); } else { WAIT_BAR(0); } } while (0)
    for (; t + 1 < NT; ++t) { STEP(t, true, (t + 3 < NT), (t + 1 < NT), (t + 1 < NT), false); ENDW(t); RESC(); ROT(); }
    if (NEXT) { const int n0 = sl_next, n1 = NXS(n0), n2 = NXS(n1); DMA_KN(0, n0); DMA_V(0, n0); DMA_KN(1, n1); DMA_KN(2, n2); s0 = n0; }
    if (!NEXT && popq != nullptr && tid == 0) popv = (int)__hip_atomic_fetch_add(popq, 1u, RLX_AGENT);
    STEP(NT - 1, true, false, false, false, true); RESC();
    { const LAS unsigned char* vp_ = vp0 + 2 * sl_cur;
      VRD(0); VRD(1); VRD(2); VRD(3);
      oT[0] = MFMA32(VFR(0), PAF(0), oT[0]); oT[1] = MFMA32(VFR(1), PAF(0), oT[1]); oT[2] = MFMA32(VFR(2), PAF(0), oT[2]); oT[3] = MFMA32(VFR(3), PAF(0), oT[3]); H64_SBAR();
      VRD(4); VRD(5); VRD(6); VRD(7);
      oT[0] = MFMA32(VFR(0), PAF(1), oT[0]); oT[1] = MFMA32(VFR(1), PAF(1), oT[1]); oT[2] = MFMA32(VFR(2), PAF(1), oT[2]); oT[3] = MFMA32(VFR(3), PAF(1), oT[3]); H64_SBAR();
      VRD(8); VRD(9); VRD(10); VRD(11);
      oT[0] = MFMA32(VFR(0), PAF(2), oT[0]); oT[1] = MFMA32(VFR(1), PAF(2), oT[1]); oT[2] = MFMA32(VFR(2), PAF(2), oT[2]); oT[3] = MFMA32(VFR(3), PAF(2), oT[3]); H64_SBAR();
      VRD(12); VRD(13); VRD(14); VRD(15);
      oT[0] = MFMA32(VFR(0), PAF(3), oT[0]); oT[1] = MFMA32(VFR(1), PAF(3), oT[1]); oT[2] = MFMA32(VFR(2), PAF(3), oT[2]); oT[3] = MFMA32(VFR(3), PAF(3), oT[3]); H64_SBAR();
    }
    const float inv = 1.f / halfswap_sum(l_reg);
#pragma unroll
    for (int d = 0; d < 4; ++d)
#pragma unroll
        for (int r = 0; r < 16; ++r) oT[d][r] *= inv;
    asm volatile("s_waitcnt lgkmcnt(0)\n\ts_barrier" ::: "memory");
#undef MLOAD
#undef DMA_K
#undef DMA_V
#undef DMA_KN
#undef NXS
#undef WAIT_BAR
#undef SET_QX
#undef ROT
#undef KLOAD2
#undef MX3
#undef ROWMAX
#undef MBIT
#undef CROW
#undef EXM
#undef BIASADD
#undef PKW
#undef PAF
#undef VFR
#undef VRD
#undef KRD
#undef GAPA
#undef GAPB
#undef GAPB2
#undef STEP
#undef RESC
#undef ENDW
}

template <int ND>
DI void store_oT(bf16* orow, const f32x16 (&oT)[ND], int hi) {
#pragma unroll
    for (int d = 0; d < ND; ++d)
#pragma unroll
        for (int g = 0; g < 4; ++g) st4(orow + 32 * d + 8 * g + 4 * hi, oT[d][4 * g], oT[d][4 * g + 1], oT[d][4 * g + 2], oT[d][4 * g + 3]);
}

DI void attn_phase(const bf16* Z, const bf16* MLA, bf16* MIX, const unsigned long long* MASK, unsigned* O0, const float* par, const float* subln, int layer, gu32* qctr,
                   const float* w_gate, const float* w_up, const float* w_down, unsigned char* WGU, unsigned char* WD, LAS unsigned char* lds, int tid) {
    const int lane = tid & 63, wave = __builtin_amdgcn_readfirstlane(tid >> 6), r32 = lane & 31, hi = lane >> 5;
    volatile LAS int* slot = (volatile LAS int*)(lds + AUX_OFF + 2048);
    LAS float* lutall = (LAS float*)(lds + 73728);
    LAS float* gain = (LAS float*)(lds + AUX_OFF + 1024);
    const float lam = par[layer], omli = par[2 + layer];
    for (int i = tid; i < 2048; i += NTHR) lutall[i] = par[(PAR_LUT / 4) + i] - par[(PAR_LUT / 4) + (i & ~255)];
    if (tid < 128) gain[tid] = subln[layer * 128 + tid] * omli;
    __syncthreads();
    int popv = 0; bool popped = false;
    for (;;) {
        if (tid == 0) *slot = popped ? popv : (int)__hip_atomic_fetch_add(qctr, 1u, RLX_AGENT);
        popped = false;
        __syncthreads();
        const int uq = *slot;
        if (uq >= 2304) break;
        if (uq % 3 == 2) {
            const int grp = uq / 3;
            moe_convert_items<4>(w_gate, w_up, w_down, WGU, WD, (LAS float*)(lds + wave * 8448), grp * 32 + wave * 4, lane);
            __syncthreads();
            continue;
        }
        const int u = (uq / 3) * 2 + (uq % 3);
        const unsigned ue = ((const unsigned*)par)[(PAR_ORD / 4) + u];
        const int type = (int)(ue >> 16), qb = (int)((ue >> 8) & 0xffu), bh = (int)(ue & 0xffu), b = bh >> 2, h = bh & 3;
        const int q0 = qb * 256, nt = 4 * qb + 4; const size_t rb = (size_t)b * SEQ;
        const float cfar = type < 2 ? par[(PAR_LUT / 4) + (type * 4 + h) * 256] : 0.f;
        if (type == 0) {
            bf16* orow = MIX + (rb + q0 + 32 * wave + r32) * DM;
            f32x16 oT[4]; bf16x8 qfx[4]; int s0 = 0;
#define O0L(j) (*(LAS u32x4*)(lds + ((j) < 6 ? PARK_A + (j) * 8192 : PARK_B + ((j) - 6) * 8192) + tid * 16))
            const bf16* Vp = Z + rb * ZP + Z_AV + h * 128;
            attn_pass_h128<true, false, true>(lds, Z + rb * ZP + Z_AQ + (h * 2) * 64, Z + rb * ZP + Z_AK + (h * 2) * 64, Vp, ZP, ZP, ZP, q0, nt, nullptr, cfar, oT, tid, lutall + (type * 4 + h) * 256,
                                              Z + rb * ZP + Z_AQ + (h * 2 + 1) * 64, Z + rb * ZP + Z_AK + (h * 2 + 1) * 64, s0, qfx, nullptr, popv);
#pragma unroll
            for (int d = 0; d < 4; ++d)
#pragma unroll
                for (int i = 0; i < 2; ++i) O0L(d * 2 + i) = (u32x4){cvtpk(oT[d][8 * i], oT[d][8 * i + 1]), cvtpk(oT[d][8 * i + 2], oT[d][8 * i + 3]), cvtpk(oT[d][8 * i + 4], oT[d][8 * i + 5]), cvtpk(oT[d][8 * i + 6], oT[d][8 * i + 7])};
            attn_pass_h128<true, true, false>(lds, Z + rb * ZP + Z_AQ + (h * 2 + 1) * 64, Z + rb * ZP + Z_AK + (h * 2 + 1) * 64, Vp, ZP, ZP, ZP, q0, nt, nullptr, cfar, oT, tid, lutall + (type * 4 + h) * 256,
                                              nullptr, nullptr, s0, qfx, qctr, popv); popped = true;
            float ss = 0.f;
#pragma unroll
            for (int d = 0; d < 4; ++d)
#pragma unroll
                for (int i = 0; i < 2; ++i) { const u32x4 pk = O0L(d * 2 + i);
#pragma unroll
                    for (int e = 0; e < 4; ++e) { const unsigned p = pk[e]; const float a = __uint_as_float(p << 16) - lam * oT[d][8 * i + 2 * e], c2 = __uint_as_float(p & 0xffff0000u) - lam * oT[d][8 * i + 2 * e + 1];
                        oT[d][8 * i + 2 * e] = a; oT[d][8 * i + 2 * e + 1] = c2; ss += a * a + c2 * c2; } }
            const float rstd = rsqrtf(halfswap_sum(ss) * (1.f / 128.f) + EPS);
#pragma unroll
            for (int d = 0; d < 4; ++d)
#pragma unroll
                for (int rr = 0; rr < 16; ++rr) oT[d][rr] *= rstd * gain[32 * d + (rr & 3) + 8 * (rr >> 2) + 4 * hi];
            store_oT<4>(orow + h * 128, oT, hi);
        } else if (type == 1) {
            f32x16 oT[2];
            attn_pass_h64<true, true, 4>(lds, Z + rb * ZP + Z_BQ + h * 64, Z + rb * ZP + Z_BK + h * 64, Z + rb * ZP + Z_BV + h * 64, ZP, ZP, ZP, q0, nt, MASK + rb * 64, cfar, oT, tid, lutall + (type * 4 + h) * 256, qctr, popv); popped = true;
            store_oT<2>(MIX + (rb + q0 + 32 * wave + r32) * DM + 512 + h * 64, oT, hi);
        } else {
            f32x16 oT[2];
            attn_pass_h64<false, false, 3>(lds, MLA + rb * MLAP + h * 64, MLA + rb * MLAP + 256 + h * 64, MLA + rb * MLAP + 512 + h * 64, MLAP, MLAP, MLAP, q0, nt, nullptr, cfar, oT, tid, lutall + (type * 4 + h) * 256, qctr, popv); popped = true;
            store_oT<2>(MIX + (rb + q0 + 32 * wave + r32) * DM + 768 + h * 64, oT, hi);
        }
    }
}


DI void router_unit(const bf16* XA, const bf16* WRl  , const float* bg, const float* be, int* rt_e, float* rt_g, float* rstd_g, int* cnt_g, LAS unsigned char* lds, int unit, int tid) {
    const int lane = tid & 63, wave = __builtin_amdgcn_readfirstlane(tid >> 6), r32 = lane & 31, hi = lane >> 5;
    LAS int* hist = (LAS int*)(lds + AUX_OFF + 4096);
    LAS float* xch = (LAS float*)lds;
    if (tid < 32) hist[tid] = 0;
    f32x16 a0[4], a1[4]; float ss[4];
#pragma unroll
    for (int tb = 0; tb < 4; ++tb) { a0[tb] = (f32x16){}; a1[tb] = (f32x16){}; ss[tb] = 0.f; }
    const bf16* xg = XA + (size_t)(unit * 128 + r32) * DM + wave * 128 + 32 * hi;
    const bf16* wg = WRl + (size_t)r32 * 1024 + wave * 128 + 32 * hi;
    const bf16* wg2 = WRl + (size_t)(32 + (r32 < 4 ? r32 : 4)) * 1024 + wave * 128 + 32 * hi;
    u32x4 X[2][4]; bf16x8 W[2][4];
#define RT_LD(s, S) do { const int o_ = 64 * ((s) >> 2) + 8 * ((s) & 3); _Pragma("unroll") for (int tb = 0; tb < 4; ++tb) X[S][tb] = *(const u32x4*)(xg + (size_t)tb * 32 * DM + o_); \
        W[S][0] = *(const bf16x8*)(wg + o_); W[S][1] = *(const bf16x8*)(wg + 64 * 1024 + o_); W[S][2] = *(const bf16x8*)(wg2 + o_); W[S][3] = *(const bf16x8*)(wg2 + 64 * 1024 + o_); } while (0)
#define RT_CP(S) do { _Pragma("unroll") for (int tb = 0; tb < 4; ++tb) { \
            const f32x4 xa = {__uint_as_float(X[S][tb].x << 16), __uint_as_float(X[S][tb].x & 0xffff0000u), __uint_as_float(X[S][tb].y << 16), __uint_as_float(X[S][tb].y & 0xffff0000u)}, \
                        xb = {__uint_as_float(X[S][tb].z << 16), __uint_as_float(X[S][tb].z & 0xffff0000u), __uint_as_float(X[S][tb].w << 16), __uint_as_float(X[S][tb].w & 0xffff0000u)}; \
            ss[tb] += (xa[0] * xa[0] + xa[1] * xa[1]) + (xa[2] * xa[2] + xa[3] * xa[3]) + (xb[0] * xb[0] + xb[1] * xb[1]) + (xb[2] * xb[2] + xb[3] * xb[3]); \
            const bf16x8 xh = __builtin_bit_cast(bf16x8, X[S][tb]); \
            a0[tb] = MFMA32(W[S][0], xh, a0[tb]); a0[tb] = MFMA32(W[S][1], xh, a0[tb]); a1[tb] = MFMA32(W[S][2], xh, a1[tb]); a1[tb] = MFMA32(W[S][3], xh, a1[tb]); } } while (0)
    RT_LD(0, 0);
    for (int s = 0; s < 8; s += 2) {
        RT_LD(s + 1, 1);
        RT_CP(0);
        { const int sn = s + 2 < 8 ? s + 2 : 7; RT_LD(sn, 0); }
        RT_CP(1);
    }
#undef RT_LD
#undef RT_CP
#pragma unroll
    for (int r = 4; r >= 1; r >>= 1) {
        if (wave >= r && wave < 2 * r) { LAS float* o = xch + (wave - r) * (84 * 64) + lane;
#pragma unroll
            for (int tb = 0; tb < 4; ++tb) {
#pragma unroll
                for (int i = 0; i < 16; ++i) o[(tb * 21 + i) * 64] = a0[tb][i];
#pragma unroll
                for (int i = 0; i < 4; ++i) o[(tb * 21 + 16 + i) * 64] = a1[tb][i];
                o[(tb * 21 + 20) * 64] = ss[tb]; } }
        __syncthreads();
        if (wave < r) { const LAS float* o = xch + wave * (84 * 64) + lane;
#pragma unroll
            for (int tb = 0; tb < 4; ++tb) {
#pragma unroll
                for (int i = 0; i < 16; ++i) a0[tb][i] += o[(tb * 21 + i) * 64];
#pragma unroll
                for (int i = 0; i < 4; ++i) a1[tb][i] += o[(tb * 21 + 16 + i) * 64];
                ss[tb] += o[(tb * 21 + 20) * 64]; } }
        __syncthreads();
    }
    if (wave == 0) {
#pragma unroll
        for (int tb = 0; tb < 4; ++tb) {
            const int row = unit * 128 + tb * 32 + r32;
            const f32x16 acc0 = a0[tb], acc1 = a1[tb];
            const float rstd = rsqrtf(halfswap_sum(ss[tb]) * (1.f / DM) + EPS);
            float g[4];
#pragma unroll
            for (int r = 0; r < 4; ++r) { const float v = acc1[r] * rstd; const float o2 = __shfl_xor(v, 32); g[r] = (hi ? o2 : v) + bg[r]; }
            int gsel = 0; float gmax = g[0];
#pragma unroll
            for (int r = 1; r < 4; ++r) if (g[r] > gmax) { gmax = g[r]; gsel = r; }
            float gsum = 0.f;
#pragma unroll
            for (int r = 0; r < 4; ++r) gsum += expf(g[r] - gmax);
            const float gpb = 1.f / gsum;
            float part[4], e[8];
#pragma unroll
            for (int k = 0; k < 4; ++k) part[k] = (gsel == 0 ? acc0[k] : (gsel == 1 ? acc0[4 + k] : (gsel == 2 ? acc0[8 + k] : acc0[12 + k]))) * rstd;
#pragma unroll
            for (int k = 0; k < 4; ++k) { const float o2 = __shfl_xor(part[k], 32); e[k] = hi ? o2 : part[k]; e[4 + k] = hi ? part[k] : o2; }
#pragma unroll
            for (int i = 0; i < 8; ++i) e[i] += be[8 * gsel + i];
            int i1 = 0; float e1 = e[0];
#pragma unroll
            for (int i = 1; i < 8; ++i) if (e[i] > e1) { e1 = e[i]; i1 = i; }
            int i2 = -1; float e2 = -INFINITY;
#pragma unroll
            for (int i = 0; i < 8; ++i) if (i != i1 && e[i] > e2) { e2 = e[i]; i2 = i; }
            const float p2 = expf(e2 - e1), den = 1.f / (1.f + p2);
            if (hi == 0) {
                const int ea = 8 * gsel + i1, eb = 8 * gsel + i2;
                rt_e[2 * row] = ea; rt_e[2 * row + 1] = eb; rt_g[2 * row] = gpb * den; rt_g[2 * row + 1] = gpb * p2 * den; rstd_g[row] = rstd;
                atomicAdd((int*)&hist[ea], 1); atomicAdd((int*)&hist[eb], 1);
            }
        }
    }
    __syncthreads();
    if (tid < 32) cnt_g[unit * 32 + tid] = hist[tid];
    __syncthreads();
}

DI void sort_unit(const int* rt_e, int* rt_d, const float* rstd_g, const int* cnt_g, int* blk_e, int* nblk, int* src, float* rs_sorted, LAS unsigned char* lds, int unit, int tid) {
    const int lane = tid & 63, wave = __builtin_amdgcn_readfirstlane(tid >> 6);
    LAS int* pt = (LAS int*)lds; LAS int* pp = pt + 512; LAS int* tot = pp + 512; LAS int* pre = tot + 32; LAS int* base = pre + 32; LAS int* wc = base + 32; LAS int* est = wc + 128;
    { const int e = tid & 31, grp = tid >> 5; int t = 0, p = 0;
#pragma unroll 4
      for (int i = 0; i < 16; ++i) { const int c = grp * 16 + i; const int v = cnt_g[c * 32 + e]; t += v; p += (c < unit) ? v : 0; }
      pt[tid] = t; pp[tid] = p; }
    int ea = -1;
    if (tid < 256) ea = rt_e[unit * 256 + tid];
    __syncthreads();
    if (tid < 32) { int t = 0, p = 0;
#pragma unroll
        for (int g = 0; g < 16; ++g) { t += pt[g * 32 + tid]; p += pp[g * 32 + tid]; }
        tot[tid] = t; pre[tid] = p; }
    int myrank = 0;
    if (wave < 4) { int mycnt = 0;
        for (int e = 0; e < 32; ++e) { const unsigned long long m = __builtin_amdgcn_ballot_w64(ea == e);
            if (ea == e) myrank = __builtin_popcountll(m & ((1ull << lane) - 1ull));
            if (lane == e) mycnt = __builtin_popcountll(m); }
        if (lane < 32) wc[wave * 32 + lane] = mycnt; }
    __syncthreads();
    if (tid == 0) { int s = 0; for (int e = 0; e < 32; ++e) { const int padded = (tot[e] + 255) & ~255; base[e] = s + pre[e]; est[e] = s;
            if (unit == 0) for (int j = s >> 8; j < ((s + padded) >> 8); ++j) blk_e[j] = e;
            s += padded; }
        if (unit == 0) *nblk = s >> 8; }
    __syncthreads();
    if (tid < 256) { int d = base[ea] + myrank; for (int w = 0; w < wave; ++w) d += wc[w * 32 + ea];
        const int tok = unit * 128 + (tid >> 1);
        rt_d[unit * 256 + tid] = d; src[d] = tok; rs_sorted[d] = rstd_g[tok]; }
    if (unit < 32) { const int e = unit, first = est[e] + tot[e], npad = ((tot[e] + 255) & ~255) - tot[e];
        for (int i = tid; i < npad; i += NTHR) { src[first + i] = 0; rs_sorted[first + i] = 0.f; } }
    __syncthreads();
}

constexpr int NPH = 20;
struct Args { In in; float* out; unsigned char* ws; int ph_lo, ph_hi, li, pad; };
__global__ void __launch_bounds__(NTHR, 2) fwd(Args args) {
    extern __shared__ __attribute__((aligned(16))) unsigned char lds_raw[];
    LAS unsigned char* lds = (LAS unsigned char*)lds_raw;
    const int tid0 = threadIdx.x;
    const int wave0 = __builtin_amdgcn_readfirstlane(tid0 >> 6);
    const int G = gridDim.x;
    unsigned char* ws0 = args.ws; const In& I = args.in;
    gu32* ctl = (gu32*)(ws0 + WS_CTL);
    volatile LAS unsigned* MISC = (volatile LAS unsigned*)(lds + MISC_OFF);
    if (tid0 < 64) MISC[tid0] = 0u;
    __syncthreads();
    XcdBarrier bar = xcd_barrier_post((unsigned*)(ctl + CW_BAR) + args.li * XCD_BAR_WORDS, MISC + 8);
    const int lo = args.ph_lo, hi_ph = args.ph_hi;
#ifndef PHMASK
#define PHMASK 0xFFFFF
#endif
#define IN(k) (lo <= (k) && (k) < hi_ph)
#define EN(j) ((PHMASK >> (j)) & 1)
#ifndef REPMASK
#define REPMASK 0
#endif
#define NREP(j) (1 + ((REPMASK >> (j)) & 1))
#define SEAM(k) do { if (IN(k) && IN((k) + 1)) xcd_barrier(bar); } while (0)
#define PHASE_ENV \
    int tid = wave0 * 64 + (int)__builtin_amdgcn_mbcnt_hi(~0u, __builtin_amdgcn_mbcnt_lo(~0u, 0u)); asm volatile("" : "+v"(tid)); GAS unsigned char* wsg_ = (GAS unsigned char*)ws0; asm volatile("" : "+s"(wsg_)); unsigned char* ws = (unsigned char*)wsg_; \
    const int lane = tid & 63, wave = __builtin_amdgcn_readfirstlane(tid >> 6); const int gw = blockIdx.x * NWAVES + wave, NGW = G * NWAVES; \
    bf16* XA = (bf16*)(ws + WS_XA); float* OUT = (float*)(GAS float*)args.out; bf16* XN = (bf16*)(GAS bf16*)args.out; (void)OUT; bf16* Z = (bf16*)(ws + WS_Z); unsigned char* XS = ws + WS_Z; unsigned char* Y = ws + WS_Z; \
    bf16* MLA = (bf16*)(ws + WS_MLA); unsigned char* H = ws + WS_MLA; unsigned long long* MASK = (unsigned long long*)(ws + WS_MASK); \
    unsigned char* WGU = ws + WS_WGU; unsigned char* WD = ws + WS_WD; const float* par = (const float*)(ws + WS_PAR); \
    int* rt_e = (int*)(ws + WS_ROUTE + RT_E); float* rt_g = (float*)(ws + WS_ROUTE + RT_G); int* rt_d = (int*)(ws + WS_ROUTE + RT_D); \
    int* cnt_g = (int*)(ws + WS_ROUTE + RT_CNT); float* rstd_g = (float*)(ws + WS_ROUTE + RT_RSTD); int* blk_e = (int*)(ws + WS_ROUTE + RT_BLK); int* nblk = (int*)(ws + WS_ROUTE + RT_NBLK); \
    (void)lane; (void)gw; (void)NGW; (void)XA; (void)XN; (void)Z; (void)XS; (void)Y; (void)MLA; (void)H; (void)MASK; (void)WGU; (void)WD; (void)par; (void)rt_e; (void)rt_g; (void)rt_d; (void)cnt_g; (void)rstd_g; (void)blk_e; (void)nblk;

    if (EN(0) && IN(0)) { PHASE_ENV for (int rep = 0; rep < NREP(0); ++rep) prologue_phase(I, ws, lds, gw, NGW, lane, wave); }
    if (!(IN(0) && IN(1))) SEAM(0);
    {
        constexpr int l = 0;
        const int pb = 1 + 9 * l;
        if (EN(1) && IN(pb)) { PHASE_ENV
            if (l == 0) { for (int rep = 0; rep < NREP(1); ++rep) norm_phase<0>(I.x, XA, OUT, XN, I.norm_mix, Y, rt_d, rt_g, gw, NGW, lane); }
            else norm_phase<1>(I.x, XA, OUT, XN, I.norm_mix + DM, Y, rt_d, rt_g, gw, NGW, lane);
        }
        SEAM(pb);
        if (EN(2) && IN(pb + 1)) { PHASE_ENV
            pg8::Gemm g{XN, (const bf16*)(ws + WS_WIN) + (size_t)l * ZP * 1024, 1024, 1024}; pg8::StaticOrder S; S.init(M, ZP, G, (int)blockIdx.x); S.rep = NREP(2);
            pg8::EpiZ E{Z, (bf16*)(ws + WS_KIDX)};
            pg8::gemm_phase<pg8::EpiZ, pg8::StaticOrder, true, true>(lds, g, S, E, tid);
        }
        SEAM(pb + 1);
        if (EN(3) && IN(pb + 2)) { PHASE_ENV
            for (int rep = 0; rep < NREP(3); ++rep) {
            if (!((REPMASK >> 12) & 1) || rep == 0) for (int u = gw; u < 2048; u += NGW) mla_prep_unit(Z, (const bf16*)(ws + WS_WUQ) + (size_t)l * 192 * 256, (const bf16*)(ws + WS_WUKV) + (size_t)l * 384 * 128,
                                                               (const float*)(ws + WS_PAR + PAR_COS), (const float*)(ws + WS_PAR + PAR_SIN), MLA, u, lane);
            for (int i = blockIdx.x * NTHR + tid; i < NB * 256 * 4; i += G * NTHR) { const int b = i >> 10, t = (i >> 2) & 255, j = i & 3; MASK[((size_t)b * SEQ + t) * 64 + j] = ~0ull; }
            { const bf16* KX = (const bf16*)(ws + WS_KIDX); DsaOps cur_, nxt_;
              const int R0 = 9 * G <= 3840 ? 9 : 3840 / G, NST = R0 * G;
              gu32* dctr = ctl + CW_QCTR + 64 * (l + 2 * rep) + 32;
              volatile LAS int* dslot = (volatile LAS int*)(lds + MISC_OFF + 128);
              int it = blockIdx.x, r_ = 0;
              if (R0 == 0) { if (tid == 0) *dslot = (int)__hip_atomic_fetch_add(dctr, 1u, RLX_AGENT); __syncthreads(); it = *dslot; __syncthreads(); }
              if (it < 3840) dsa_load_ops(Z, KX, it, wave, lane, cur_);
              while (it < 3840) {
                  int nx;
                  if (++r_ < R0) nx = it + G;
                  else { if (tid == 0) *dslot = NST + (int)__hip_atomic_fetch_add(dctr, 1u, RLX_AGENT); __syncthreads(); nx = *dslot; }
                  dsa_load_ops(Z, KX, nx < 3840 ? nx : it, wave, lane, nxt_); dsa_select_item(Z, KX, MASK, lds, cur_, it, tid); cur_ = nxt_; it = nx; } }
            }
        }
        SEAM(pb + 2);
        if (EN(4) && IN(pb + 3)) { PHASE_ENV for (int rep = 0; rep < NREP(4); ++rep) attn_phase(Z, MLA, XN, MASK, (unsigned*)(ws + WS_O0), par, I.diff_subln, l, ctl + CW_QCTR + 64 * (l + 2 * rep),
                I.w_gate + (size_t)l * NEXP * 1024 * 512, I.w_up + (size_t)l * NEXP * 1024 * 512, I.w_down + (size_t)l * NEXP * 512 * 1024, WGU, WD, lds, tid); }
        SEAM(pb + 3);
        if (EN(5) && IN(pb + 4)) { PHASE_ENV
            pg8::Gemm g{XN, (const bf16*)(ws + WS_WOUT) + (size_t)l * 1024 * 1024, 1024, 1024}; pg8::StaticOrder S; S.init(M, DM, G, (int)blockIdx.x); S.rep = NREP(5);
            pg8::EpiRes<(l != 0)> E{l == 0 ? (const void*)I.x : (const void*)XA, XA, I.norm_ffn + l * DM, ws + WS_XT};
            pg8::gemm_phase<pg8::EpiRes<(l != 0)>, pg8::StaticOrder, true, true>(lds, g, S, E, tid);
        }
        SEAM(pb + 4);
        if (EN(6) && IN(pb + 5)) { PHASE_ENV for (int rep = 0; rep < NREP(6); ++rep) for (int u = blockIdx.x; u < 256; u += G)
            router_unit(XA, (const bf16*)(ws + WS_WR) + (size_t)l * 2 * 64 * 1024, I.b_group + l * 4, I.b_expert + l * 32, rt_e, rt_g, rstd_g, cnt_g, lds, u, tid); }
        SEAM(pb + 5);
        if (EN(7) && IN(pb + 6)) { PHASE_ENV for (int rep = 0; rep < NREP(7); ++rep) for (int u = blockIdx.x; u < 256; u += G) sort_unit(rt_e, rt_d, rstd_g, cnt_g, blk_e, nblk, (int*)(ws + WS_SRC), (float*)(ws + WS_RS), lds, u, tid); }
        SEAM(pb + 6);
        if (EN(8) && IN(pb + 7)) { PHASE_ENV
            pg8::Gemm g{ws + WS_XT, WGU, 1024, 1024}; pg8::MoeOrder S{blk_e, *nblk * 4, G, (int)blockIdx.x, NREP(8), (const int*)(ws + WS_SRC)};
            pg8::EpiGU E{H, (const float*)(ws + WS_RS)};
            pg8::gemm_phase<pg8::EpiGU, pg8::MoeOrder, true, true, 1, true>(lds, g, S, E, tid);
        }
        SEAM(pb + 7);
        if (EN(9) && IN(pb + 8)) { PHASE_ENV
            pg8::Gemm g{H, WD, 512, 512}; pg8::MoeOrder S{blk_e, *nblk * 4, G, (int)blockIdx.x, NREP(9)};
            pg8::EpiF8A E{Y, DM, 16.f / 256.f};
            pg8::gemm_phase<pg8::EpiF8A, pg8::MoeOrder, true, true, 1, false, true>(lds, g, S, E, tid);
        }
        SEAM(pb + 8);
    }
    {
        constexpr int l = 1;
        const int pb = 1 + 9 * l;
        if (EN(1) && IN(pb)) { PHASE_ENV
            if (l == 0) { for (int rep = 0; rep < NREP(1); ++rep) norm_phase<0>(I.x, XA, OUT, XN, I.norm_mix, Y, rt_d, rt_g, gw, NGW, lane); }
            else norm_phase<1>(I.x, XA, OUT, XN, I.norm_mix + DM, Y, rt_d, rt_g, gw, NGW, lane);
        }
        SEAM(pb);
        if (EN(2) && IN(pb + 1)) { PHASE_ENV
            pg8::Gemm g{XN, (const bf16*)(ws + WS_WIN) + (size_t)l * ZP * 1024, 1024, 1024}; pg8::StaticOrder S; S.init(M, ZP, G, (int)blockIdx.x); S.rep = NREP(2);
            pg8::EpiZ E{Z, (bf16*)(ws + WS_KIDX)};
            pg8::gemm_phase<pg8::EpiZ, pg8::StaticOrder, true, true>(lds, g, S, E, tid);
        }
        SEAM(pb + 1);
        if (EN(3) && IN(pb + 2)) { PHASE_ENV
            for (int rep = 0; rep < NREP(3); ++rep) {
            if (!((REPMASK >> 12) & 1) || rep == 0) for (int u = gw; u < 2048; u += NGW) mla_prep_unit(Z, (const bf16*)(ws + WS_WUQ) + (size_t)l * 192 * 256, (const bf16*)(ws + WS_WUKV) + (size_t)l * 384 * 128,
                                                               (const float*)(ws + WS_PAR + PAR_COS), (const float*)(ws + WS_PAR + PAR_SIN), MLA, u, lane);
            for (int i = blockIdx.x * NTHR + tid; i < NB * 256 * 4; i += G * NTHR) { const int b = i >> 10, t = (i >> 2) & 255, j = i & 3; MASK[((size_t)b * SEQ + t) * 64 + j] = ~0ull; }
            { const bf16* KX = (const bf16*)(ws + WS_KIDX); DsaOps cur_, nxt_;
              const int R0 = 9 * G <= 3840 ? 9 : 3840 / G, NST = R0 * G;
              gu32* dctr = ctl + CW_QCTR + 64 * (l + 2 * rep) + 32;
              volatile LAS int* dslot = (volatile LAS int*)(lds + MISC_OFF + 128);
              int it = blockIdx.x, r_ = 0;
              if (R0 == 0) { if (tid == 0) *dslot = (int)__hip_atomic_fetch_add(dctr, 1u, RLX_AGENT); __syncthreads(); it = *dslot; __syncthreads(); }
              if (it < 3840) dsa_load_ops(Z, KX, it, wave, lane, cur_);
              while (it < 3840) {
                  int nx;
                  if (++r_ < R0) nx = it + G;
                  else { if (tid == 0) *dslot = NST + (int)__hip_atomic_fetch_add(dctr, 1u, RLX_AGENT); __syncthreads(); nx = *dslot; }
                  dsa_load_ops(Z, KX, nx < 3840 ? nx : it, wave, lane, nxt_); dsa_select_item(Z, KX, MASK, lds, cur_, it, tid); cur_ = nxt_; it = nx; } }
            }
        }
        SEAM(pb + 2);
        if (EN(4) && IN(pb + 3)) { PHASE_ENV for (int rep = 0; rep < NREP(4); ++rep) attn_phase(Z, MLA, XN, MASK, (unsigned*)(ws + WS_O0), par, I.diff_subln, l, ctl + CW_QCTR + 64 * (l + 2 * rep),
                I.w_gate + (size_t)l * NEXP * 1024 * 512, I.w_up + (size_t)l * NEXP * 1024 * 512, I.w_down + (size_t)l * NEXP * 512 * 1024, WGU, WD, lds, tid); }
        SEAM(pb + 3);
        if (EN(5) && IN(pb + 4)) { PHASE_ENV
            pg8::Gemm g{XN, (const bf16*)(ws + WS_WOUT) + (size_t)l * 1024 * 1024, 1024, 1024}; pg8::StaticOrder S; S.init(M, DM, G, (int)blockIdx.x); S.rep = NREP(5);
            pg8::EpiRes<(l != 0)> E{l == 0 ? (const void*)I.x : (const void*)XA, XA, I.norm_ffn + l * DM, ws + WS_XT};
            pg8::gemm_phase<pg8::EpiRes<(l != 0)>, pg8::StaticOrder, true, true>(lds, g, S, E, tid);
        }
        SEAM(pb + 4);
        if (EN(6) && IN(pb + 5)) { PHASE_ENV for (int rep = 0; rep < NREP(6); ++rep) for (int u = blockIdx.x; u < 256; u += G)
            router_unit(XA, (const bf16*)(ws + WS_WR) + (size_t)l * 2 * 64 * 1024, I.b_group + l * 4, I.b_expert + l * 32, rt_e, rt_g, rstd_g, cnt_g, lds, u, tid); }
        SEAM(pb + 5);
        if (EN(7) && IN(pb + 6)) { PHASE_ENV for (int rep = 0; rep < NREP(7); ++rep) for (int u = blockIdx.x; u < 256; u += G) sort_unit(rt_e, rt_d, rstd_g, cnt_g, blk_e, nblk, (int*)(ws + WS_SRC), (float*)(ws + WS_RS), lds, u, tid); }
        SEAM(pb + 6);
        if (EN(8) && IN(pb + 7)) { PHASE_ENV
            pg8::Gemm g{ws + WS_XT, WGU, 1024, 1024}; pg8::MoeOrder S{blk_e, *nblk * 4, G, (int)blockIdx.x, NREP(8), (const int*)(ws + WS_SRC)};
            pg8::EpiGU E{H, (const float*)(ws + WS_RS)};
            pg8::gemm_phase<pg8::EpiGU, pg8::MoeOrder, true, true, 1, true>(lds, g, S, E, tid);
        }
        SEAM(pb + 7);
        if (EN(9) && IN(pb + 8)) { PHASE_ENV
            pg8::Gemm g{H, WD, 512, 512}; pg8::MoeOrder S{blk_e, *nblk * 4, G, (int)blockIdx.x, NREP(9)};
            pg8::EpiF8A E{Y, DM, 16.f / 256.f};
            pg8::gemm_phase<pg8::EpiF8A, pg8::MoeOrder, true, true, 1, false, true>(lds, g, S, E, tid);
        }
        SEAM(pb + 8);
    }
    if (EN(10) && IN(19)) { PHASE_ENV norm_phase<2>(I.x, XA, OUT, XN, I.norm_final, Y, rt_d, rt_g, gw, NGW, lane); }
#undef IN
#undef SEAM
}

#ifndef MK_SPLIT
#define MK_SPLIT 0
#endif
extern "C" void kernel_launch(void* const* d_in, const int* in_sizes, int n_in, void* d_out, int out_size, void* d_ws, size_t ws_size, hipStream_t stream) {
    static int grid = 0;
    if (grid == 0) {
        if (n_in != 23 || out_size != M * DM || ws_size < WS_END) { fprintf(stderr, "kernel_launch: unexpected shapes (n_in %d out %d ws %zu)\n", n_in, out_size, ws_size); grid = -1; return; }
        int dev = 0, cus = 0, per_cu = 0;
        if (hipGetDevice(&dev) != hipSuccess || hipDeviceGetAttribute(&cus, hipDeviceAttributeMultiprocessorCount, dev) != hipSuccess) { grid = -1; return; }
        if (hipFuncSetAttribute((const void*)fwd, hipFuncAttributeMaxDynamicSharedMemorySize, LDS_BYTES) != hipSuccess) { fprintf(stderr, "kernel_launch: hipFuncSetAttribute failed\n"); grid = -1; return; }
        if (hipOccupancyMaxActiveBlocksPerMultiprocessor(&per_cu, (const void*)fwd, NTHR, LDS_BYTES) != hipSuccess || per_cu < 1) { fprintf(stderr, "kernel_launch: occupancy query says %d\n", per_cu); }
        (void)hipGetLastError();
        grid = cus;
    }
    if (grid < 0) return;
    (void)hipMemsetAsync((char*)d_ws + WS_CTL, 0, CTL_ZERO_BYTES, stream);
    Args a{};
    const float** ip = (const float**)&a.in;
    for (int i = 0; i < 23; ++i) ip[i] = (const float*)d_in[i];
    a.out = (float*)d_out; a.ws = (unsigned char*)d_ws;
#if MK_SPLIT
    for (int p = 0; p < NPH; ++p) { a.ph_lo = p; a.ph_hi = p + 1; a.li = p; hipLaunchKernelGGL(fwd, dim3(grid), dim3(NTHR), LDS_BYTES, stream, a); }
#else
    a.ph_lo = 0; a.ph_hi = NPH; a.li = 0;
    hipLaunchKernelGGL(fwd, dim3(grid), dim3(NTHR), LDS_BYTES, stream, a);
#endif
}
```

```cpp
#include <hip/hip_runtime.h>
#include <cstdio>
#include <cstdint>

#define GAS __attribute__((address_space(1)))
#define LAS __attribute__((address_space(3)))
typedef unsigned short bf16;
typedef short bf16x8 __attribute__((ext_vector_type(8)));
typedef short s16x4 __attribute__((ext_vector_type(4)));
typedef float f32x2 __attribute__((ext_vector_type(2)));
typedef float f32x4 __attribute__((ext_vector_type(4)));
typedef float f32x16 __attribute__((ext_vector_type(16)));
typedef unsigned u32x2 __attribute__((ext_vector_type(2)));
typedef unsigned u32x4 __attribute__((ext_vector_type(4)));
typedef __bf16 bf16x2_t __attribute__((ext_vector_type(2)));
typedef short v4i16_t __attribute__((ext_vector_type(4)));
typedef GAS unsigned gu32;
#define RLX_AGENT __ATOMIC_RELAXED, __HIP_MEMORY_SCOPE_AGENT
#define DI __device__ __forceinline__

constexpr int NB = 8, SEQ = 4096, DM = 1024, M = NB * SEQ;
constexpr int DIN = 3000, ZP = 3072;
constexpr int Z_AQ = 0, Z_AK = 512, Z_AV = 1024, Z_BQ = 1536, Z_BK = 1792, Z_BV = 2048, Z_IQ = 2304, Z_IK = 2560, Z_IW = 2592, Z_CQ = 2600, Z_CKV = 2856, Z_CKR = 2984;
constexpr int NEXP = 32, DEXP = 512, MAXROWS = 2 * M + NEXP * 256;
constexpr int MLAP = 768;
constexpr float EPS = 1e-6f, LOG2E = 1.4426950408889634f;
constexpr int NWAVES = 8, NTHR = 512;

constexpr size_t MiB = 1u << 20;
constexpr size_t WS_CTL = 0, CTL_ZERO_BYTES = 1 * MiB;
constexpr size_t WS_PAR = 1 * MiB;
constexpr size_t WS_WIN = 2 * MiB;
constexpr size_t WS_WOUT = 14 * MiB;
constexpr size_t WS_WUQ = 18 * MiB;
constexpr size_t WS_WUKV = WS_WUQ + 256 * 1024;
constexpr size_t WS_WR = WS_WUQ + 512 * 1024;
constexpr size_t WS_ROUTE = 19 * MiB;
constexpr size_t WS_WGU = 20 * MiB;
constexpr size_t WS_WD = 84 * MiB;
constexpr size_t WS_XA = 116 * MiB;
constexpr size_t WS_XN = 116 * MiB;
constexpr size_t WS_Z = 180 * MiB;
constexpr size_t WS_MLA = 372 * MiB;
constexpr size_t WS_MASK = 444 * MiB;
constexpr size_t WS_KIDX = 460 * MiB;
constexpr size_t WS_O0 = 462 * MiB;
constexpr size_t WS_XT = WS_Z + 128 * MiB;
constexpr size_t WS_SRC = WS_Z + 176 * MiB;
constexpr size_t WS_RS = WS_Z + 177 * MiB;
constexpr size_t WS_END = 478 * MiB;
constexpr size_t PAR_LAM = 0, PAR_LUT = 256, PAR_ORD = 8704, PAR_COS = 16384, PAR_SIN = 16384 + 131072;
constexpr size_t RT_E = 0, RT_G = 262144, RT_D = 524288, RT_CNT = 786432, RT_BLK = 786432 + 32768, RT_NBLK = 786432 + 36864, RT_RSTD = 786432 + 65536;
constexpr int CW_BAR = 4096;
constexpr int CW_QCTR = 200000;
constexpr int RING_BYTES = 131072, AUX_OFF = RING_BYTES, AUX_BYTES = 8192, MISC_OFF = AUX_OFF + AUX_BYTES, PARK_A = 81920, PARK_B = MISC_OFF + 256, ORD_OFF = PARK_B + 16384, LDS_BYTES = ORD_OFF + 6144;

DI float bf2f(bf16 v) { return __builtin_bit_cast(float, (unsigned)v << 16); }
DI unsigned cvtpk(float lo, float hi) { f32x2 v = {lo, hi}; bf16x2_t b = __builtin_convertvector(v, bf16x2_t); return __builtin_bit_cast(unsigned, b); }
DI bf16 f2bf(float f) { return (bf16)(cvtpk(f, 0.f) & 0xffffu); }
DI float wave_sum(float v) {
#pragma unroll
    for (int o = 1; o < 64; o <<= 1) v += __shfl_xor(v, o);
    return v;
}
DI float halfswap_max(float m) { auto rr = __builtin_amdgcn_permlane32_swap(__float_as_uint(m), __float_as_uint(m), false, false); return fmaxf(__uint_as_float(rr[0]), __uint_as_float(rr[1])); }
DI float halfswap_sum(float m) { auto rr = __builtin_amdgcn_permlane32_swap(__float_as_uint(m), __float_as_uint(m), false, false); return __uint_as_float(rr[0]) + __uint_as_float(rr[1]); }
#define MFMA32(a, b, c) __builtin_amdgcn_mfma_f32_32x32x16_bf16((a), (b), (c), 0, 0, 0)
namespace pg8 {
#define PG8_LAS __attribute__((address_space(3)))
typedef unsigned short bf16_t;
constexpr int BM = 256, BK = 64, HALF = 128, HTB = HALF * BK * 2  , STAGE_BYTES = 8 * HTB, NXCD = 8, WGM = 8;

__host__ __device__ __forceinline__ int lds_byte(int r, int c) { const int st = (r >> 4) * 2 + (c >> 5), rr = r & 15, cc = c & 31, ob = rr * 64 + cc * 2; return st * 1024 + (ob ^ (((ob >> 9) & 1) << 5)); }
__host__ __device__ __forceinline__ void stage_rc(int b, int& R, int& C) { const int st = b / 1024, sb = b % 1024, swz = sb ^ (((sb >> 9) & 1) << 5); R = (st >> 1) * 16 + swz / 64; C = (st & 1) * 32 + (swz % 64) / 2; }
__host__ __device__ __forceinline__ int perm32(int rho) { const int n = rho >> 4, i = rho & 15; return 8 * (i >> 2) + 4 * n + (i & 3); }

struct Unit { int pm, pn, pb; };
struct Gemm { const void* A; const void* Bt; int lda, K; };

struct StaticOrder {
    static constexpr const int* src = nullptr;
    int nM, nN, nwg, G, c, rep = 1;
    __host__ __device__ void init(int M_, int N_, int G_, int c_) { nM = M_ / BM; nN = N_ / BM; nwg = nM * nN; G = G_; c = c_; }
    __host__ __device__ bool next(int i, Unit& u) const {
        if (rep > 1) { const int cntU = c < nwg ? (nwg - c + G - 1) / G : 0; if (i >= cntU * rep) return false; i %= cntU; }
        const long L = (long)i * G + c; if (L >= nwg) return false;
        int wgid = (int)L; { const int q = nwg / NXCD, r = nwg % NXCD, xcd = wgid % NXCD, off = wgid / NXCD; wgid = (xcd < r ? xcd * (q + 1) : r * (q + 1) + (xcd - r) * q) + off; }
        const int nig = WGM * nN, gid = wgid / nig, fm = gid * WGM, gsz = (nM - fm) < WGM ? (nM - fm) : WGM;
        u.pm = fm + ((wgid % nig) % gsz); u.pn = (wgid % nig) / gsz; u.pb = u.pn; return true;
    }
    __device__ __forceinline__ void a_ready(const Unit&) const {}
    __device__ __forceinline__ void done(const Unit&) const {}
};
struct MoeOrder {
    const int* blk_e; int nunits, G, c, rep = 1; const int* src = nullptr;
    __device__ __forceinline__ bool next(int i, Unit& u) const {
        if (rep > 1) { const int cntU = c < nunits ? (nunits - c + G - 1) / G : 0; if (i >= cntU * rep) return false; i %= cntU; }
        int pm, pn;
        if ((G & 31) == 0) { const int x = c & 7, j = c >> 3, rpx = G >> 5; pm = i * (G >> 2) + x * rpx + (j >> 2); pn = j & 3; }
        else { const int L = i * G + c; pm = L >> 2; pn = L & 3; }
        if (pm * 4 >= nunits) return false;
        u.pm = pm; u.pn = pn; u.pb = blk_e[pm] * 4 + pn; return true;
    }
    __device__ __forceinline__ void a_ready(const Unit&) const {}
    __device__ __forceinline__ void done(const Unit&) const {}
};

struct EpiBf16 {
    static constexpr bool PERM = true, AFTER_DRAIN = false;
    bf16_t* O; int ldc; float scale = 1.f;
    __device__ __forceinline__ void operator()(const f32x4 (&acc)[2][2][4][2], const Unit& u, int wr, int wc, int fr, int fq) const {
        const int row0 = u.pm * BM + wr * 64 + fr, col0 = u.pn * BM + wc * 32 + 8 * fq;
#pragma unroll
        for (int ai = 0; ai < 2; ++ai)
#pragma unroll
            for (int m = 0; m < 4; ++m) { bf16_t* rowp = O + (size_t)(row0 + ai * HALF + m * 16) * ldc + col0;
#pragma unroll
                for (int bj = 0; bj < 2; ++bj) { const f32x4 v0 = acc[ai][bj][m][0] * scale, v1 = acc[ai][bj][m][1] * scale;
                    u32x4 w; w.x = cvtpk(v0[0], v0[1]); w.y = cvtpk(v0[2], v0[3]); w.z = cvtpk(v1[0], v1[1]); w.w = cvtpk(v1[2], v1[3]);
                    *(u32x4*)(rowp + bj * HALF) = w; } }
    }
};
struct EpiF8 {
    static constexpr bool PERM = true, AFTER_DRAIN = false;
    unsigned char* O; int ldc; float scale;
    __device__ __forceinline__ void operator()(const f32x4 (&acc)[2][2][4][2], const Unit& u, int wr, int wc, int fr, int fq) const {
        const int row0 = u.pm * BM + wr * 64 + fr, col0 = u.pn * BM + wc * 32 + 8 * fq;
#pragma unroll
        for (int ai = 0; ai < 2; ++ai)
#pragma unroll
            for (int m = 0; m < 4; ++m) { unsigned char* rowp = O + (size_t)(row0 + ai * HALF + m * 16) * ldc + col0;
#pragma unroll
                for (int bj = 0; bj < 2; ++bj) { float h[8];
#pragma unroll
                    for (int n = 0; n < 2; ++n)
#pragma unroll
                        for (int e = 0; e < 4; ++e) h[4 * n + e] = __builtin_amdgcn_fmed3f(acc[ai][bj][m][n][e] * scale, -448.f, 448.f);
                    int w0 = 0, w1 = 0;
                    w0 = __builtin_amdgcn_cvt_pk_fp8_f32(h[0], h[1], w0, false); w0 = __builtin_amdgcn_cvt_pk_fp8_f32(h[2], h[3], w0, true);
                    w1 = __builtin_amdgcn_cvt_pk_fp8_f32(h[4], h[5], w1, false); w1 = __builtin_amdgcn_cvt_pk_fp8_f32(h[6], h[7], w1, true);
                    u32x2 w; w.x = (unsigned)w0; w.y = (unsigned)w1; *(u32x2*)(rowp + bj * HALF) = w; } }
    }
};
struct EpiF8A {
    static constexpr bool PERM = true, AFTER_DRAIN = false;
    unsigned char* O; int ldc; float scale;
    __device__ __forceinline__ void operator()(const f32x4 (&acc)[2][2][4][2], const Unit& u, int wr, int wc, int fr, int fq) const {
        const int row0 = u.pm * BM + wr * 64 + fr, col0 = u.pn * BM + wc * 64 + 16 * fq;
#pragma unroll
        for (int ai = 0; ai < 2; ++ai)
#pragma unroll
            for (int m = 0; m < 4; ++m) { unsigned char* rowp = O + (size_t)(row0 + ai * HALF + m * 16) * ldc + col0; u32x4 w;
#pragma unroll
                for (int bj = 0; bj < 2; ++bj) { float h[8];
#pragma unroll
                    for (int n = 0; n < 2; ++n)
#pragma unroll
                        for (int e = 0; e < 4; ++e) h[4 * n + e] = __builtin_amdgcn_fmed3f(acc[ai][bj][m][n][e] * scale, -448.f, 448.f);
                    int w0 = 0, w1 = 0;
                    w0 = __builtin_amdgcn_cvt_pk_fp8_f32(h[0], h[1], w0, false); w0 = __builtin_amdgcn_cvt_pk_fp8_f32(h[2], h[3], w0, true);
                    w1 = __builtin_amdgcn_cvt_pk_fp8_f32(h[4], h[5], w1, false); w1 = __builtin_amdgcn_cvt_pk_fp8_f32(h[6], h[7], w1, true);
                    w[2 * bj] = (unsigned)w0; w[2 * bj + 1] = (unsigned)w1; }
                *(u32x4*)rowp = w; }
    }
};
struct EpiZ {
    static constexpr bool PERM = true, AFTER_DRAIN = false;
    bf16_t* O; bf16_t* KIDX;
    __device__ __forceinline__ void operator()(const f32x4 (&acc)[2][2][4][2], const Unit& u, int wr, int wc, int fr, int fq) const {
        const int row0 = u.pm * BM + wr * 64 + fr, col0 = u.pn * BM + wc * 32 + 8 * fq;
        const bool kx = (u.pn == 10) && (wc == 0);
#pragma unroll
        for (int ai = 0; ai < 2; ++ai)
#pragma unroll
            for (int m = 0; m < 4; ++m) { const int row = row0 + ai * HALF + m * 16; bf16_t* rowp = O + (size_t)row * 3072 + col0;
#pragma unroll
                for (int bj = 0; bj < 2; ++bj) { const f32x4 v0 = acc[ai][bj][m][0], v1 = acc[ai][bj][m][1];
                    u32x4 w; w.x = cvtpk(v0[0], v0[1]); w.y = cvtpk(v0[2], v0[3]); w.z = cvtpk(v1[0], v1[1]); w.w = cvtpk(v1[2], v1[3]);
                    *(u32x4*)(rowp + bj * HALF) = w;
                    if (bj == 0 && kx) *(u32x4*)(KIDX + (size_t)row * 32 + 8 * fq) = w; } }
    }
};
template <bool BASE16>
struct EpiRes {
    static constexpr bool PERM = true, AFTER_DRAIN = false;
    const void* base; bf16_t* out; const float* gain; unsigned char* XT;
    __device__ __forceinline__ void operator()(const f32x4 (&acc)[2][2][4][2], const Unit& u, int wr, int wc, int fr, int fq) const {
        const int row0 = u.pm * BM + wr * 64 + fr, col0 = u.pn * BM + wc * 32 + 8 * fq;
        f32x4 gn[2][2];
#pragma unroll
        for (int bj = 0; bj < 2; ++bj) { gn[bj][0] = *(const f32x4*)(gain + col0 + bj * HALF); gn[bj][1] = *(const f32x4*)(gain + col0 + bj * HALF + 4); }
#pragma unroll
        for (int ai = 0; ai < 2; ++ai)
#pragma unroll
            for (int m = 0; m < 4; ++m) { const size_t off = (size_t)(row0 + ai * HALF + m * 16) * 1024 + col0;
#pragma unroll
                for (int bj = 0; bj < 2; ++bj) { f32x4 b0, b1;
                    if constexpr (BASE16) { const u32x4 bw = *(const u32x4*)((const bf16_t*)base + off + bj * HALF);
                        b0 = (f32x4){__uint_as_float(bw.x << 16), __uint_as_float(bw.x & 0xffff0000u), __uint_as_float(bw.y << 16), __uint_as_float(bw.y & 0xffff0000u)};
                        b1 = (f32x4){__uint_as_float(bw.z << 16), __uint_as_float(bw.z & 0xffff0000u), __uint_as_float(bw.w << 16), __uint_as_float(bw.w & 0xffff0000u)}; }
                    else { b0 = *(const f32x4*)((const float*)base + off + bj * HALF); b1 = *(const f32x4*)((const float*)base + off + bj * HALF + 4); }
                    const f32x4 o0 = b0 + acc[ai][bj][m][0], o1 = b1 + acc[ai][bj][m][1];
                    { u32x4 ow; ow.x = cvtpk(o0[0], o0[1]); ow.y = cvtpk(o0[2], o0[3]); ow.z = cvtpk(o1[0], o1[1]); ow.w = cvtpk(o1[2], o1[3]); *(u32x4*)(out + off + bj * HALF) = ow; }
                    const f32x4 t0 = o0 * gn[bj][0], t1 = o1 * gn[bj][1]; int w0 = 0, w1 = 0;
                    w0 = __builtin_amdgcn_cvt_pk_fp8_f32(t0[0], t0[1], w0, false); w0 = __builtin_amdgcn_cvt_pk_fp8_f32(t0[2], t0[3], w0, true);
                    w1 = __builtin_amdgcn_cvt_pk_fp8_f32(t1[0], t1[1], w1, false); w1 = __builtin_amdgcn_cvt_pk_fp8_f32(t1[2], t1[3], w1, true);
                    u32x2 w8; w8.x = (unsigned)w0; w8.y = (unsigned)w1; *(u32x2*)(XT + off + bj * HALF) = w8; } }
    }
};
struct EpiGU {
    static constexpr bool PERM = true, AFTER_DRAIN = false;
    unsigned char* H; const float* RS;
    __device__ __forceinline__ void operator()(const f32x4 (&acc)[2][2][4][2], const Unit& u, int wr, int wc, int fr, int fq) const {
        const int row0 = u.pm * BM + wr * 64 + fr, col0 = u.pn * HALF + wc * 32 + 8 * fq;
        float rs[2][4];
#pragma unroll
        for (int ai = 0; ai < 2; ++ai)
#pragma unroll
            for (int m = 0; m < 4; ++m) rs[ai][m] = RS[row0 + ai * HALF + m * 16] * 0.03125f;
#pragma unroll
        for (int ai = 0; ai < 2; ++ai)
#pragma unroll
            for (int m = 0; m < 4; ++m) { unsigned char* rowp = H + (size_t)(row0 + ai * HALF + m * 16) * 512 + col0;
                float h[8];
#pragma unroll
                for (int n = 0; n < 2; ++n)
#pragma unroll
                    for (int e = 0; e < 4; ++e) { const float g = acc[ai][0][m][n][e] * rs[ai][m], up = acc[ai][1][m][n][e] * rs[ai][m];
                        const float hv = 8.f * g * __builtin_amdgcn_rcpf(1.f + __builtin_amdgcn_exp2f(-g * 1.4426950408889634f)) * up;
                        h[4 * n + e] = __builtin_amdgcn_fmed3f(hv, -448.f, 448.f); }
                int w0 = 0, w1 = 0;
                w0 = __builtin_amdgcn_cvt_pk_fp8_f32(h[0], h[1], w0, false); w0 = __builtin_amdgcn_cvt_pk_fp8_f32(h[2], h[3], w0, true);
                w1 = __builtin_amdgcn_cvt_pk_fp8_f32(h[4], h[5], w1, false); w1 = __builtin_amdgcn_cvt_pk_fp8_f32(h[6], h[7], w1, true);
                u32x2 w; w.x = (unsigned)w0; w.y = (unsigned)w1; *(u32x2*)rowp = w; }
    }
};

template <class Epi, class Sched, bool ALIGN_EPI = false, bool SP2 = false, int ESZ = 2  ,
          bool GATHER = false  ,
          bool BADJ = false  >
__device__ __forceinline__ void gemm_phase(PG8_LAS unsigned char* lds, const Gemm g, const Sched& S, const Epi& E, const int tid) {
    const int wid = __builtin_amdgcn_readfirstlane(tid >> 6), lane = tid & 63, wr = wid >> 2, wc = wid & 3, fr = lane & 15, fq = lane >> 4;
    const int K = g.K, nt = K * ESZ / (BK * 2);
    unsigned voffA[2], voffB[2], colA[2]; int rowA[2];
#pragma unroll
    for (int i = 0; i < 2; ++i) { int R, C; stage_rc(tid * 16 + i * 8192, R, C); const int c32_ = perm32(R & 31);
        const int Rb = BADJ ? (64 * (R >> 5) + 16 * (c32_ >> 3) + (c32_ & 7)) : (Epi::PERM ? ((R & ~31) + c32_) : R);
        voffA[i] = (unsigned)(R * g.lda * ESZ + C * 2); voffB[i] = (unsigned)(Rb * K * ESZ + C * 2); rowA[i] = R; colA[i] = (unsigned)(C * 2); }
    unsigned vgc[2][2], vgn[2][2];
#define PG8_SRC(u, vg) do { _Pragma("unroll") for (int h_ = 0; h_ < 2; ++h_) _Pragma("unroll") for (int i_ = 0; i_ < 2; ++i_) \
        vg[h_][i_] = (unsigned)S.src[(u).pm * BM + h_ * HALF + rowA[i_]] * (unsigned)(g.lda * ESZ) + colA[i_]; } while (0)
#define PG8_STAGE_A(bufoff, gbase, h, VG) do { if constexpr (GATHER) PG8_STAGE(bufoff, gbase, VG[h]); else PG8_STAGE(bufoff, (gbase) + (h) * hstepA, voffA); } while (0)
    const size_t kstep = (size_t)(BK * 2);
    const size_t hstepA = (size_t)HALF * g.lda * ESZ, hstepB = (size_t)(BADJ ? 8 : HALF) * K * ESZ;
    const size_t tstepA = 2 * hstepA, tstepB = (size_t)BM * K * ESZ;
    const unsigned ldsw = (unsigned)wid * 1024u;
    const int aoff = lds_byte(wr * 64 + fr, fq * 8), boff = lds_byte(wc * 32 + fr, fq * 8);
#define PG8_SA(b, h) (((b) * 2 + (h)) * HTB)
#define PG8_SB(b, h) ((4 + (b) * 2 + (h)) * HTB)
#define PG8_STAGE(bufoff, gbase, voff) do { _Pragma("unroll") for (int _i = 0; _i < 2; ++_i) \
        __builtin_amdgcn_global_load_lds((const unsigned*)((const char*)(gbase) + (voff)[_i]), (PG8_LAS unsigned*)(lds + (bufoff) + ldsw + _i * 8192), 16, 0, 0); } while (0)
#define PG8_LDA(dst, b, h) do { _Pragma("unroll") for (int m = 0; m < 4; ++m) { if constexpr (ESZ == 2) { _Pragma("unroll") for (int k = 0; k < 2; ++k) dst[m][k] = *(const PG8_LAS bf16x8*)(lds + PG8_SA(b, h) + aoff + m * 2048 + k * 1024); } \
        else { const u32x4 lo_ = *(const PG8_LAS u32x4*)(lds + PG8_SA(b, h) + aoff + m * 2048), hi_ = *(const PG8_LAS u32x4*)(lds + PG8_SA(b, h) + aoff + m * 2048 + 1024); dst##8[m] = __builtin_shufflevector(lo_, hi_, 0, 1, 2, 3, 4, 5, 6, 7); } } } while (0)
#define PG8_LDB(dst, b, h) do { _Pragma("unroll") for (int n = 0; n < 2; ++n) { if constexpr (ESZ == 2) { _Pragma("unroll") for (int k = 0; k < 2; ++k) dst[n][k] = *(const PG8_LAS bf16x8*)(lds + PG8_SB(b, h) + boff + n * 2048 + k * 1024); } \
        else { const u32x4 lo_ = *(const PG8_LAS u32x4*)(lds + PG8_SB(b, h) + boff + n * 2048), hi_ = *(const PG8_LAS u32x4*)(lds + PG8_SB(b, h) + boff + n * 2048 + 1024); dst##8[n] = __builtin_shufflevector(lo_, hi_, 0, 1, 2, 3, 4, 5, 6, 7); } } } while (0)
#define PG8_MMA(ai, bj, At, Bt) do { __builtin_amdgcn_s_setprio(1); _Pragma("unroll") for (int m = 0; m < 4; ++m) _Pragma("unroll") for (int n = 0; n < 2; ++n) { \
        if constexpr (ESZ == 2) { _Pragma("unroll") for (int k = 0; k < 2; ++k) acc[ai][bj][m][n] = __builtin_amdgcn_mfma_f32_16x16x32_bf16(Bt[n][k], At[m][k], acc[ai][bj][m][n], 0, 0, 0); } \
        else acc[ai][bj][m][n] = __builtin_amdgcn_mfma_scale_f32_16x16x128_f8f6f4(__builtin_bit_cast(v8i_t, Bt##8[n]), __builtin_bit_cast(v8i_t, At##8[m]), acc[ai][bj][m][n], 0, 0, 0, 0, 0, 0); } \
        __builtin_amdgcn_s_setprio(0); if constexpr (ESZ == 1) { _Pragma("unroll") for (int m = 0; m < 4; ++m) _Pragma("unroll") for (int n = 0; n < 2; ++n) asm volatile("" : "+v"(acc[ai][bj][m][n])); } } while (0)
#define PG8_WAIT_V(n) asm volatile("s_waitcnt vmcnt(" #n ")" ::: "memory")
#define PG8_WAIT_L(n) asm volatile("s_waitcnt lgkmcnt(" #n ")" ::: "memory")
#define PG8_BAR __builtin_amdgcn_s_barrier()
#define PG8_SCHED __builtin_amdgcn_sched_barrier(0)
    Unit cur, nxt; int ui = 0;
    if (!S.next(0, cur)) return;
    f32x4 acc[2][2][4][2];
#pragma unroll
    for (int a = 0; a < 2; ++a)
#pragma unroll
        for (int b = 0; b < 2; ++b)
#pragma unroll
            for (int m = 0; m < 4; ++m)
#pragma unroll
                for (int n = 0; n < 2; ++n) acc[a][b][m][n] = (f32x4){0.f, 0.f, 0.f, 0.f};
    typedef int v8i_t __attribute__((ext_vector_type(8))); typedef unsigned u32x8_t __attribute__((ext_vector_type(8)));
    bf16x8 At[4][2], B0[2][2], B1[2][2]; u32x8_t At8[4], B08[2], B18[2];
    const char* cA = (const char*)g.A + (GATHER ? (size_t)0 : (size_t)cur.pm * tstepA); const char* cB = (const char*)g.Bt + (size_t)cur.pb * tstepB;
    if constexpr (GATHER) PG8_SRC(cur, vgc);
    S.a_ready(cur);
    if constexpr (SP2) {
        PG8_STAGE(PG8_SB(0, 0), cB, voffB); PG8_STAGE(PG8_SB(0, 1), cB + hstepB, voffB); PG8_STAGE_A(PG8_SA(0, 0), cA, 0, vgc); PG8_STAGE_A(PG8_SA(0, 1), cA, 1, vgc);
        if (wr == 1) PG8_BAR;
        PG8_WAIT_V(2); PG8_BAR;
        PG8_STAGE(PG8_SB(1, 0), cB + kstep, voffB); PG8_STAGE_A(PG8_SA(1, 0), cA + kstep, 0, vgc); PG8_STAGE(PG8_SB(1, 1), cB + hstepB + kstep, voffB);
        PG8_WAIT_V(6); PG8_BAR;
    } else {
        PG8_STAGE(PG8_SB(0, 0), cB, voffB); PG8_STAGE(PG8_SA(0, 0), cA, voffA); PG8_STAGE(PG8_SB(0, 1), cB + hstepB, voffB); PG8_STAGE(PG8_SA(0, 1), cA + hstepA, voffA);
        if (wr == 1) PG8_BAR;
        PG8_WAIT_V(4); PG8_BAR;
        PG8_STAGE(PG8_SB(1, 0), cB + kstep, voffB); PG8_STAGE(PG8_SA(1, 0), cA + kstep, voffA); PG8_STAGE(PG8_SB(1, 1), cB + hstepB + kstep, voffB);
        PG8_WAIT_V(6); PG8_BAR;
    }
    for (;;) {
        const bool has_next = S.next(ui + 1, nxt);
        const char* nA = (has_next && !GATHER) ? (const char*)g.A + (size_t)nxt.pm * tstepA : cA; const char* nB = has_next ? (const char*)g.Bt + (size_t)nxt.pb * tstepB : cB;
        if constexpr (GATHER) { static_assert(!GATHER || SP2, "GATHER is wired into the SP2 loop only"); if (has_next) PG8_SRC(nxt, vgn); else { _Pragma("unroll") for (int h_ = 0; h_ < 2; ++h_) _Pragma("unroll") for (int i_ = 0; i_ < 2; ++i_) vgn[h_][i_] = vgc[h_][i_]; } }
#pragma unroll 1
        for (int t = 0; t < nt; t += 2) {
            const bool last = (t == nt - 2);
            const char* a1 = cA + (size_t)(t + 1) * kstep;
            const char* a2 = last ? nA : cA + (size_t)(t + 2) * kstep; const char* b2 = last ? nB : cB + (size_t)(t + 2) * kstep;
            const char* a3 = a2 + kstep; const char* b3 = b2 + kstep;
            if (last && has_next) S.a_ready(nxt);
            unsigned vg2[2][2];
            if constexpr (GATHER) { _Pragma("unroll") for (int h_ = 0; h_ < 2; ++h_) _Pragma("unroll") for (int i_ = 0; i_ < 2; ++i_) vg2[h_][i_] = last ? vgn[h_][i_] : vgc[h_][i_]; }
            if constexpr (SP2) {
            PG8_LDB(B0, 0, 0); PG8_LDB(B1, 0, 1); PG8_SCHED; PG8_LDA(At, 0, 0); PG8_STAGE_A(PG8_SA(1, 1), a1, 1, vgc);
            PG8_WAIT_V(8); PG8_WAIT_L(0); PG8_BAR; PG8_MMA(0, 0, At, B0); PG8_MMA(0, 1, At, B1); PG8_BAR; PG8_SCHED;
            PG8_LDA(At, 0, 1); PG8_STAGE(PG8_SB(0, 0), b2, voffB); PG8_STAGE(PG8_SB(0, 1), b2 + hstepB, voffB); PG8_STAGE_A(PG8_SA(0, 0), a2, 0, vg2);
            PG8_WAIT_V(8); PG8_WAIT_L(0); PG8_BAR; PG8_MMA(1, 0, At, B0); PG8_MMA(1, 1, At, B1); PG8_BAR; PG8_SCHED;
            PG8_LDB(B0, 1, 0); PG8_LDB(B1, 1, 1); PG8_SCHED; PG8_LDA(At, 1, 0); PG8_STAGE_A(PG8_SA(0, 1), a2, 1, vg2);
            PG8_WAIT_V(8); PG8_WAIT_L(0); PG8_BAR; PG8_MMA(0, 0, At, B0); PG8_MMA(0, 1, At, B1); PG8_BAR; PG8_SCHED;
            PG8_LDA(At, 1, 1); PG8_STAGE(PG8_SB(1, 0), b3, voffB); PG8_STAGE(PG8_SB(1, 1), b3 + hstepB, voffB); PG8_STAGE_A(PG8_SA(1, 0), a3, 0, vg2);
            PG8_WAIT_V(8); PG8_WAIT_L(0); PG8_BAR; PG8_MMA(1, 0, At, B0); PG8_MMA(1, 1, At, B1); PG8_BAR; PG8_SCHED;
            } else {
            PG8_LDB(B0, 0, 0); PG8_SCHED; PG8_LDA(At, 0, 0); PG8_STAGE(PG8_SA(1, 1), a1 + hstepA, voffA);
            PG8_WAIT_L(8); PG8_BAR; PG8_WAIT_L(0); PG8_MMA(0, 0, At, B0); PG8_BAR; PG8_SCHED;
            PG8_LDB(B1, 0, 1); PG8_STAGE(PG8_SB(0, 0), b2, voffB);
            PG8_BAR; PG8_WAIT_L(0); PG8_MMA(0, 1, At, B1); PG8_BAR;
            PG8_LDA(At, 0, 1); PG8_STAGE(PG8_SA(0, 0), a2, voffA);
            PG8_BAR; PG8_WAIT_L(0); PG8_MMA(1, 0, At, B0); PG8_BAR; PG8_SCHED;
            PG8_STAGE(PG8_SB(0, 1), b2 + hstepB, voffB);
            PG8_WAIT_V(6); PG8_BAR; PG8_MMA(1, 1, At, B1); PG8_BAR;
            PG8_LDB(B0, 1, 0); PG8_SCHED; PG8_LDA(At, 1, 0); PG8_STAGE(PG8_SA(0, 1), a2 + hstepA, voffA);
            PG8_WAIT_L(8); PG8_BAR; PG8_WAIT_L(0); PG8_MMA(0, 0, At, B0); PG8_BAR; PG8_SCHED;
            PG8_LDB(B1, 1, 1); PG8_STAGE(PG8_SB(1, 0), b3, voffB);
            PG8_BAR; PG8_WAIT_L(0); PG8_MMA(0, 1, At, B1); PG8_BAR;
            PG8_LDA(At, 1, 1); PG8_STAGE(PG8_SA(1, 0), a3, voffA);
            PG8_BAR; PG8_WAIT_L(0); PG8_MMA(1, 0, At, B0); PG8_BAR; PG8_SCHED;
            PG8_STAGE(PG8_SB(1, 1), b3 + hstepB, voffB);
            PG8_WAIT_V(6); PG8_BAR; PG8_MMA(1, 1, At, B1); PG8_BAR;
            }
        }
        if constexpr (ALIGN_EPI) { if (wr == 0) PG8_BAR; }
        if constexpr (!Epi::AFTER_DRAIN) { E(acc, cur, wr, wc, fr, fq); S.done(cur); }
        if (!has_next) break;
#pragma unroll
        for (int a = 0; a < 2; ++a)
#pragma unroll
            for (int b = 0; b < 2; ++b)
#pragma unroll
                for (int m = 0; m < 4; ++m)
#pragma unroll
                    for (int n = 0; n < 2; ++n) acc[a][b][m][n] = (f32x4){0.f, 0.f, 0.f, 0.f};
        cur = nxt; cA = nA; cB = nB; ++ui;
        if constexpr (GATHER) { _Pragma("unroll") for (int h_ = 0; h_ < 2; ++h_) _Pragma("unroll") for (int i_ = 0; i_ < 2; ++i_) vgc[h_][i_] = vgn[h_][i_]; }
        if constexpr (ALIGN_EPI) { if (wr == 1) PG8_BAR; }
    }
    PG8_WAIT_V(0);
    if constexpr (!ALIGN_EPI) { if (wr == 0) PG8_BAR; }
    PG8_BAR;
    if constexpr (Epi::AFTER_DRAIN) { E.fused(acc, cur, wr, wc, fr, fq, lds, wid, lane); S.done(cur); }
#undef PG8_SA
#undef PG8_SB
#undef PG8_STAGE
#undef PG8_STAGE_A
#undef PG8_SRC
#undef PG8_LDA
#undef PG8_LDB
#undef PG8_MMA
#undef PG8_WAIT_V
#undef PG8_WAIT_L
#undef PG8_BAR
#undef PG8_SCHED
}
}

#define XB_TMO      128
#define XB_XCNT(j)  (256  + 64 * (j))
#define XB_XSUB(j)  (1280 + 64 * (j))
#define XB_XGEN(j)  (2304 + 64 * (j))
#define XB_TOP      3328
#define XB_TOPGEN   3392
#define XCD_BAR_WORDS 3456
#define XB_SPIN_CAP (1u << 18)

__device__ __forceinline__ unsigned xb_ld(unsigned* p)              { return __hip_atomic_load(p, __ATOMIC_RELAXED, __HIP_MEMORY_SCOPE_AGENT); }
__device__ __forceinline__ unsigned xb_add(unsigned* p, unsigned v) { return __hip_atomic_fetch_add(p, v, __ATOMIC_RELAXED, __HIP_MEMORY_SCOPE_AGENT); }
__device__ __forceinline__ unsigned xb_xcc_id() { return (unsigned)__builtin_amdgcn_s_getreg((3 << 11) | 20) & 0xFu; }
#define XB_SPIN(cond, bar) do { unsigned _sp = 0; while (cond) { __builtin_amdgcn_s_sleep(1); \
    if ((++_sp & 255u) == 0u) { if (xb_ld(&(bar)[XB_TMO])) break; if (_sp > XB_SPIN_CAP) { atomicAdd(&(bar)[XB_TMO], 1u); break; } } } } while (0)

struct XcdBarrier {
    unsigned* bar; unsigned x;
    volatile LAS unsigned* st;
};

__device__ __forceinline__ XcdBarrier xcd_barrier_post(unsigned* bar, volatile LAS unsigned* st) {
    XcdBarrier b; b.bar = bar; b.x = xb_xcc_id(); b.st = st;
    if (threadIdx.x == 0) (void)xb_add(&bar[XB_XCNT(b.x)], 1u);
    return b;
}
__device__ __forceinline__ void xcd_barrier_complete(unsigned* bar, unsigned x, unsigned& nloc, unsigned& nx) {
    const unsigned G = gridDim.x * gridDim.y * gridDim.z;
    unsigned sum, cnt, mine, sp = 0u;
    for (;;) {
        sum = 0u; cnt = 0u; mine = 0u;
#pragma unroll
        for (unsigned j = 0; j < 16; ++j) { const unsigned c = xb_ld(&bar[XB_XCNT(j)]); sum += c; cnt += (c > 0u) ? 1u : 0u; mine = (j == x) ? c : mine; }
        if (sum == G) break;
        __builtin_amdgcn_s_sleep(1);
        if ((++sp & 255u) == 0u) { if (xb_ld(&bar[XB_TMO])) break; if (sp > XB_SPIN_CAP) { atomicAdd(&bar[XB_TMO], 1u); break; } }
    }
    nloc = mine > 0u ? mine : 1u; nx = cnt > 0u ? cnt : 1u;
}

__device__ __forceinline__ void xcd_barrier(const XcdBarrier& b) {
    asm volatile("s_waitcnt vmcnt(0)" ::: "memory");
    __syncthreads();
    if (threadIdx.x == 0) {
        unsigned* bar = b.bar;
        __builtin_amdgcn_s_waitcnt(0);
        unsigned nloc = b.st[0], nx = b.st[1];
        if (nloc == 0u) { xcd_barrier_complete(bar, b.x, nloc, nx); b.st[0] = nloc; b.st[1] = nx; }
        const unsigned old = xb_add(&bar[XB_XSUB(b.x)], 1u);
        const unsigned gen = old / nloc;
        if (old + 1u == (gen + 1u) * nloc) {
            __builtin_amdgcn_fence(__ATOMIC_RELEASE, "agent");
            asm volatile("s_waitcnt vmcnt(0)" ::: "memory");
            const unsigned og = xb_add(&bar[XB_TOP], 1u);
            const unsigned tg = og / nx;
            if (og + 1u == (tg + 1u) * nx) xb_add(&bar[XB_TOPGEN], 1u);
            else XB_SPIN(xb_ld(&bar[XB_TOPGEN]) == tg, bar);
            __builtin_amdgcn_fence(__ATOMIC_ACQUIRE, "agent");
            xb_add(&bar[XB_XGEN(b.x)], 1u);
            asm volatile("s_waitcnt vmcnt(0)" ::: "memory");
        } else {
            XB_SPIN(xb_ld(&bar[XB_XGEN(b.x)]) == gen, bar);
            __builtin_amdgcn_fence(__ATOMIC_ACQUIRE, "agent");
            asm volatile("s_waitcnt vmcnt(0)" ::: "memory");
        }
    }
    __syncthreads();
}

template <class Fetch, class Dst>
DI void tr_item(LAS float* scr, int k0, int n0, int lane, const Fetch& fetch, const Dst& dst) {
#pragma unroll 8
    for (int i = 0; i < 32; ++i) { const int kk = 2 * i + (lane >> 5); scr[kk * 33 + (lane & 31)] = fetch(k0 + kk, n0 + (lane & 31)); }
    asm volatile("s_waitcnt lgkmcnt(0)" ::: "memory");
    const int c = lane & 7;
#pragma unroll
    for (int j = 0; j < 4; ++j) { const int n = (lane >> 3) + 8 * j; const LAS float* s = scr + (8 * c) * 33 + n;
        u32x4 o; o.x = cvtpk(s[0], s[33]); o.y = cvtpk(s[66], s[99]); o.z = cvtpk(s[132], s[165]); o.w = cvtpk(s[198], s[231]);
        *(u32x4*)(dst(n0 + n) + k0 + 8 * c) = o; }
    asm volatile("s_waitcnt lgkmcnt(0)" ::: "memory");
}

DI int t5_bucket(int rel) {
    const int n = rel < 0 ? -rel : rel; const int ret = rel > 0 ? 16 : 0;
    int v;
    if (n < 8) v = n; else if (n < 12) v = 8; else if (n < 16) v = 9; else if (n < 23) v = 10; else if (n < 32) v = 11; else if (n < 46) v = 12; else if (n < 64) v = 13; else if (n < 91) v = 14; else v = 15;
    return ret + v;
}

struct MoeItem { const float* src; unsigned char* dst; int ns, kd; };
DI MoeItem moe_item_of(const float* w_gate, const float* w_up, const float* w_down, unsigned char* WGU, unsigned char* WD, int it) {
    constexpr int I_GU = NEXP * 16 * 16 * 2;
    MoeItem m;
    if (it < I_GU) { const int up = it & 1, r = it >> 1, nb = r & 15, kb = (r >> 4) & 15, e = r >> 8; const int n0 = nb * 32;
        m.src = (up ? w_up : w_gate) + (size_t)e * 1024 * 512 + (size_t)(kb * 64) * 512 + n0; m.ns = 512; m.kd = 1024;
        m.dst = WGU + (size_t)e * 1024 * 1024 + (size_t)((up ? 128 : 0) + ((n0 >> 7) << 8) + (n0 & 127)) * 1024 + kb * 64;
    } else { const int r = it - I_GU, nb = r & 31, kb = (r >> 5) & 7, e = r >> 8;
        m.src = w_down + (size_t)e * 512 * 1024 + (size_t)(kb * 64) * 1024 + nb * 32; m.ns = 1024; m.kd = 512;
        m.dst = WD + (size_t)e * 1024 * 512 + (size_t)(nb * 32) * 512 + kb * 64; }
    return m;
}
DI void moe_item_load(const MoeItem& m, f32x4 (&r)[8], int lane) {
#pragma unroll
    for (int i = 0; i < 8; ++i) r[i] = __builtin_nontemporal_load((const f32x4*)(m.src + (size_t)(8 * i + (lane >> 3)) * m.ns + 4 * (lane & 7)));
}
DI void moe_item_store(const MoeItem& m, const f32x4 (&r)[8], LAS float* scr, int lane) {
#pragma unroll
    for (int i = 0; i < 8; ++i) { LAS float* p = scr + (8 * i + (lane >> 3)) * 33 + 4 * (lane & 7); p[0] = r[i][0]; p[1] = r[i][1]; p[2] = r[i][2]; p[3] = r[i][3]; }
    asm volatile("s_waitcnt lgkmcnt(0)" ::: "memory");
    const int c = lane & 3;
#pragma unroll
    for (int j = 0; j < 2; ++j) { const int n = (lane >> 2) + 16 * j; const LAS float* s = scr + (16 * c) * 33 + n;
        u32x4 o;
#pragma unroll
        for (int q = 0; q < 4; ++q) { int w = 0;
            w = __builtin_amdgcn_cvt_pk_fp8_f32(s[(4 * q) * 33] * 32.f, s[(4 * q + 1) * 33] * 32.f, w, false);
            w = __builtin_amdgcn_cvt_pk_fp8_f32(s[(4 * q + 2) * 33] * 32.f, s[(4 * q + 3) * 33] * 32.f, w, true); o[q] = (unsigned)w; }
        *(u32x4*)(m.dst + (size_t)n * m.kd + 16 * c) = o; }
    asm volatile("s_waitcnt lgkmcnt(0)" ::: "memory");
}
template <int NI>
DI void moe_convert_items(const float* w_gate, const float* w_up, const float* w_down, unsigned char* WGU, unsigned char* WD, LAS float* scr, int it0, int lane) {
    f32x4 ra[NI][8]; MoeItem ma[NI];
#pragma unroll
    for (int i = 0; i < NI; ++i) { ma[i] = moe_item_of(w_gate, w_up, w_down, WGU, WD, it0 + i); moe_item_load(ma[i], ra[i], lane); }
#pragma unroll
    for (int i = 0; i < NI; ++i) moe_item_store(ma[i], ra[i], scr, lane);
}
constexpr int MOE_CONV_ITEMS = NEXP * 16 * 16 * 2 + NEXP * 8 * 32;

struct In {
    const float *x, *w_in, *w_out, *norm_mix, *norm_ffn, *rel_bias, *lam_q1, *lam_k1, *lam_q2, *lam_k2, *diff_subln, *mla_q_norm, *mla_kv_norm, *w_uq, *w_ukv,
                *w_group, *b_group, *w_expert, *b_expert, *w_gate, *w_up, *w_down, *norm_final;
};

DI void prologue_phase(const In& I, unsigned char* ws, LAS unsigned char* lds, int gw, int NGW, int lane, int wave) {
    LAS float* scr = (LAS float*)(lds + wave * 16384);
    bf16* WinT = (bf16*)(ws + WS_WIN); bf16* WoT = (bf16*)(ws + WS_WOUT); bf16* WuqT = (bf16*)(ws + WS_WUQ); bf16* WukvT = (bf16*)(ws + WS_WUKV); bf16* WR = (bf16*)(ws + WS_WR);
    constexpr int I1 = 2 * 16 * 96, I2 = 2 * 16 * 32, I3 = 2 * 4 * 6, I4 = 2 * 2 * 12, I5 = 2 * 2 * 16 * 2;
    for (int it = gw; it < I1 + I2 + I3 + I4 + I5; it += NGW) {
        int r = it;
        if (r < I1) { const int l = r / 1536, q = r % 1536, kb = q / 96, nb = q % 96; const float* W = I.w_in + (size_t)l * 1024 * DIN; bf16* D = WinT + (size_t)l * ZP * 1024;
            tr_item(scr, kb * 64, nb * 32, lane, [=](int k, int n) { if (n >= DIN) return 0.f; float s = 1.f; if (n < 512 || (n >= Z_BQ && n < Z_BK)) s = 0.125f * LOG2E; else if (n >= Z_IW && n < Z_CQ) s = 0.0625f; return W[(size_t)k * DIN + n] * s; },
                    [=](int n) { return D + (size_t)n * 1024; }); continue; }
        r -= I1;
        if (r < I2) { const int l = r / 512, q = r % 512, kb = q / 32, nb = q % 32; const float* W = I.w_out + (size_t)l * 1024 * 1024; bf16* D = WoT + (size_t)l * 1024 * 1024;
            tr_item(scr, kb * 64, nb * 32, lane, [=](int k, int n) { return W[(size_t)k * 1024 + n]; }, [=](int n) { return D + (size_t)n * 1024; }); continue; }
        r -= I2;
        if (r < I3) { const int l = r / 24, q = r % 24, kb = q / 6, nb = q % 6; const float* W = I.w_uq + (size_t)l * 256 * 192; const float* g = I.mla_q_norm + l * 256; bf16* D = WuqT + (size_t)l * 192 * 256;
            const float qs = 0.14433756729740643f * LOG2E;
            tr_item(scr, kb * 64, nb * 32, lane, [=](int k, int n) { const int o = n < 128 ? (n >> 5) * 48 + (n & 31) : ((n - 128) >> 4) * 48 + 32 + ((n - 128) & 15); return W[(size_t)k * 192 + o] * g[k] * qs; },
                    [=](int n) { return D + (size_t)n * 256; }); continue; }
        r -= I3;
        if (r < I4) { const int l = r / 24, q = r % 24, kb = q / 12, nb = q % 12; const float* W = I.w_ukv + (size_t)l * 128 * 384; const float* g = I.mla_kv_norm + l * 128; bf16* D = WukvT + (size_t)l * 384 * 128;
            tr_item(scr, kb * 64, nb * 32, lane, [=](int k, int n) { const int o = n < 128 ? (n >> 5) * 96 + (n & 31) : ((n - 128) >> 6) * 96 + 32 + ((n - 128) & 63); return W[(size_t)k * 384 + o] * g[k]; },
                    [=](int n) { return D + (size_t)n * 128; }); continue; }
        r -= I4;
        { const int lo = r & 1, q = r >> 1, nb = q & 1, kb = (q >> 1) & 15, l = q >> 5; const float* We = I.w_expert + (size_t)l * 1024 * 32; const float* Wg = I.w_group + (size_t)l * 1024 * 4; const float* gf = I.norm_ffn + (size_t)l * DM;
          bf16* D = WR + ((size_t)(l * 2 + lo) * 64) * 1024;
          tr_item(scr, kb * 64, nb * 32, lane, [=](int k, int n) { float w = (n < 32 ? We[(size_t)k * 32 + n] : (n < 36 ? Wg[(size_t)k * 4 + (n - 32)] : 0.f)) * gf[k]; if (lo) w = w - bf2f(f2bf(w)); return w; },
                  [=](int n) { return D + (size_t)n * 1024; }); }
    }
    float* par = (float*)(ws + WS_PAR);
    const int gt = gw * 64 + lane, NGT = NGW * 64;
    for (int i = gt; i < SEQ * 8; i += NGT) { const int t = i >> 3, f = i & 7; const float inv = powf(10000.f, -(float)(2 * f) / 16.f); const float ang = (float)t * inv;
        ((float*)(ws + WS_PAR + PAR_COS))[i] = cosf(ang); ((float*)(ws + WS_PAR + PAR_SIN))[i] = sinf(ang); }
    for (int i = gt; i < 8 * 256; i += NGT) { const int hh = i >> 8, rel = (i & 255) - 192; ((float*)(ws + WS_PAR + PAR_LUT))[i] = I.rel_bias[t5_bucket(rel) * 8 + hh] * LOG2E; }
    if (gw == 2 && lane == 0) {
        unsigned* ord = (unsigned*)(ws + WS_PAR + PAR_ORD); int n = 0;
        for (int c = 32; c >= 1; --c) {
            if (c % 2 == 0 && c / 2 - 1 <= 15) for (int bh = 0; bh < 32; ++bh) ord[n++] = (0u << 16) | ((unsigned)(c / 2 - 1) << 8) | (unsigned)bh;
            if (c <= 16) for (int ty = 1; ty < 3; ++ty) for (int bh = 0; bh < 32; ++bh) ord[n++] = ((unsigned)ty << 16) | ((unsigned)(c - 1) << 8) | (unsigned)bh; }
    }
    if (gw < 2) { const int l = gw; const float a = wave_sum(I.lam_q1[l * 64 + lane] * I.lam_k1[l * 64 + lane]), b = wave_sum(I.lam_q2[l * 64 + lane] * I.lam_k2[l * 64 + lane]);
        const float li = 0.8f - 0.6f * expf(-0.3f * (float)l); if (lane == 0) { par[l] = expf(a) - expf(b) + li; par[2 + l] = 1.f - li; } }
}

template <int MODE>
DI void norm_phase(const float* src, bf16* XA, float* OUT, bf16* XN, const float* gain, const unsigned char* Y  , const int* rt_d, const float* rt_g, int gw, int NGW, int lane) {
    f32x4 g4[4];
#pragma unroll
    for (int j = 0; j < 4; ++j) g4[j] = *(const f32x4*)(gain + 4 * lane + 256 * j);
    for (int m = gw; m < M; m += NGW) {
        f32x4 v[4];
        if (MODE == 0) {
#pragma unroll
            for (int j = 0; j < 4; ++j) v[j] = *(const f32x4*)(src + (size_t)m * DM + 4 * lane + 256 * j);
        } else {
#pragma unroll
            for (int j = 0; j < 4; ++j) { const u32x2 w = *(const u32x2*)(XA + (size_t)m * DM + 4 * lane + 256 * j);
                v[j] = (f32x4){__uint_as_float(w.x << 16), __uint_as_float(w.x & 0xffff0000u), __uint_as_float(w.y << 16), __uint_as_float(w.y & 0xffff0000u)}; }
        }
        if (MODE != 0) {
            const int d0 = rt_d[2 * m], d1 = rt_d[2 * m + 1]; const float w0 = rt_g[2 * m] * 0.0625f, w1 = rt_g[2 * m + 1] * 0.0625f;
            const unsigned char* y0 = Y + (size_t)d0 * DM, * y1 = Y + (size_t)d1 * DM;
#pragma unroll
            for (int j = 0; j < 4; ++j) { const int a = *(const int*)(y0 + 4 * lane + 256 * j), b = *(const int*)(y1 + 4 * lane + 256 * j);
                const f32x2 a01 = __builtin_amdgcn_cvt_pk_f32_fp8(a, false), a23 = __builtin_amdgcn_cvt_pk_f32_fp8(a, true), b01 = __builtin_amdgcn_cvt_pk_f32_fp8(b, false), b23 = __builtin_amdgcn_cvt_pk_f32_fp8(b, true);
                v[j][0] += w0 * a01[0] + w1 * b01[0]; v[j][1] += w0 * a01[1] + w1 * b01[1]; v[j][2] += w0 * a23[0] + w1 * b23[0]; v[j][3] += w0 * a23[1] + w1 * b23[1]; }
        }
        float ss = 0.f;
#pragma unroll
        for (int j = 0; j < 4; ++j) ss += (v[j][0] * v[j][0] + v[j][1] * v[j][1]) + (v[j][2] * v[j][2] + v[j][3] * v[j][3]);
        const float rstd = rsqrtf(wave_sum(ss) * (1.f / DM) + EPS);
        if (MODE == 1) {
#pragma unroll
            for (int j = 0; j < 4; ++j) { u32x2 w; w.x = cvtpk(v[j][0], v[j][1]); w.y = cvtpk(v[j][2], v[j][3]); *(u32x2*)(XA + (size_t)m * DM + 4 * lane + 256 * j) = w; }
        }
        if (MODE == 2) {
#pragma unroll
            for (int j = 0; j < 4; ++j) *(f32x4*)(OUT + (size_t)m * DM + 4 * lane + 256 * j) = v[j] * rstd * g4[j];
        } else {
#pragma unroll
            for (int j = 0; j < 4; ++j) { const f32x4 o = v[j] * rstd * g4[j]; u32x2 w; w.x = cvtpk(o[0], o[1]); w.y = cvtpk(o[2], o[3]); *(u32x2*)(XN + (size_t)m * DM + 4 * lane + 256 * j) = w; }
        }
    }
}

DI void st4(bf16* p, float a, float b, float c, float d) { u32x2 w; w.x = cvtpk(a, b); w.y = cvtpk(c, d); *(u32x2*)p = w; }
DI void mla_prep_unit(const bf16* Z, const bf16* WuqT, const bf16* WukvT, const float* cosT, const float* sinT, bf16* MLA, int unit, int lane) {
    const int slice = unit >> 1, part = unit & 1, r32 = lane & 31, hi = lane >> 5;
    const int row = slice * 32 + r32, t = row & (SEQ - 1);
    const bf16* zr = Z + (size_t)row * ZP; bf16* orow = MLA + (size_t)row * MLAP;
    const f32x4 cs = *(const f32x4*)(cosT + t * 8 + 4 * hi), sn = *(const f32x4*)(sinT + t * 8 + 4 * hi);
    const u32x4 zero4 = {0u, 0u, 0u, 0u};
    if (part == 0) {
        bf16x8 bq[16]; float ss = 0.f;
#pragma unroll
        for (int s = 0; s < 16; ++s) { bq[s] = *(const bf16x8*)(zr + Z_CQ + 16 * s + 8 * hi);
#pragma unroll
            for (int j = 0; j < 8; ++j) { const float f = bf2f((bf16)bq[s][j]); ss += f * f; } }
        const float rstd = rsqrtf(halfswap_sum(ss) * (1.f / 256.f) + EPS);
        auto epi_q = [&](const int nb, const f32x16& acc) __attribute__((always_inline)) {
            if (nb < 4) {
#pragma unroll
                for (int g = 0; g < 4; ++g) st4(orow + nb * 64 + 8 * g + 4 * hi, acc[4 * g] * rstd, acc[4 * g + 1] * rstd, acc[4 * g + 2] * rstd, acc[4 * g + 3] * rstd);
            } else {
#pragma unroll
                for (int hb = 0; hb < 2; ++hb) { const int head = 2 * (nb - 4) + hb; float o1[4], o2[4];
#pragma unroll
                    for (int j = 0; j < 4; ++j) { const float x1 = acc[8 * hb + j] * rstd, x2 = acc[8 * hb + 4 + j] * rstd; o1[j] = x1 * cs[j] - x2 * sn[j]; o2[j] = x1 * sn[j] + x2 * cs[j]; }
                    st4(orow + head * 64 + 32 + 4 * hi, o1[0], o1[1], o1[2], o1[3]); st4(orow + head * 64 + 40 + 4 * hi, o2[0], o2[1], o2[2], o2[3]);
                    *(u32x4*)(orow + head * 64 + 48 + 8 * hi) = zero4; }
            }
        };
        bf16x8 wA[16], wB[16];
#define MLA_WLOAD(W, nbx) do { const bf16* wp_ = WuqT + (size_t)((nbx) * 32 + r32) * 256 + 8 * hi; _Pragma("unroll") for (int s = 0; s < 16; ++s) W[s] = *(const bf16x8*)(wp_ + 16 * s); } while (0)
        MLA_WLOAD(wA, 0);
#pragma unroll 1
        for (int nb = 0; nb < 6; nb += 2) {
            MLA_WLOAD(wB, nb + 1);
            { f32x16 acc = {};
#pragma unroll
              for (int s = 0; s < 16; ++s) acc = MFMA32(wA[s], bq[s], acc);
              epi_q(nb, acc); }
            MLA_WLOAD(wA, nb + 2 < 6 ? nb + 2 : 5);
            { f32x16 acc = {};
#pragma unroll
              for (int s = 0; s < 16; ++s) acc = MFMA32(wB[s], bq[s], acc);
              epi_q(nb + 1, acc); }
        }
#undef MLA_WLOAD
    } else {
        bf16x8 bk[8]; float ss = 0.f;
#pragma unroll
        for (int s = 0; s < 8; ++s) { bk[s] = *(const bf16x8*)(zr + Z_CKV + 16 * s + 8 * hi);
#pragma unroll
            for (int j = 0; j < 8; ++j) { const float f = bf2f((bf16)bk[s][j]); ss += f * f; } }
        const float rstd = rsqrtf(halfswap_sum(ss) * (1.f / 128.f) + EPS);
        auto epi_kv = [&](const int nb, const f32x16& acc) __attribute__((always_inline)) {
            bf16* o = nb < 4 ? orow + 256 + nb * 64 : orow + 512 + ((nb - 4) >> 1) * 64 + ((nb - 4) & 1) * 32;
#pragma unroll
            for (int g = 0; g < 4; ++g) st4(o + 8 * g + 4 * hi, acc[4 * g] * rstd, acc[4 * g + 1] * rstd, acc[4 * g + 2] * rstd, acc[4 * g + 3] * rstd);
        };
        bf16x8 wA[8], wB[8];
#define MLA_WLOAD(W, nbx) do { const bf16* wp_ = WukvT + (size_t)((nbx) * 32 + r32) * 128 + 8 * hi; _Pragma("unroll") for (int s = 0; s < 8; ++s) W[s] = *(const bf16x8*)(wp_ + 16 * s); } while (0)
        MLA_WLOAD(wA, 0);
#pragma unroll 1
        for (int nb = 0; nb < 12; nb += 2) {
            MLA_WLOAD(wB, nb + 1);
            { f32x16 acc = {};
#pragma unroll
              for (int s = 0; s < 8; ++s) acc = MFMA32(wA[s], bk[s], acc);
              epi_kv(nb, acc); }
            MLA_WLOAD(wA, nb + 2 < 12 ? nb + 2 : 11);
            { f32x16 acc = {};
#pragma unroll
              for (int s = 0; s < 8; ++s) acc = MFMA32(wB[s], bk[s], acc);
              epi_kv(nb + 1, acc); }
        }
#undef MLA_WLOAD
        const u32x2 a = *(const u32x2*)(zr + Z_CKR + 4 * hi), b = *(const u32x2*)(zr + Z_CKR + 8 + 4 * hi);
        const float x1[4] = {__uint_as_float(a.x << 16), __uint_as_float(a.x & 0xffff0000u), __uint_as_float(a.y << 16), __uint_as_float(a.y & 0xffff0000u)};
        const float x2[4] = {__uint_as_float(b.x << 16), __uint_as_float(b.x & 0xffff0000u), __uint_as_float(b.y << 16), __uint_as_float(b.y & 0xffff0000u)};
        float o1[4], o2[4];
#pragma unroll
        for (int j = 0; j < 4; ++j) { o1[j] = x1[j] * cs[j] - x2[j] * sn[j]; o2[j] = x1[j] * sn[j] + x2[j] * cs[j]; }
#pragma unroll
        for (int h = 0; h < 4; ++h) { st4(orow + 256 + h * 64 + 32 + 4 * hi, o1[0], o1[1], o1[2], o1[3]); st4(orow + 256 + h * 64 + 40 + 4 * hi, o2[0], o2[1], o2[2], o2[3]);
            *(u32x4*)(orow + 256 + h * 64 + 48 + 8 * hi) = zero4; }
    }
}

DI int wave_sum_i(int v) {
    v += __builtin_amdgcn_update_dpp(0, v, 0x111, 0xf, 0xf, false); v += __builtin_amdgcn_update_dpp(0, v, 0x112, 0xf, 0xf, false);
    v += __builtin_amdgcn_update_dpp(0, v, 0x114, 0xf, 0xf, false); v += __builtin_amdgcn_update_dpp(0, v, 0x118, 0xf, 0xf, false);
    return __builtin_amdgcn_readlane(v, 15) + __builtin_amdgcn_readlane(v, 31) + __builtin_amdgcn_readlane(v, 47) + __builtin_amdgcn_readlane(v, 63);
}
DI float wave_max_f(float f) {
    const int ninf = (int)0xff800000u; int v = __float_as_int(f);
#define WMX(ctrl) v = __float_as_int(fmaxf(__int_as_float(v), __int_as_float(__builtin_amdgcn_update_dpp(ninf, v, ctrl, 0xf, 0xf, false))))
    WMX(0x111); WMX(0x112); WMX(0x114); WMX(0x118);
#undef WMX
    return fmaxf(fmaxf(__int_as_float(__builtin_amdgcn_readlane(v, 15)), __int_as_float(__builtin_amdgcn_readlane(v, 31))), fmaxf(__int_as_float(__builtin_amdgcn_readlane(v, 47)), __int_as_float(__builtin_amdgcn_readlane(v, 63))));
}
DI float relu_i(float x) { const int i = __float_as_int(x); return __int_as_float(i > 0 ? i : 0); }
DI unsigned fkey(float f) { const unsigned u = __float_as_uint(f); return (u & 0x80000000u) ? ~u : (u | 0x80000000u); }

struct DsaOps { bf16x8 af[2][2]; bf16x8 w8[2][2]; bf16x8 cb[2][2]; };
DI void dsa_load_ops(const bf16* Z, const bf16* KIDX, int item, int wave, int lane, DsaOps& o) {
    const int r32 = lane & 31, hi = lane >> 5;
    const int c = 63 - (item >> 6), rem = item & 63, b = rem >> 3, sg = rem & 7;
    const int n = 64 * (c + 1), t0 = 64 * c + 8 * sg; const size_t rowbase = (size_t)b * SEQ;
    const int ql = ((r32 >> 4) & 1) * 2 + ((r32 >> 2) & 1), hh = ((r32 >> 3) & 1) * 4 + (r32 & 3);
#pragma unroll
    for (int rb = 0; rb < 2; ++rb) {
#pragma unroll
        for (int s = 0; s < 2; ++s) o.af[rb][s] = *(const bf16x8*)(Z + (rowbase + t0 + 4 * rb + ql) * ZP + Z_IQ + hh * 32 + 16 * s + 8 * hi);
#pragma unroll
        for (int q2 = 0; q2 < 2; ++q2) o.w8[rb][q2] = *(const bf16x8*)(Z + (rowbase + t0 + 4 * rb + 2 * q2 + hi) * ZP + Z_IW);
    }
    const int nkb = n >> 5;
    const bf16* kp0 = KIDX + (rowbase + r32) * 32 + 8 * hi;
#pragma unroll
    for (int u = 0; u < 2; ++u) { const int k2 = wave + 8 * u; const int kk = k2 < nkb ? k2 : wave; const bf16* kp = kp0 + (size_t)(32 * kk) * 32; o.cb[u][0] = *(const bf16x8*)kp; o.cb[u][1] = *(const bf16x8*)(kp + 16); }
}
DI void dsa_select_item(const bf16* Z, const bf16* KIDX, unsigned long long* MASK, LAS unsigned char* lds, const DsaOps& ops, int item, int tid) {
    const int lane = tid & 63, wave = __builtin_amdgcn_readfirstlane(tid >> 6), r32 = lane & 31, hi = lane >> 5;
    const int c = 63 - (item >> 6), rem = item & 63, b = rem >> 3, sg = rem & 7;
    const int n = 64 * (c + 1), t0 = 64 * c + 8 * sg; const size_t rowbase = (size_t)b * SEQ;
    LAS float* sc = (LAS float*)lds;
    bf16x8 af[2][2]; float wv[2][16];
#pragma unroll
    for (int rb = 0; rb < 2; ++rb) {
#pragma unroll
        for (int s = 0; s < 2; ++s) af[rb][s] = ops.af[rb][s];
#pragma unroll
        for (int q2 = 0; q2 < 2; ++q2) {
#pragma unroll
            for (int j = 0; j < 8; ++j) wv[rb][8 * q2 + j] = bf2f((bf16)ops.w8[rb][q2][j]); }
    }
    {
        const int nkb = n >> 5;
        const bf16* kp0 = KIDX + (rowbase + r32) * 32 + 8 * hi;
        bf16x8 cb[2][2], nb[2][2];
#pragma unroll
        for (int u = 0; u < 2; ++u) { cb[u][0] = ops.cb[u][0]; cb[u][1] = ops.cb[u][1]; }
        for (int kb = wave; kb < nkb; kb += 2 * NWAVES) {
#pragma unroll
            for (int u = 0; u < 2; ++u) { const int k2 = kb + 16 + 8 * u; const int kk = k2 < nkb ? k2 : wave; const bf16* kp = kp0 + (size_t)(32 * kk) * 32; nb[u][0] = *(const bf16x8*)kp; nb[u][1] = *(const bf16x8*)(kp + 16); }
#pragma unroll
            for (int u = 0; u < 2; ++u) if (kb + 8 * u < nkb) {
                const int key = 32 * (kb + 8 * u) + r32;
#pragma unroll
                for (int rb = 0; rb < 2; ++rb) {
                    f32x16 acc = {};
                    acc = MFMA32(af[rb][0], cb[u][0], acc); acc = MFMA32(af[rb][1], cb[u][1], acc);
                    float s0 = 0.f, s1 = 0.f;
#pragma unroll
                    for (int r = 0; r < 8; ++r) { s0 = fmaf(wv[rb][r], relu_i(acc[r]), s0); s1 = fmaf(wv[rb][8 + r], relu_i(acc[8 + r]), s1); }
                    sc[(4 * rb + hi) * n + key] = s0; sc[(4 * rb + 2 + hi) * n + key] = s1;
                }
            }
#pragma unroll
            for (int u = 0; u < 2; ++u) { cb[u][0] = nb[u][0]; cb[u][1] = nb[u][1]; }
        }
    }
    __syncthreads();
    {
        const int nreg = c + 1, ngrp = (nreg + 7) >> 3;
        float v[64];
#pragma unroll
        for (int g = 0; g < 8; ++g) {
#pragma unroll
            for (int jj = 0; jj < 8; ++jj) v[8 * g + jj] = -INFINITY;
            if (g < ngrp) {
#pragma unroll
                for (int jj = 0; jj < 8; ++jj) { const int j = 8 * g + jj; if (j < nreg) v[j] = sc[wave * n + 64 * j + lane]; } } }
        float mxl = v[0], mnl = fminf(fminf(v[0], v[1]), fminf(v[2], v[3]));
#pragma unroll
        for (int g = 0; g < 8; ++g) if (g < ngrp) {
#pragma unroll
            for (int jj = 0; jj < 8; ++jj) mxl = fmaxf(mxl, v[8 * g + jj]);
            if (8 * g + 8 <= nreg) {
#pragma unroll
                for (int jj = 0; jj < 8; ++jj) mnl = fminf(mnl, v[8 * g + jj]); } }
        const float mx = wave_max_f(mxl), mn = -wave_max_f(-mnl);
        unsigned T = 0u; bool haveT = false; int c_hi = 0, neq = -1;
        if (mx > mn) {
            const float scale = 126.5f / (mx - mn);
            unsigned w[16];
#pragma unroll
            for (int q = 0; q < 16; ++q) { unsigned x = 0x80808080u;
                if (q < 2 * ngrp) {
#pragma unroll
                    for (int k = 0; k < 4; ++k) { const unsigned cc = (unsigned)((v[4 * q + k] - mn) * scale); x |= cc << (8 * k); } }
                w[q] = x; }
            unsigned p = 0u;
#pragma unroll
            for (int bit = 6; bit >= 0; --bit) { const unsigned cand = p | (1u << bit), rep = cand * 0x01010101u; int cl = 0;
#pragma unroll
                for (int g = 0; g < 8; ++g) if (g < ngrp) { cl += __builtin_popcount((w[2 * g] - rep) & 0x80808080u); cl += __builtin_popcount((w[2 * g + 1] - rep) & 0x80808080u); }
                const int cnt = wave_sum_i(cl);
                if (cnt >= 256) p = cand; else c_hi = cnt; }
            LAS unsigned* cand_l = (LAS unsigned*)(lds + AUX_OFF + wave * 512);
            int off = 0;
#pragma unroll
            for (int g = 0; g < 8; ++g) if (g < ngrp) {
#pragma unroll
                for (int jj = 0; jj < 8; ++jj) { const int j = 8 * g + jj; const bool isc = ((w[j >> 2] >> (8 * (j & 3))) & 0xffu) == (p | 0x80u); const unsigned long long bal = __builtin_amdgcn_ballot_w64(isc);
                    if (bal) { const int pos = off + (int)__builtin_amdgcn_mbcnt_hi((unsigned)(bal >> 32), __builtin_amdgcn_mbcnt_lo((unsigned)bal, 0u));
                        if (isc && pos < 128) cand_l[pos] = fkey(v[j]);
                        off += __builtin_popcountll(bal); } } }
            const int need = 256 - c_hi;
            if (off <= 128) {
                const unsigned ck0 = lane < off ? cand_l[lane] : 0u, ck1 = lane + 64 < off ? cand_l[lane + 64] : 0u;
                unsigned prefix = 0u;
                for (int bit = 31; bit >= 0; --bit) { const unsigned cd = prefix | (1u << bit);
                    const int cnt = __builtin_popcountll(__builtin_amdgcn_ballot_w64(ck0 >= cd)) + __builtin_popcountll(__builtin_amdgcn_ballot_w64(ck1 >= cd));
                    if (cnt >= need) prefix = cd; }
                T = prefix; haveT = true;
                c_hi += __builtin_popcountll(__builtin_amdgcn_ballot_w64(ck0 > T)) + __builtin_popcountll(__builtin_amdgcn_ballot_w64(ck1 > T));
                neq = __builtin_popcountll(__builtin_amdgcn_ballot_w64(ck0 == T)) + __builtin_popcountll(__builtin_amdgcn_ballot_w64(ck1 == T));
            }
        }
        if (!haveT) {
            unsigned prefix = 0u;
            for (int bit = 31; bit >= 0; --bit) { const unsigned cd = prefix | (1u << bit); int cnt = 0;
#pragma unroll
                for (int g = 0; g < 8; ++g) if (g < ngrp) {
#pragma unroll
                    for (int jj = 0; jj < 8; ++jj) cnt += __builtin_popcountll(__builtin_amdgcn_ballot_w64(fkey(v[8 * g + jj]) >= cd)); }
                if (cnt >= 256) prefix = cd; }
            T = prefix; c_hi = 0;
#pragma unroll
            for (int g = 0; g < 8; ++g) if (g < ngrp) {
#pragma unroll
                for (int jj = 0; jj < 8; ++jj) c_hi += __builtin_popcountll(__builtin_amdgcn_ballot_w64(fkey(v[8 * g + jj]) > T)); }
        }
        int remn = 256 - c_hi; unsigned mlo = 0u, mhi = 0u;
        if (neq == remn) {
            const float Tf = __uint_as_float((T & 0x80000000u) ? (T & 0x7fffffffu) : ~T);
#pragma unroll
            for (int g = 0; g < 8; ++g) if (g < ngrp) {
#pragma unroll
                for (int jj = 0; jj < 8; ++jj) { const int j = 8 * g + jj; const unsigned long long ww = __builtin_amdgcn_ballot_w64(v[j] >= Tf); const unsigned wl = (unsigned)ww, wh2 = (unsigned)(ww >> 32);
                    asm volatile("s_nop 4\n\tv_writelane_b32 %0, %1, %2" : "+v"(mlo) : "s"(wl), "n"(j));
                    asm volatile("v_writelane_b32 %0, %1, %2" : "+v"(mhi) : "s"(wh2), "n"(j)); } }
        } else {
#pragma unroll
            for (int g = 0; g < 8; ++g) if (g < ngrp) {
#pragma unroll
                for (int jj = 0; jj < 8; ++jj) { const int j = 8 * g + jj;
                    const unsigned kj = fkey(v[j]);
                    const unsigned long long gt = __builtin_amdgcn_ballot_w64(kj > T); unsigned long long eq = __builtin_amdgcn_ballot_w64(kj == T);
                    if (eq) { const int ne = __builtin_popcountll(eq);
                        if (ne > remn) { unsigned long long tk = 0ull; for (int i = 0; i < remn; ++i) { const unsigned long long lb = eq & (0ull - eq); tk |= lb; eq ^= lb; } eq = tk; remn = 0; }
                        else remn -= ne; }
                    const unsigned long long ww = gt | eq; const unsigned wl = (unsigned)ww, wh2 = (unsigned)(ww >> 32);
                    asm volatile("s_nop 4\n\tv_writelane_b32 %0, %1, %2" : "+v"(mlo) : "s"(wl), "n"(j));
                    asm volatile("v_writelane_b32 %0, %1, %2" : "+v"(mhi) : "s"(wh2), "n"(j)); } }
        }
        if (lane < nreg) MASK[(rowbase + t0 + wave) * 64 + lane] = ((unsigned long long)mhi << 32) | mlo;
    }
    __syncthreads();
}

DI s16x4 vtr(const LAS unsigned char* p) { return __builtin_bit_cast(s16x4, __builtin_amdgcn_ds_read_tr16_b64_v4i16((LAS v4i16_t*)p)); }

template <int DV, bool BIAS, bool MASK, int KS = 4  >
DI void attn_pass(LAS unsigned char* lds, const bf16* Q, const bf16* K, const bf16* V, int pq, int pk, int pv, int q0, int nt, const unsigned long long* maskb, float cfar, f32x16 (&oT)[DV / 32], int tid) {
    constexpr int ND = DV / 32, NV = DV / 64;
    asm volatile("" : "+v"(tid));
    const int lane = tid & 63, wave = __builtin_amdgcn_readfirstlane(tid >> 6), r32 = lane & 31, hi = lane >> 5;
    const int qw0 = q0 + 32 * wave, mylimit = (qw0 >> 6) + 1;
    const LAS float* lut = (const LAS float*)(lds + AUX_OFF);
    float m_ref = -64.f;
    constexpr bool LMF = (DV == 64);
    f32x16 lacc = {}; float l_run = 0.f;
    const short one_hi0 = hi == 0 ? (short)0x3F80 : (short)0;
    const bf16x8 kx = {one_hi0, one_hi0, one_hi0, 0, 0, 0, 0, 0};
    bf16x8 qx;
#define SET_QX() do { const float c_ = cfar - m_ref; const unsigned b1_ = cvtpk(c_, 0.f) & 0xffffu; const float r1_ = c_ - __uint_as_float(b1_ << 16); const unsigned b2_ = cvtpk(r1_, 0.f) & 0xffffu; \
        const float r2_ = r1_ - __uint_as_float(b2_ << 16); const unsigned b3_ = cvtpk(r2_, 0.f) & 0xffffu; \
        qx = (bf16x8){(short)(hi == 0 ? b1_ : 0u), (short)(hi == 0 ? b2_ : 0u), (short)(hi == 0 ? b3_ : 0u), 0, 0, 0, 0, 0}; } while (0)
    SET_QX();
    const bf16x8 ones = {0x3F80, 0x3F80, 0x3F80, 0x3F80, 0x3F80, 0x3F80, 0x3F80, 0x3F80};
#pragma unroll
    for (int d = 0; d < ND; ++d) oT[d] = (f32x16){};
    bf16x8 qf[4];
#pragma unroll
    for (int d0 = 0; d0 < 4; ++d0) qf[d0] = *(const bf16x8*)(Q + (size_t)(qw0 + r32) * pq + 16 * d0 + 8 * hi);
    LAS bf16x8* qpark = (LAS bf16x8*)(lds + 49152 + wave * 4096) + lane;
    if constexpr (ND == 4) {
#pragma unroll
        for (int d0 = 0; d0 < 4; ++d0) qpark[d0 * 64] = qf[d0];
    }
    const bf16* ksrc = K + (size_t)lane * pk + wave * 8;
    const bf16* vsrc[NV];
#pragma unroll
    for (int i = 0; i < NV; ++i) { const int p = wave + 8 * i, dh = p >> 2, rg = p & 3; vsrc[i] = V + (size_t)(rg * 16 + (lane >> 2)) * pv + dh * 32 + (lane & 3) * 8; }
    LAS unsigned char* kdst = lds + wave * 1024 + lane * 16;
    LAS unsigned char* vdst = lds + 16384 + wave * 1024 + lane * 16;
    const LAS unsigned char* kfr = lds + hi * 1024 + r32 * 16;
    const LAS unsigned char* vfr = lds + 16384 + ((lane >> 4) & 1) * 32 + (lane & 3) * 8 + (4 * hi + ((lane & 15) >> 2)) * 64;
    u32x4 kA, vA[NV], kB, vB[NV];
#define AT_LOAD(t, KR, VR) do { KR = *(const u32x4*)(ksrc + (size_t)(t) * 64 * pk); _Pragma("unroll") for (int i = 0; i < NV; ++i) VR[i] = *(const u32x4*)(vsrc[i] + (size_t)(t) * 64 * pv); } while (0)
#define AT_STORE(buf, KR, VR) do { *(LAS u32x4*)(kdst + (buf) * 8192) = KR; _Pragma("unroll") for (int i = 0; i < NV; ++i) *(LAS u32x4*)(vdst + (buf) * 16384 + i * 8192) = VR[i]; } while (0)
    AT_LOAD(0, kA, vA); AT_LOAD(1, kB, vB);
    AT_STORE(0, kA, vA);
    __syncthreads();
#define SB() __builtin_amdgcn_sched_barrier(0)
#define VFRAG(SET, d) do { _Pragma("unroll") for (int ks = 0; ks < 4; ++ks) { SET[2 * ks] = vtr(vb + (d) * 4096 + ks * 1024); SET[2 * ks + 1] = vtr(vb + (d) * 4096 + ks * 1024 + 512); } } while (0)
#define VMMA(SET, d) do { _Pragma("unroll") for (int ks = 0; ks < 4; ++ks) { const bf16x8 vf = {SET[2 * ks][0], SET[2 * ks][1], SET[2 * ks][2], SET[2 * ks][3], SET[2 * ks + 1][0], SET[2 * ks + 1][1], SET[2 * ks + 1][2], SET[2 * ks + 1][3]}; \
        oT[d] = MFMA32(vf, __builtin_bit_cast(bf16x8, pw[ks]), oT[d]); } } while (0)
    auto compute = [&](const int kt, const int cur) __attribute__((always_inline)) {
        if (kt < mylimit) {
            unsigned long long mw = 0ull;
            if (MASK) mw = maskb[(size_t)(qw0 + r32) * 64 + kt];
            const int relb = kt * 64 - qw0;
            const bool nearb = BIAS && (relb + 63 > -91);
            f32x16 p0, p1;
            const LAS unsigned char* kb = kfr + cur * 8192;
            const LAS unsigned char* vb = vfr + cur * 16384;
            if constexpr (ND == 2) {
                bf16x8 kf[8];
#pragma unroll
                for (int d0 = 0; d0 < KS; ++d0) { kf[2 * d0] = *(const LAS bf16x8*)(kb + d0 * 2048); kf[2 * d0 + 1] = *(const LAS bf16x8*)(kb + d0 * 2048 + 512); }
                SB();
                p0 = MFMA32(kx, qx, (f32x16){}); p1 = MFMA32(kx, qx, (f32x16){});
#pragma unroll
                for (int d0 = 0; d0 < KS; ++d0) { p0 = MFMA32(kf[2 * d0], qf[d0], p0); p1 = MFMA32(kf[2 * d0 + 1], qf[d0], p1); }
            } else {
                bf16x8 kf[4], qh[2];
#pragma unroll
                for (int d0 = 0; d0 < 2; ++d0) { kf[2 * d0] = *(const LAS bf16x8*)(kb + d0 * 2048); kf[2 * d0 + 1] = *(const LAS bf16x8*)(kb + d0 * 2048 + 512); qh[d0] = qpark[d0 * 64]; }
                SB();
                p0 = MFMA32(kx, qx, (f32x16){}); p1 = MFMA32(kx, qx, (f32x16){});
                p0 = MFMA32(kf[0], qh[0], p0); p1 = MFMA32(kf[1], qh[0], p1); p0 = MFMA32(kf[2], qh[1], p0); p1 = MFMA32(kf[3], qh[1], p1);
                SB();
#pragma unroll
                for (int d0 = 0; d0 < 2; ++d0) { kf[2 * d0] = *(const LAS bf16x8*)(kb + (d0 + 2) * 2048); kf[2 * d0 + 1] = *(const LAS bf16x8*)(kb + (d0 + 2) * 2048 + 512); qh[d0] = qpark[(d0 + 2) * 64]; }
                SB();
                p0 = MFMA32(kf[0], qh[0], p0); p1 = MFMA32(kf[1], qh[0], p1); p0 = MFMA32(kf[2], qh[1], p0); p1 = MFMA32(kf[3], qh[1], p1);
            }
            SB();
            s16x4 vs0[8], vs1[8];
            VFRAG(vs0, 0); if constexpr (ND == 2) VFRAG(vs1, 1);
            SB();
            if (BIAS) { if (nearb) { const LAS float* lb = lut + (relb + 192 - r32 + 4 * hi);
#pragma unroll
                for (int r = 0; r < 16; ++r) { const int cc = (r & 3) + 8 * (r >> 2); p0[r] += lb[cc]; p1[r] += lb[cc + 32]; } } }
#pragma unroll
            for (int r = 0; r < 16; ++r) { p0[r] = __builtin_amdgcn_exp2f(p0[r]); p1[r] = __builtin_amdgcn_exp2f(p1[r]); }
            if (MASK) { const unsigned mlo = (unsigned)mw >> (4 * hi), mhi = (unsigned)(mw >> 32) >> (4 * hi);
#pragma unroll
                for (int r = 0; r < 16; ++r) { const int cc = (r & 3) + 8 * (r >> 2);
                    p0[r] = __int_as_float(__float_as_int(p0[r]) & ((int)(mlo << (31 - cc)) >> 31)); p1[r] = __int_as_float(__float_as_int(p1[r]) & ((int)(mhi << (31 - cc)) >> 31)); } }
            float em = fmaxf(p0[0], p1[0]);
#pragma unroll
            for (int r = 1; r < 16; ++r) em = fmaxf(em, fmaxf(p0[r], p1[r]));
            em = halfswap_max(em);
            if (__any(em > 256.f)) {
                const float dl = fmaxf(__builtin_amdgcn_logf(em), 0.f), alpha = __builtin_amdgcn_exp2f(-dl); m_ref += dl; SET_QX();
#pragma unroll
                for (int r = 0; r < 16; ++r) { p0[r] *= alpha; p1[r] *= alpha; if (LMF) lacc[r] *= alpha; }
                l_run *= alpha;
#pragma unroll
                for (int d = 0; d < ND; ++d)
#pragma unroll
                    for (int r = 0; r < 16; ++r) oT[d][r] *= alpha; }
            if (!LMF) {
#pragma unroll
                for (int r = 0; r < 16; ++r) l_run += p0[r] + p1[r]; }
            u32x4 pw[4];
#pragma unroll
            for (int s = 0; s < 2; ++s) { pw[s] = (u32x4){cvtpk(p0[8 * s], p0[8 * s + 1]), cvtpk(p0[8 * s + 2], p0[8 * s + 3]), cvtpk(p0[8 * s + 4], p0[8 * s + 5]), cvtpk(p0[8 * s + 6], p0[8 * s + 7])};
                pw[2 + s] = (u32x4){cvtpk(p1[8 * s], p1[8 * s + 1]), cvtpk(p1[8 * s + 2], p1[8 * s + 3]), cvtpk(p1[8 * s + 4], p1[8 * s + 5]), cvtpk(p1[8 * s + 6], p1[8 * s + 7])}; }
            SB();
            if constexpr (ND == 2) {
                VMMA(vs0, 0); VMMA(vs1, 1);
#pragma unroll
                for (int ks = 0; ks < 4; ++ks) if (LMF) lacc = MFMA32(ones, __builtin_bit_cast(bf16x8, pw[ks]), lacc);
            } else {
                VFRAG(vs1, 1); SB();
                VMMA(vs0, 0); SB();
                VFRAG(vs0, 2); SB();
                VMMA(vs1, 1); SB();
                VFRAG(vs1, 3); SB();
                VMMA(vs0, 2); SB();
                VMMA(vs1, 3);
            }
            SB();
        }
    };
    for (int kt = 0; kt < nt; kt += 2) {
        { const int t2 = kt + 2 < nt ? kt + 2 : nt - 1; AT_LOAD(t2, kA, vA); }
        compute(kt, 0);
        AT_STORE(1, kB, vB);
        __syncthreads();
        { const int t3 = kt + 3 < nt ? kt + 3 : nt - 1; AT_LOAD(t3, kB, vB); }
        compute(kt + 1, 1);
        AT_STORE(0, kA, vA);
        __syncthreads();
    }
#undef SET_QX
#undef AT_LOAD
#undef AT_STORE
#undef SB
#undef VFRAG
#undef VMMA
    const float inv = 1.f / (LMF ? lacc[0] : halfswap_sum(l_run));
#pragma unroll
    for (int d = 0; d < ND; ++d)
#pragma unroll
        for (int r = 0; r < 16; ++r) oT[d][r] *= inv;
}

#define H64_SBAR() __builtin_amdgcn_sched_barrier(0)
DI void glds16s(const void* base, unsigned voff, unsigned lds_base) {
    unsigned sv; asm volatile("s_mov_b32 %0, m0\n\ts_mov_b32 m0, %3\n\ts_nop 0\n\tglobal_load_lds_dwordx4 %1, %2\n\ts_mov_b32 m0, %0" : "=&s"(sv) : "v"(voff), "s"(base), "s"(lds_base) : "memory"); }
DI const bf16* uniform_ptr(const bf16* p) { const unsigned long long v = (unsigned long long)p; const unsigned lo = (unsigned)__builtin_amdgcn_readfirstlane((int)(unsigned)v), hi2 = (unsigned)__builtin_amdgcn_readfirstlane((int)(unsigned)(v >> 32));
    return (const bf16*)(((unsigned long long)hi2 << 32) | lo); }
DI void glds4s(const void* base, unsigned voff, unsigned lds_base) {
    unsigned sv; asm volatile("s_mov_b32 %0, m0\n\ts_mov_b32 m0, %3\n\ts_nop 0\n\tglobal_load_lds_dword %1, %2\n\ts_mov_b32 m0, %0" : "=&s"(sv) : "v"(voff), "s"(base), "s"(lds_base) : "memory"); }
DI void gld64s(unsigned long long& dst, const void* base, unsigned voff) { asm volatile("global_load_dwordx2 %0, %1, %2" : "=&v"(dst) : "v"(voff), "s"(base) : "memory"); }
#define H64_PIN(x) asm volatile("" : "+v"(x))
struct DynNext {
    gu32* qctr; volatile LAS int* slot2; const LAS unsigned* ordl; const bf16* Z; const bf16* MLA; int tid, qrow, hi;
    int popv, uqn; bool valid; const bf16* Kn; const bf16* qnl; int pkn;
    DI void pop() { if (tid == 0) popv = (int)__hip_atomic_fetch_add(qctr, 1u, RLX_AGENT); }
    DI void publish() { if (tid == 0) *slot2 = popv; }
    DI void decode() {
        uqn = __builtin_amdgcn_readfirstlane(*slot2);
        valid = __builtin_amdgcn_readfirstlane((uqn < 2304 && (uqn % 3) != 2) ? 1 : 0) != 0;
        Kn = Z; qnl = Z; pkn = ZP;
        if (valid) {
            const int u = (uqn / 3) * 2 + (uqn % 3);
            const unsigned ue = (unsigned)__builtin_amdgcn_readfirstlane((int)ordl[u]);
            const int type = (int)(ue >> 16), qb = (int)((ue >> 8) & 0xffu), bh = (int)(ue & 0xffu), b = bh >> 2, h = bh & 3;
            const size_t rb = (size_t)b * SEQ, qr = rb + (size_t)(qb * 256 + qrow);
            if (type == 0)      { Kn = Z + rb * ZP + Z_AK + (h * 2) * 64; qnl = Z + qr * ZP + Z_AQ + (h * 2) * 64 + 8 * hi; pkn = ZP; }
            else if (type == 1) { Kn = Z + rb * ZP + Z_BK + h * 64;       qnl = Z + qr * ZP + Z_BQ + h * 64 + 8 * hi;       pkn = ZP; }
            else                { Kn = MLA + rb * MLAP + 256 + h * 64;    qnl = MLA + qr * MLAP + h * 64 + 8 * hi;          pkn = MLAP; }
        }
    }
};

template <bool BIAS, bool MASK, int KS>
DI void attn_pass_h64(LAS unsigned char* lds, const bf16* Q, const bf16* K, const bf16* V, int pq, int pk, int pv, int q0, int nt, const unsigned long long* maskb, float cfar, f32x16 (&oT)[2], int tid, const LAS float* lut, int pre, int& s0, bf16x8 (&qf)[4], DynNext& nx) {
    asm volatile("" : "+v"(tid));
    const int lane = tid & 63, wave = __builtin_amdgcn_readfirstlane(tid >> 6), r32 = lane & 31, hi = lane >> 5;
    const int qw0 = q0 + 32 * wave, mylimit = (qw0 >> 6) + 1, NT = nt;
    constexpr int SLOTB = 8192, LDS_V = 3 * SLOTB;
    const unsigned koff = (unsigned)(lane * pk + wave * 8) * 2u, voff = (unsigned)((16 * (wave & 3) + (lane >> 2)) * pv + (wave >> 2) * 32 + (lane & 3) * 8) * 2u;
    const unsigned kdst_u = (unsigned)(unsigned long)(lds + wave * 1024), vdst_u = (unsigned)(unsigned long)(lds + LDS_V + wave * 1024);
#define DMA_K(t, slot) glds16s(K + (size_t)(t) * 64 * pk, koff, (unsigned)__builtin_amdgcn_readfirstlane((int)(kdst_u + (unsigned)(slot))))
#define DMA_KN(t, slot) glds16s(uniform_ptr(nx.Kn + (size_t)(t) * 64 * nx.pkn), koffn, (unsigned)__builtin_amdgcn_readfirstlane((int)(kdst_u + (unsigned)(slot))))
#define DMA_V(t, slot) glds16s(V + (size_t)(t) * 64 * pv, voff, (unsigned)__builtin_amdgcn_readfirstlane((int)(vdst_u + (unsigned)(slot))))
#define WAIT_BAR(N) asm volatile("s_waitcnt vmcnt(" #N ") lgkmcnt(0)\n\ts_barrier" ::: "memory")
    const LAS unsigned char* vp0 = lds + LDS_V + ((lane >> 4) & 1) * 32 + (lane & 3) * 8 + (4 * hi + ((lane & 15) >> 2)) * 64;
    const LAS unsigned char* kp0 = lds + hi * 1024 + r32 * 16;
    const unsigned moff = (unsigned)(qw0 + r32) * 512u + 4u * (unsigned)hi;
    const unsigned mdst_u = (unsigned)(unsigned long)(lds + 49152 + wave * 512);
    const LAS unsigned* mrd = (const LAS unsigned*)(lds + 49152 + wave * 512) + r32;
#define DMA_M(t) glds4s(maskb + (t), moff, (unsigned)__builtin_amdgcn_readfirstlane((int)(mdst_u + 256u * ((unsigned)(t) & 1u))))
#define MREAD(t) do { const LAS unsigned* p_ = mrd + 64 * ((t) & 1); mwc = (unsigned long long)p_[0] | ((unsigned long long)p_[32] << 32); } while (0)
    unsigned long long mwc = ~0ull;
#define NXS(x) ((x) == 2 * SLOTB ? 0 : (x) + SLOTB)
    const int b0 = pre ? s0 : 0, b1 = NXS(b0), b2 = NXS(b1);
    if (!pre) { DMA_K(0, b0); DMA_V(0, b0); DMA_K(1, b1); } else DMA_V(0, b0);
    if (MASK) DMA_M(0);
    if (!pre) {
#pragma unroll
        for (int d0 = 0; d0 < KS; ++d0) qf[d0] = *(const bf16x8*)(Q + (size_t)(qw0 + r32) * pq + 16 * d0 + 8 * hi);
    }
    float m_ref = 0.f, l_reg = 0.f, fsc = 1.f; bool resc = false;
    const short one_hi0 = hi == 0 ? (short)0x3F80 : (short)0;
    const bf16x8 kx = {one_hi0, one_hi0, one_hi0, 0, 0, 0, 0, 0};
    bf16x8 qx;
#define SET_QX() do { const float c_ = cfar - m_ref; const unsigned b1_ = cvtpk(c_, 0.f) & 0xffffu; const float r1_ = c_ - __uint_as_float(b1_ << 16); const unsigned b2_ = cvtpk(r1_, 0.f) & 0xffffu; \
        const float r2_ = r1_ - __uint_as_float(b2_ << 16); const unsigned b3_ = cvtpk(r2_, 0.f) & 0xffffu; \
        qx = (bf16x8){(short)(hi == 0 ? b1_ : 0u), (short)(hi == 0 ? b2_ : 0u), (short)(hi == 0 ? b3_ : 0u), 0, 0, 0, 0, 0}; } while (0)
    SET_QX();
    oT[0] = (f32x16){}; oT[1] = (f32x16){};
    f32x16 pA0, pA1, pB0, pB1; bf16x8 kf[8]; s16x4 vlo[4], vhi[4]; u32x4 pw0, pw1, pw2, pw3;
    int sl_prev = b0, sl_cur = b0, sl_next = b1;
#define ROT() do { sl_prev = sl_cur; sl_cur = sl_next; sl_next = (sl_next == 2 * SLOTB) ? 0 : sl_next + SLOTB; } while (0)
#define KLOAD2(kp, d0) do { kf[2 * (d0)] = *(const LAS bf16x8*)((kp) + (d0) * 2048); kf[2 * (d0) + 1] = *(const LAS bf16x8*)((kp) + (d0) * 2048 + 512); } while (0)
#define MX3(a, b, c) fmaxf(fmaxf((a), (b)), (c))
#define ROWMAX(p0, p1, out) do { float a_ = MX3(p0[0], p0[1], p1[0]), b_ = MX3(p0[2], p0[3], p1[1]); a_ = MX3(a_, p1[2], p1[3]); \
        _Pragma("unroll") for (int r = 4; r < 16; r += 4) { a_ = MX3(a_, p0[r], p0[r + 1]); b_ = MX3(b_, p0[r + 2], p0[r + 3]); a_ = MX3(a_, p1[r], p1[r + 1]); b_ = MX3(b_, p1[r + 2], p1[r + 3]); } \
        out = halfswap_max(fmaxf(a_, b_)); } while (0)
#define MBIT(mw_, cc) __builtin_amdgcn_sbfe((int)(mw_), (cc), 1)
#define CROW(r) (((r) & 3) + 8 * ((r) >> 2))
#define EXM(X, i, mw_) do { X[i] = __builtin_amdgcn_exp2f(X[i]); if (MASK) X[i] = __int_as_float(__float_as_int(X[i]) & MBIT(mw_, CROW(i))); } while (0)
#define BIASADD(C0, C1, t) do { if (BIAS) { const int relb = (t) * 64 - qw0; if (relb + 63 > -91) { const LAS float* lb = lut + (relb + 192 - r32 + 4 * hi); \
        _Pragma("unroll") for (int r = 0; r < 16; ++r) { C0[r] += lb[CROW(r)]; C1[r] += lb[CROW(r) + 32]; } } } } while (0)
    if (!pre) { DMA_K(2, b2); asm volatile("s_waitcnt vmcnt(3)" ::: "memory"); }
    else if (MASK) { asm volatile("s_waitcnt vmcnt(0)" ::: "memory"); }
    else { asm volatile("s_waitcnt vmcnt(9)" ::: "memory"); }
    asm volatile("s_waitcnt lgkmcnt(0)\n\ts_barrier" ::: "memory");
    if (MASK) MREAD(0);
#pragma unroll
    for (int d0 = 0; d0 < KS; ++d0) KLOAD2(kp0 + b0, d0);
    pA0 = MFMA32(kx, qx, (f32x16){}); pA1 = MFMA32(kx, qx, (f32x16){});
#pragma unroll
    for (int d0 = 0; d0 < KS; ++d0) { pA0 = MFMA32(kf[2 * d0], qf[d0], pA0); pA1 = MFMA32(kf[2 * d0 + 1], qf[d0], pA1); }
    BIASADD(pA0, pA1, 0);
    { float rm; ROWMAX(pA0, pA1, rm); m_ref = rm;
      const unsigned mlo0 = (unsigned)mwc >> (4 * hi), mhi0 = (unsigned)(mwc >> 32) >> (4 * hi);
#pragma unroll
      for (int r = 0; r < 16; ++r) { pA0[r] -= rm; pA1[r] -= rm; EXM(pA0, r, mlo0); EXM(pA1, r, mhi0); } }
    SET_QX();
    if (MASK) DMA_M(1);
    WAIT_BAR(0);
    DMA_K(3, b0); DMA_V(1, b1); ROT();
#pragma unroll
    for (int d0 = 0; d0 < KS; ++d0) KLOAD2(kp0 + sl_cur, d0);
    WAIT_BAR(2);
#define PKW(P, i) cvtpk(P[i], P[i + 1])
#define PAF(k) __builtin_bit_cast(bf16x8, pw##k)
#define VFR(j) (bf16x8){vlo[(j) & 3][0], vlo[(j) & 3][1], vlo[(j) & 3][2], vlo[(j) & 3][3], vhi[(j) & 3][0], vhi[(j) & 3][1], vhi[(j) & 3][2], vhi[(j) & 3][3]}
#define VRD(j) do { vlo[(j) & 3] = vtr(vp_ + (((j) & 1) * 4096 + ((j) >> 1) * 1024)); vhi[(j) & 3] = vtr(vp_ + (((j) & 1) * 4096 + ((j) >> 1) * 1024 + 512)); } while (0)
#define KRD(G, d0) do { if ((G) && (d0) < KS) { KLOAD2(kp0 + sl_next, d0); H64_SBAR(); } } while (0)
#define GAPA(MF, a0, a1, a2, a3, W0, W1, PW) do { MF; sacc += a0; sacc += a1; sacc += a2; sacc += a3; W0; W1; H64_PIN(PW); H64_PIN(sacc); H64_SBAR(); } while (0)
#define GAPB(MF, X, i, mw_) do { MF; EXM(X, i, mw_); EXM(X, (i) + 1, mw_); EXM(X, (i) + 2, mw_); EXM(X, (i) + 3, mw_); H64_PIN(X); H64_SBAR(); } while (0)
#define QKA(C0, C1, g) (KS == 4 ? ((g) & 1 ? (C1 = MFMA32(kf[g], qf[(g) >> 1], C1)) : (C0 = MFMA32(kf[g], qf[(g) >> 1], C0))) \
                                : ((g) < 2 ? ((g) & 1 ? (C1 = MFMA32(kx, qx, (f32x16){})) : (C0 = MFMA32(kx, qx, (f32x16){}))) \
                                           : ((g) & 1 ? (C1 = MFMA32(kf[(g) - 2], qf[((g) - 2) >> 1], C1)) : (C0 = MFMA32(kf[(g) - 2], qf[((g) - 2) >> 1], C0)))))
#define STEP(C0, C1, P0, P1, t, BAND, GK, GV, GL, GQ) do { H64_SBAR(); \
    if (MASK) { MREAD(t); if (GV) DMA_M((t) + 1); } \
    const LAS unsigned char* vp_ = vp0 + sl_prev; \
    if (KS == 4) { C0 = MFMA32(kx, qx, (f32x16){}); C1 = MFMA32(kx, qx, (f32x16){}); H64_SBAR(); } \
    VRD(0); H64_SBAR(); float sacc = P0[0] + P0[1]; \
                        GAPA(QKA(C0, C1, 0), P0[2], P0[3], P0[4], P0[5],     pw0[0] = PKW(P0, 0),  pw0[1] = PKW(P0, 2),  pw0); \
    VRD(1); H64_SBAR(); GAPA(QKA(C0, C1, 1), P0[6], P0[7], P0[8], P0[9],     pw0[2] = PKW(P0, 4),  pw0[3] = PKW(P0, 6),  pw0); \
    VRD(2); H64_SBAR(); GAPA(QKA(C0, C1, 2), P0[10], P0[11], P0[12], P0[13], pw1[0] = PKW(P0, 8),  pw1[1] = PKW(P0, 10), pw1); \
    VRD(3); H64_SBAR(); GAPA(QKA(C0, C1, 3), P0[14], P0[15], P1[0], P1[1],   pw1[2] = PKW(P0, 12), pw1[3] = PKW(P0, 14), pw1); \
                        GAPA(QKA(C0, C1, 4), P1[2], P1[3], P1[4], P1[5],     pw2[0] = PKW(P1, 0),  pw2[1] = PKW(P1, 2),  pw2); \
                        GAPA(QKA(C0, C1, 5), P1[6], P1[7], P1[8], P1[9],     pw2[2] = PKW(P1, 4),  pw2[3] = PKW(P1, 6),  pw2); \
                        GAPA(QKA(C0, C1, 6), P1[10], P1[11], P1[12], P1[13], pw3[0] = PKW(P1, 8),  pw3[1] = PKW(P1, 10), pw3); \
                        GAPA(QKA(C0, C1, 7), P1[14], P1[15], 0.f, 0.f,       pw3[2] = PKW(P1, 12), pw3[3] = PKW(P1, 14), pw3); \
    l_reg += sacc; \
    if (GK) DMA_K((t) + 3, sl_cur); if (GV) DMA_V((t) + 1, sl_next); \
    if (GQ) { if (nx.valid) { _Pragma("unroll") for (int d0 = 0; d0 < 4; ++d0) qf[d0] = *(const bf16x8*)(nx.qnl + 16 * d0); } } \
    if (BAND) { if ((t) >= mylimit) { _Pragma("unroll") for (int r = 0; r < 16; ++r) { C0[r] = -INFINITY; C1[r] = -INFINITY; } } } \
    BIASADD(C0, C1, t); \
    { float rm; ROWMAX(C0, C1, rm); resc = false; \
      if (__builtin_expect(__any(rm > 8.f), 0)) { const float dl = fmaxf(rm, 0.f); m_ref += dl; fsc = __builtin_amdgcn_exp2f(-dl); l_reg *= fsc; resc = true; SET_QX(); \
          _Pragma("unroll") for (int r = 0; r < 16; ++r) { C0[r] -= dl; C1[r] -= dl; } } } \
    const unsigned mlo_ = (unsigned)mwc >> (4 * hi), mhi_ = (unsigned)(mwc >> 32) >> (4 * hi); H64_SBAR(); \
    GAPB(oT[0] = MFMA32(VFR(0), PAF(0), oT[0]), C0, 0, mlo_);  VRD(4); H64_SBAR(); GAPB(oT[1] = MFMA32(VFR(1), PAF(0), oT[1]), C0, 4, mlo_);  VRD(5); H64_SBAR(); \
    KRD(GL, 0); GAPB(oT[0] = MFMA32(VFR(2), PAF(1), oT[0]), C0, 8, mlo_);  VRD(6); H64_SBAR(); KRD(GL, 1); GAPB(oT[1] = MFMA32(VFR(3), PAF(1), oT[1]), C0, 12, mlo_); VRD(7); H64_SBAR(); \
    KRD(GL, 2); GAPB(oT[0] = MFMA32(VFR(4), PAF(2), oT[0]), C1, 0, mhi_);  KRD(GL, 3); GAPB(oT[1] = MFMA32(VFR(5), PAF(2), oT[1]), C1, 4, mhi_); \
    GAPB(oT[0] = MFMA32(VFR(6), PAF(3), oT[0]), C1, 8, mhi_);              GAPB(oT[1] = MFMA32(VFR(7), PAF(3), oT[1]), C1, 12, mhi_); \
    } while (0)
#define RESC() do { if (resc) { _Pragma("unroll") for (int r = 0; r < 16; ++r) { oT[0][r] *= fsc; oT[1][r] *= fsc; } } } while (0)
    int t = 1;
    for (; t + 5 < NT; t += 2) {
        STEP(pB0, pB1, pA0, pA1, t, false, true, true, true, false);     WAIT_BAR(2); RESC(); ROT();
        STEP(pA0, pA1, pB0, pB1, t + 1, false, true, true, true, false); WAIT_BAR(2); RESC(); ROT();
    }
#define ENDW(tt) do { if ((tt) + 3 < NT) { WAIT_BAR(2); } else if ((tt) + 2 < NT) { WAIT_BAR(1); } else { WAIT_BAR(0); } } while (0)
    for (; t + 1 < NT; t += 2) {
        if (t + 3 >= NT) nx.pop();
        STEP(pB0, pB1, pA0, pA1, t, true, (t + 3 < NT), (t + 1 < NT), (t + 1 < NT), false);         ENDW(t);     RESC(); ROT();
        STEP(pA0, pA1, pB0, pB1, t + 1, true, (t + 4 < NT), (t + 2 < NT), (t + 2 < NT), false);     if (t + 3 >= NT) nx.publish();
        ENDW(t + 1); RESC(); ROT();
    }
    nx.decode();
    if (nx.valid) { const int n0 = sl_next, n1 = NXS(n0), n2 = NXS(n1); const unsigned koffn = (unsigned)(lane * nx.pkn + wave * 8) * 2u;
        DMA_KN(0, n0); DMA_KN(1, n1); DMA_KN(2, n2); s0 = n0; }
    STEP(pB0, pB1, pA0, pA1, NT - 1, true, false, false, false, true); RESC();
    { float sacc = pB0[0] + pB0[1];
#pragma unroll
      for (int r = 2; r < 16; ++r) sacc += pB0[r];
#pragma unroll
      for (int r = 0; r < 16; ++r) sacc += pB1[r];
      l_reg += sacc;
      pw0 = (u32x4){PKW(pB0, 0), PKW(pB0, 2), PKW(pB0, 4), PKW(pB0, 6)}; pw1 = (u32x4){PKW(pB0, 8), PKW(pB0, 10), PKW(pB0, 12), PKW(pB0, 14)};
      pw2 = (u32x4){PKW(pB1, 0), PKW(pB1, 2), PKW(pB1, 4), PKW(pB1, 6)}; pw3 = (u32x4){PKW(pB1, 8), PKW(pB1, 10), PKW(pB1, 12), PKW(pB1, 14)};
      const LAS unsigned char* vp_ = vp0 + sl_cur;
      VRD(0); VRD(1); VRD(2); VRD(3);
      oT[0] = MFMA32(VFR(0), PAF(0), oT[0]); oT[1] = MFMA32(VFR(1), PAF(0), oT[1]); oT[0] = MFMA32(VFR(2), PAF(1), oT[0]); oT[1] = MFMA32(VFR(3), PAF(1), oT[1]); H64_SBAR();
      VRD(4); VRD(5); VRD(6); VRD(7);
      oT[0] = MFMA32(VFR(4), PAF(2), oT[0]); oT[1] = MFMA32(VFR(5), PAF(2), oT[1]); oT[0] = MFMA32(VFR(6), PAF(3), oT[0]); oT[1] = MFMA32(VFR(7), PAF(3), oT[1]); }
    const float inv = 1.f / halfswap_sum(l_reg);
#pragma unroll
    for (int d = 0; d < 2; ++d)
#pragma unroll
        for (int r = 0; r < 16; ++r) oT[d][r] *= inv;
    asm volatile("s_waitcnt lgkmcnt(0)\n\ts_barrier" ::: "memory");
#undef DMA_M
#undef MREAD
#undef DMA_K
#undef DMA_V
#undef DMA_KN
#undef NXS
#undef WAIT_BAR
#undef SET_QX
#undef ROT
#undef KLOAD2
#undef MX3
#undef ROWMAX
#undef MBIT
#undef CROW
#undef EXM
#undef BIASADD
#undef PKW
#undef PAF
#undef VFR
#undef VRD
#undef KRD
#undef GAPA
#undef GAPB
#undef QKA
#undef STEP
#undef RESC
#undef ENDW
}

template <bool BIAS, bool PRE, bool NEXT>
DI void attn_pass_h128(LAS unsigned char* lds, const bf16* Q, const bf16* K, const bf16* V, int pq, int pk, int pv, int q0, int nt, const unsigned long long* maskb, float cfar, f32x16 (&oT)[4], int tid, const LAS float* lut,
                       const bf16* Qn, const bf16* Kn, int pre, int& s0, bf16x8 (&qf)[4], DynNext& nx) {
    constexpr bool MASK = false; constexpr int KS = 4;
    asm volatile("" : "+v"(tid));
    const int lane = tid & 63, wave = __builtin_amdgcn_readfirstlane(tid >> 6), r32 = lane & 31, hi = lane >> 5;
    const int qw0 = q0 + 32 * wave, mylimit = (qw0 >> 6) + 1, NT = nt;
    constexpr int SLOTB = 8192, VSLOTB = 16384, LDS_V = 3 * SLOTB;
    const unsigned koff = (unsigned)(lane * pk + wave * 8) * 2u, voff = (unsigned)((16 * (wave & 3) + (lane >> 2)) * pv + (wave >> 2) * 32 + (lane & 3) * 8) * 2u;
    const unsigned kdst_u = (unsigned)(unsigned long)(lds + wave * 1024), vdst_u = (unsigned)(unsigned long)(lds + LDS_V + wave * 1024);
#define DMA_K(t, slot) glds16s(K + (size_t)(t) * 64 * pk, koff, (unsigned)__builtin_amdgcn_readfirstlane((int)(kdst_u + (unsigned)(slot))))
#define DMA_KN(t, slot) glds16s(Kn + (size_t)(t) * 64 * pk, koff, (unsigned)__builtin_amdgcn_readfirstlane((int)(kdst_u + (unsigned)(slot))))
#define DMA_KD(t, slot) glds16s(uniform_ptr(nx.Kn + (size_t)(t) * 64 * nx.pkn), koffn, (unsigned)__builtin_amdgcn_readfirstlane((int)(kdst_u + (unsigned)(slot))))
#define DMA_V(t, slot) do { glds16s(V + (size_t)(t) * 64 * pv, voff, (unsigned)__builtin_amdgcn_readfirstlane((int)(vdst_u + 2u * (unsigned)(slot)))); \
        glds16s(V + (size_t)(t) * 64 * pv + 64, voff, (unsigned)__builtin_amdgcn_readfirstlane((int)(vdst_u + 2u * (unsigned)(slot) + 8192u))); } while (0)
#define WAIT_BAR(N) do { if (MASK) asm volatile("s_waitcnt vmcnt(" #N ") lgkmcnt(0)\n\ts_barrier" : "+v"(mwc), "+v"(mwn) :: "memory"); else asm volatile("s_waitcnt vmcnt(" #N ") lgkmcnt(0)\n\ts_barrier" ::: "memory"); } while (0)
    const LAS unsigned char* vp0 = lds + LDS_V + ((lane >> 4) & 1) * 32 + (lane & 3) * 8 + (4 * hi + ((lane & 15) >> 2)) * 64;
    const LAS unsigned char* kp0 = lds + hi * 1024 + r32 * 16;
    const unsigned moff = (unsigned)(qw0 + r32) * 512u;
#define MLOAD(dst, t) gld64s(dst, maskb + (t), moff)
    unsigned long long mwc = ~0ull, mwn = ~0ull;
#define NXS(x) ((x) == 2 * SLOTB ? 0 : (x) + SLOTB)
    const int b0 = (PRE || pre) ? s0 : 0, b1 = NXS(b0), b2 = NXS(b1);
    if (!PRE) { if (!pre) { DMA_K(0, b0); DMA_V(0, b0); DMA_K(1, b1); } else DMA_V(0, b0); }
    if (!PRE && !pre) {
#pragma unroll
        for (int d0 = 0; d0 < KS; ++d0) qf[d0] = *(const bf16x8*)(Q + (size_t)(qw0 + r32) * pq + 16 * d0 + 8 * hi);
    }
    float m_ref = 0.f, l_reg = 0.f, fsc = 1.f; bool resc = false;
    const short one_hi0 = hi == 0 ? (short)0x3F80 : (short)0;
    const bf16x8 kx = {one_hi0, one_hi0, one_hi0, 0, 0, 0, 0, 0};
    bf16x8 qx;
#define SET_QX() do { const float c_ = cfar - m_ref; const unsigned b1_ = cvtpk(c_, 0.f) & 0xffffu; const float r1_ = c_ - __uint_as_float(b1_ << 16); const unsigned b2_ = cvtpk(r1_, 0.f) & 0xffffu; \
        const float r2_ = r1_ - __uint_as_float(b2_ << 16); const unsigned b3_ = cvtpk(r2_, 0.f) & 0xffffu; \
        qx = (bf16x8){(short)(hi == 0 ? b1_ : 0u), (short)(hi == 0 ? b2_ : 0u), (short)(hi == 0 ? b3_ : 0u), 0, 0, 0, 0, 0}; } while (0)
    SET_QX();
    oT[0] = (f32x16){}; oT[1] = (f32x16){}; oT[2] = (f32x16){}; oT[3] = (f32x16){};
    f32x16 C0, C1; bf16x8 kf[8]; s16x4 vlo[4], vhi[4]; u32x4 pw0, pw1, pw2, pw3;
    int sl_prev = b0, sl_cur = b0, sl_next = b1;
#define ROT() do { sl_prev = sl_cur; sl_cur = sl_next; sl_next = (sl_next == 2 * SLOTB) ? 0 : sl_next + SLOTB; } while (0)
#define KLOAD2(kp, d0) do { kf[2 * (d0)] = *(const LAS bf16x8*)((kp) + (d0) * 2048); kf[2 * (d0) + 1] = *(const LAS bf16x8*)((kp) + (d0) * 2048 + 512); } while (0)
#define MX3(a, b, c) fmaxf(fmaxf((a), (b)), (c))
#define ROWMAX(p0, p1, out) do { float a_ = MX3(p0[0], p0[1], p1[0]), b_ = MX3(p0[2], p0[3], p1[1]); a_ = MX3(a_, p1[2], p1[3]); \
        _Pragma("unroll") for (int r = 4; r < 16; r += 4) { a_ = MX3(a_, p0[r], p0[r + 1]); b_ = MX3(b_, p0[r + 2], p0[r + 3]); a_ = MX3(a_, p1[r], p1[r + 1]); b_ = MX3(b_, p1[r + 2], p1[r + 3]); } \
        out = halfswap_max(fmaxf(a_, b_)); } while (0)
#define MBIT(mw_, cc) ((int)((mw_) << (31 - (cc))) >> 31)
#define CROW(r) (((r) & 3) + 8 * ((r) >> 2))
#define EXM(X, i, mw_) do { X[i] = __builtin_amdgcn_exp2f(X[i]); if (MASK) X[i] = __int_as_float(__float_as_int(X[i]) & MBIT(mw_, CROW(i))); } while (0)
#define BIASADD(C0, C1, t) do { if (BIAS) { const int relb = (t) * 64 - qw0; if (relb + 63 > -91) { const LAS float* lb = lut + (relb + 192 - r32 + 4 * hi); \
        _Pragma("unroll") for (int r = 0; r < 16; ++r) { C0[r] += lb[CROW(r)]; C1[r] += lb[CROW(r) + 32]; } } } } while (0)
    if (!PRE && !pre) DMA_K(2, b2);
    if (!PRE && pre) { asm volatile("s_waitcnt vmcnt(9)" ::: "memory"); } else { asm volatile("s_waitcnt vmcnt(4)" ::: "memory"); }
    asm volatile("s_waitcnt lgkmcnt(0)\n\ts_barrier" ::: "memory");
#pragma unroll
    for (int d0 = 0; d0 < KS; ++d0) KLOAD2(kp0 + b0, d0);
    C0 = MFMA32(kx, qx, (f32x16){}); C1 = MFMA32(kx, qx, (f32x16){});
#pragma unroll
    for (int d0 = 0; d0 < KS; ++d0) { C0 = MFMA32(kf[2 * d0], qf[d0], C0); C1 = MFMA32(kf[2 * d0 + 1], qf[d0], C1); }
    BIASADD(C0, C1, 0);
    { float rm; ROWMAX(C0, C1, rm); m_ref = rm; float sacc = 0.f;
#pragma unroll
      for (int r = 0; r < 16; ++r) { C0[r] = __builtin_amdgcn_exp2f(C0[r] - rm); C1[r] = __builtin_amdgcn_exp2f(C1[r] - rm); sacc += C0[r] + C1[r]; }
      l_reg = sacc;
      pw0 = (u32x4){cvtpk(C0[0], C0[1]), cvtpk(C0[2], C0[3]), cvtpk(C0[4], C0[5]), cvtpk(C0[6], C0[7])}; pw1 = (u32x4){cvtpk(C0[8], C0[9]), cvtpk(C0[10], C0[11]), cvtpk(C0[12], C0[13]), cvtpk(C0[14], C0[15])};
      pw2 = (u32x4){cvtpk(C1[0], C1[1]), cvtpk(C1[2], C1[3]), cvtpk(C1[4], C1[5]), cvtpk(C1[6], C1[7])}; pw3 = (u32x4){cvtpk(C1[8], C1[9]), cvtpk(C1[10], C1[11]), cvtpk(C1[12], C1[13]), cvtpk(C1[14], C1[15])}; }
    SET_QX();
    if (MASK) MLOAD(mwn, 1);
    WAIT_BAR(0);
    if (MASK) mwc = mwn;
    DMA_K(3, b0); DMA_V(1, b1); ROT();
#pragma unroll
    for (int d0 = 0; d0 < KS; ++d0) KLOAD2(kp0 + sl_cur, d0);
    WAIT_BAR(3);
#define PKW(P, i) cvtpk(P[i], P[i + 1])
#define PAF(k) __builtin_bit_cast(bf16x8, pw##k)
#define VFR(i) (bf16x8){vlo[i][0], vlo[i][1], vlo[i][2], vlo[i][3], vhi[i][0], vhi[i][1], vhi[i][2], vhi[i][3]}
#define VRD(i) do { vlo[(i) & 3] = vtr(vp_ + (((i) & 3) * 4096 + ((i) >> 2) * 1024)); vhi[(i) & 3] = vtr(vp_ + (((i) & 3) * 4096 + ((i) >> 2) * 1024 + 512)); } while (0)
#define KRD(G, d0) do { if ((G) && (d0) < KS) { KLOAD2(kp0 + sl_next, d0); H64_SBAR(); } } while (0)
#define GAPA(MF, a0, a1, a2, a3, W0, W1, PW) do { MF; sacc += a0; sacc += a1; sacc += a2; sacc += a3; W0; W1; H64_PIN(PW); H64_PIN(sacc); H64_SBAR(); } while (0)
#define GAPB2(MF, X, i) do { MF; X[i] = __builtin_amdgcn_exp2f(X[i]); X[(i) + 1] = __builtin_amdgcn_exp2f(X[(i) + 1]); H64_PIN(X); H64_SBAR(); } while (0)
#define GAPB(MF, X, i, mw_) do { MF; EXM(X, i, mw_); EXM(X, (i) + 1, mw_); EXM(X, (i) + 2, mw_); EXM(X, (i) + 3, mw_); H64_PIN(X); H64_SBAR(); } while (0)
#define STEP(t, BAND, GK, GV, GL, GQ) do { H64_SBAR(); \
    const LAS unsigned char* vp_ = vp0 + 2 * sl_prev; \
    C0 = MFMA32(kx, qx, (f32x16){}); C1 = MFMA32(kx, qx, (f32x16){}); H64_SBAR(); \
    VRD(0); H64_SBAR(); C0 = MFMA32(kf[0], qf[0], C0); H64_SBAR(); VRD(1); H64_SBAR(); C1 = MFMA32(kf[1], qf[0], C1); H64_SBAR(); \
    VRD(2); H64_SBAR(); C0 = MFMA32(kf[2], qf[1], C0); H64_SBAR(); VRD(3); H64_SBAR(); C1 = MFMA32(kf[3], qf[1], C1); H64_SBAR(); \
    C0 = MFMA32(kf[4], qf[2], C0); H64_SBAR(); C1 = MFMA32(kf[5], qf[2], C1); H64_SBAR(); \
    C0 = MFMA32(kf[6], qf[3], C0); H64_SBAR(); C1 = MFMA32(kf[7], qf[3], C1); H64_SBAR(); \
    if (GK) DMA_K((t) + 3, sl_cur); if (GV) DMA_V((t) + 1, sl_next); \
    if (NEXT && (GQ)) { _Pragma("unroll") for (int d0 = 0; d0 < KS; ++d0) qf[d0] = *(const bf16x8*)(Qn + (size_t)(qw0 + r32) * pq + 16 * d0 + 8 * hi); } \
    if (PRE && (GQ)) { if (nx.valid) { _Pragma("unroll") for (int d0 = 0; d0 < 4; ++d0) qf[d0] = *(const bf16x8*)(nx.qnl + 16 * d0); } } \
    if (BAND) { if ((t) >= mylimit) { _Pragma("unroll") for (int r = 0; r < 16; ++r) { C0[r] = -INFINITY; C1[r] = -INFINITY; } } } \
    BIASADD(C0, C1, t); \
    { float rm; ROWMAX(C0, C1, rm); resc = false; \
      if (__builtin_expect(__any(rm > 8.f), 0)) { const float dl = fmaxf(rm, 0.f); m_ref += dl; fsc = __builtin_amdgcn_exp2f(-dl); l_reg *= fsc; resc = true; SET_QX(); \
          _Pragma("unroll") for (int r = 0; r < 16; ++r) { C0[r] -= dl; C1[r] -= dl; } } } \
    float sacc = 0.f; H64_SBAR(); \
    oT[0] = MFMA32(VFR(0), PAF(0), oT[0]); C0[0] = __builtin_amdgcn_exp2f(C0[0]); C0[1] = __builtin_amdgcn_exp2f(C0[1]); C0[2] = __builtin_amdgcn_exp2f(C0[2]); H64_PIN(C0); H64_SBAR(); VRD(4); H64_SBAR(); \
    oT[1] = MFMA32(VFR(1), PAF(0), oT[1]); C0[3] = __builtin_amdgcn_exp2f(C0[3]); C0[4] = __builtin_amdgcn_exp2f(C0[4]); C0[5] = __builtin_amdgcn_exp2f(C0[5]); sacc += C0[0]; sacc += C0[1]; H64_PIN(C0); H64_PIN(sacc); H64_SBAR(); VRD(5); H64_SBAR(); \
    oT[2] = MFMA32(VFR(2), PAF(0), oT[2]); C0[6] = __builtin_amdgcn_exp2f(C0[6]); C0[7] = __builtin_amdgcn_exp2f(C0[7]); C0[8] = __builtin_amdgcn_exp2f(C0[8]); sacc += C0[2]; sacc += C0[3]; H64_PIN(C0); H64_PIN(sacc); H64_SBAR(); VRD(6); H64_SBAR(); \
    oT[3] = MFMA32(VFR(3), PAF(0), oT[3]); C0[9] = __builtin_amdgcn_exp2f(C0[9]); C0[10] = __builtin_amdgcn_exp2f(C0[10]); C0[11] = __builtin_amdgcn_exp2f(C0[11]); sacc += C0[4]; sacc += C0[5]; H64_PIN(C0); H64_PIN(sacc); H64_SBAR(); VRD(7); H64_SBAR(); \
    oT[0] = MFMA32(VFR(0), PAF(1), oT[0]); C0[12] = __builtin_amdgcn_exp2f(C0[12]); C0[13] = __builtin_amdgcn_exp2f(C0[13]); C0[14] = __builtin_amdgcn_exp2f(C0[14]); sacc += C0[6]; sacc += C0[7]; pw0[0] = cvtpk(C0[0], C0[1]); H64_PIN(C0); H64_PIN(pw0); H64_PIN(sacc); H64_SBAR(); VRD(8); H64_SBAR(); \
    oT[1] = MFMA32(VFR(1), PAF(1), oT[1]); C0[15] = __builtin_amdgcn_exp2f(C0[15]); C1[0] = __builtin_amdgcn_exp2f(C1[0]); C1[1] = __builtin_amdgcn_exp2f(C1[1]); sacc += C0[8]; sacc += C0[9]; pw0[1] = cvtpk(C0[2], C0[3]); H64_PIN(C0); H64_PIN(C1); H64_PIN(pw0); H64_PIN(sacc); H64_SBAR(); VRD(9); H64_SBAR(); \
    oT[2] = MFMA32(VFR(2), PAF(1), oT[2]); C1[2] = __builtin_amdgcn_exp2f(C1[2]); C1[3] = __builtin_amdgcn_exp2f(C1[3]); C1[4] = __builtin_amdgcn_exp2f(C1[4]); sacc += C0[10]; sacc += C0[11]; pw0[2] = cvtpk(C0[4], C0[5]); H64_PIN(C1); H64_PIN(pw0); H64_PIN(sacc); H64_SBAR(); VRD(10); H64_SBAR(); \
    oT[3] = MFMA32(VFR(3), PAF(1), oT[3]); C1[5] = __builtin_amdgcn_exp2f(C1[5]); C1[6] = __builtin_amdgcn_exp2f(C1[6]); C1[7] = __builtin_amdgcn_exp2f(C1[7]); sacc += C0[12]; sacc += C0[13]; pw0[3] = cvtpk(C0[6], C0[7]); H64_PIN(C1); H64_PIN(pw0); H64_PIN(sacc); H64_SBAR(); VRD(11); H64_SBAR(); \
    KRD(GL, 0); oT[0] = MFMA32(VFR(0), PAF(2), oT[0]); C1[8] = __builtin_amdgcn_exp2f(C1[8]); C1[9] = __builtin_amdgcn_exp2f(C1[9]); C1[10] = __builtin_amdgcn_exp2f(C1[10]); sacc += C0[14]; sacc += C0[15]; pw1[0] = cvtpk(C0[8], C0[9]); H64_PIN(C1); H64_PIN(pw1); H64_PIN(sacc); H64_SBAR(); VRD(12); H64_SBAR(); \
    oT[1] = MFMA32(VFR(1), PAF(2), oT[1]); C1[11] = __builtin_amdgcn_exp2f(C1[11]); C1[12] = __builtin_amdgcn_exp2f(C1[12]); C1[13] = __builtin_amdgcn_exp2f(C1[13]); sacc += C1[0]; sacc += C1[1]; pw1[1] = cvtpk(C0[10], C0[11]); H64_PIN(C1); H64_PIN(pw1); H64_PIN(sacc); H64_SBAR(); VRD(13); H64_SBAR(); \
    KRD(GL, 1); oT[2] = MFMA32(VFR(2), PAF(2), oT[2]); C1[14] = __builtin_amdgcn_exp2f(C1[14]); C1[15] = __builtin_amdgcn_exp2f(C1[15]); sacc += C1[2]; sacc += C1[3]; pw1[2] = cvtpk(C0[12], C0[13]); H64_PIN(C1); H64_PIN(pw1); H64_PIN(sacc); H64_SBAR(); VRD(14); H64_SBAR(); \
    oT[3] = MFMA32(VFR(3), PAF(2), oT[3]); sacc += C1[4]; sacc += C1[5]; pw1[3] = cvtpk(C0[14], C0[15]); H64_PIN(pw1); H64_PIN(sacc); H64_SBAR(); VRD(15); H64_SBAR(); \
    KRD(GL, 2); oT[0] = MFMA32(VFR(0), PAF(3), oT[0]); sacc += C1[6]; sacc += C1[7]; pw2[0] = cvtpk(C1[0], C1[1]); H64_PIN(pw2); H64_PIN(sacc); H64_SBAR(); \
    oT[1] = MFMA32(VFR(1), PAF(3), oT[1]); sacc += C1[8]; sacc += C1[9]; pw2[1] = cvtpk(C1[2], C1[3]); H64_PIN(pw2); H64_PIN(sacc); H64_SBAR(); \
    KRD(GL, 3); oT[2] = MFMA32(VFR(2), PAF(3), oT[2]); sacc += C1[10]; sacc += C1[11]; pw2[2] = cvtpk(C1[4], C1[5]); H64_PIN(pw2); H64_PIN(sacc); H64_SBAR(); \
    oT[3] = MFMA32(VFR(3), PAF(3), oT[3]); sacc += C1[12]; sacc += C1[13]; pw2[3] = cvtpk(C1[6], C1[7]); H64_PIN(pw2); H64_PIN(sacc); H64_SBAR(); \
    sacc += C1[14]; sacc += C1[15]; l_reg += sacc; \
    pw3[0] = cvtpk(C1[8], C1[9]); pw3[1] = cvtpk(C1[10], C1[11]); pw3[2] = cvtpk(C1[12], C1[13]); pw3[3] = cvtpk(C1[14], C1[15]); \
    } while (0)
#define RESC() do { if (resc) { _Pragma("unroll") for (int r = 0; r < 16; ++r) { oT[0][r] *= fsc; oT[1][r] *= fsc; oT[2][r] *= fsc; oT[3][r] *= fsc; } } } while (0)
    int t = 1;
    for (; t + 4 < NT; ++t) { STEP(t, false, true, true, true, false); WAIT_BAR(3); RESC(); ROT(); }
#define ENDW(tt) do { if ((tt) + 3 < NT) { WAIT_BAR(3); } else if ((tt) + 2 < NT) { WAIT_BAR(2); } else { WAIT_BAR(0); } } while (0)
    for (; t + 1 < NT; ++t) { if (PRE && t + 3 == NT) nx.pop(); STEP(t, true, (t + 3 < NT), (t + 1 < NT), (t + 1 < NT), false); if (PRE && t + 2 == NT) nx.publish(); ENDW(t); RESC(); ROT(); }
    if (NEXT) { const int n0 = sl_next, n1 = NXS(n0), n2 = NXS(n1); DMA_KN(0, n0); DMA_V(0, n0); DMA_KN(1, n1); DMA_KN(2, n2); s0 = n0; }
    if (PRE) { nx.decode(); if (nx.valid) { const int n0 = sl_next, n1 = NXS(n0), n2 = NXS(n1); const unsigned koffn = (unsigned)(lane * nx.pkn + wave * 8) * 2u; DMA_KD(0, n0); DMA_KD(1, n1); DMA_KD(2, n2); s0 = n0; } }
    STEP(NT - 1, true, false, false, false, true); RESC();
    { const LAS unsigned char* vp_ = vp0 + 2 * sl_cur;
      VRD(0); VRD(1); VRD(2); VRD(3);
      oT[0] = MFMA32(VFR(0), PAF(0), oT[0]); oT[1] = MFMA32(VFR(1), PAF(0), oT[1]); oT[2] = MFMA32(VFR(2), PAF(0), oT[2]); oT[3] = MFMA32(VFR(3), PAF(0), oT[3]); H64_SBAR();
      VRD(4); VRD(5); VRD(6); VRD(7);
      oT[0] = MFMA32(VFR(0), PAF(1), oT[0]); oT[1] = MFMA32(VFR(1), PAF(1), oT[1]); oT[2] = MFMA32(VFR(2), PAF(1), oT[2]); oT[3] = MFMA32(VFR(3), PAF(1), oT[3]); H64_SBAR();
      VRD(8); VRD(9); VRD(10); VRD(11);
      oT[0] = MFMA32(VFR(0), PAF(2), oT[0]); oT[1] = MFMA32(VFR(1), PAF(2), oT[1]); oT[2] = MFMA32(VFR(2), PAF(2), oT[2]); oT[3] = MFMA32(VFR(3), PAF(2), oT[3]); H64_SBAR();
      VRD(12); VRD(13); VRD(14); VRD(15);
      oT[0] = MFMA32(VFR(0), PAF(3), oT[0]); oT[1] = MFMA32(VFR(1), PAF(3), oT[1]); oT[2] = MFMA32(VFR(2), PAF(3), oT[2]); oT[3] = MFMA32(VFR(3), PAF(3), oT[3]); H64_SBAR();
    }
    const float inv = 1.f / halfswap_sum(l_reg);
#pragma unroll
    for (int d = 0; d < 4; ++d)
#pragma unroll
        for (int r = 0; r < 16; ++r) oT[d][r] *= inv;
    asm volatile("s_waitcnt lgkmcnt(0)\n\ts_barrier" ::: "memory");
#undef MLOAD
#undef DMA_K
#undef DMA_V
#undef DMA_KN
#undef DMA_KD
#undef NXS
#undef WAIT_BAR
#undef SET_QX
#undef ROT
#undef KLOAD2
#undef MX3
#undef ROWMAX
#undef MBIT
#undef CROW
#undef EXM
#undef BIASADD
#undef PKW
#undef PAF
#undef VFR
#undef VRD
#undef KRD
#undef GAPA
#undef GAPB
#undef GAPB2
#undef STEP
#undef RESC
#undef ENDW
}

template <int ND>
DI void store_oT(bf16* orow, const f32x16 (&oT)[ND], int hi) {
#pragma unroll
    for (int d = 0; d < ND; ++d)
#pragma unroll
        for (int g = 0; g < 4; ++g) st4(orow + 32 * d + 8 * g + 4 * hi, oT[d][4 * g], oT[d][4 * g + 1], oT[d][4 * g + 2], oT[d][4 * g + 3]);
}

DI void attn_phase(const bf16* Z, const bf16* MLA, bf16* MIX, const unsigned long long* MASK, unsigned* O0, const float* par, const float* subln, int layer, gu32* qctr,
                   const float* w_gate, const float* w_up, const float* w_down, unsigned char* WGU, unsigned char* WD, LAS unsigned char* lds, int tid) {
    const int lane = tid & 63, wave = __builtin_amdgcn_readfirstlane(tid >> 6), r32 = lane & 31, hi = lane >> 5;
    volatile LAS int* slot = (volatile LAS int*)(lds + AUX_OFF + 2048);
    LAS float* lutall = (LAS float*)(lds + 73728);
    LAS float* gain = (LAS float*)(lds + AUX_OFF + 1024);
    const float lam = par[layer], omli = par[2 + layer];
    for (int i = tid; i < 2048; i += NTHR) lutall[i] = par[(PAR_LUT / 4) + i] - par[(PAR_LUT / 4) + (i & ~255)];
    if (tid < 128) gain[tid] = subln[layer * 128 + tid] * omli;
    LAS unsigned* ordl = (LAS unsigned*)(lds + ORD_OFF);
    for (int i = tid; i < 1536; i += NTHR) ordl[i] = ((const unsigned*)par)[(PAR_ORD / 4) + i];
    __syncthreads();
    DynNext nx; nx.qctr = qctr; nx.slot2 = slot + 16; nx.ordl = ordl; nx.Z = Z; nx.MLA = MLA; nx.tid = tid; nx.qrow = 32 * wave + r32; nx.hi = hi; nx.popv = 0; nx.uqn = 0; nx.valid = false; nx.Kn = Z; nx.qnl = Z; nx.pkn = ZP;
    bool known = false; int s0 = 0; bf16x8 qfx[4];
    for (;;) {
        int uq, pre = 0;
        if (known) { uq = __builtin_amdgcn_readfirstlane(nx.uqn); pre = __builtin_amdgcn_readfirstlane(nx.valid ? 1 : 0); }
        else { if (tid == 0) *slot = (int)__hip_atomic_fetch_add(qctr, 1u, RLX_AGENT); __syncthreads(); uq = *slot; }
        known = false;
        if (uq >= 2304) break;
        if (uq % 3 == 2) {
            const int grp = uq / 3;
            moe_convert_items<4>(w_gate, w_up, w_down, WGU, WD, (LAS float*)(lds + wave * 8448), grp * 32 + wave * 4, lane);
            __syncthreads();
            continue;
        }
        const int u = (uq / 3) * 2 + (uq % 3);
        const unsigned ue = (unsigned)__builtin_amdgcn_readfirstlane((int)ordl[u]);
        const int type = (int)(ue >> 16), qb = (int)((ue >> 8) & 0xffu), bh = (int)(ue & 0xffu), b = bh >> 2, h = bh & 3;
        const int q0 = qb * 256, nt = 4 * qb + 4; const size_t rb = (size_t)b * SEQ;
        const float cfar = type < 2 ? par[(PAR_LUT / 4) + (type * 4 + h) * 256] : 0.f;
        if (type == 0) {
            bf16* orow = MIX + (rb + q0 + 32 * wave + r32) * DM;
            f32x16 oT[4];
#define O0L(j) (*(LAS u32x4*)(lds + ((j) < 6 ? PARK_A + (j) * 8192 : PARK_B + ((j) - 6) * 8192) + tid * 16))
            const bf16* Vp = Z + rb * ZP + Z_AV + h * 128;
            attn_pass_h128<true, false, true>(lds, Z + rb * ZP + Z_AQ + (h * 2) * 64, Z + rb * ZP + Z_AK + (h * 2) * 64, Vp, ZP, ZP, ZP, q0, nt, nullptr, cfar, oT, tid, lutall + (type * 4 + h) * 256,
                                              Z + rb * ZP + Z_AQ + (h * 2 + 1) * 64, Z + rb * ZP + Z_AK + (h * 2 + 1) * 64, pre, s0, qfx, nx);
#pragma unroll
            for (int d = 0; d < 4; ++d)
#pragma unroll
                for (int i = 0; i < 2; ++i) O0L(d * 2 + i) = (u32x4){cvtpk(oT[d][8 * i], oT[d][8 * i + 1]), cvtpk(oT[d][8 * i + 2], oT[d][8 * i + 3]), cvtpk(oT[d][8 * i + 4], oT[d][8 * i + 5]), cvtpk(oT[d][8 * i + 6], oT[d][8 * i + 7])};
            attn_pass_h128<true, true, false>(lds, Z + rb * ZP + Z_AQ + (h * 2 + 1) * 64, Z + rb * ZP + Z_AK + (h * 2 + 1) * 64, Vp, ZP, ZP, ZP, q0, nt, nullptr, cfar, oT, tid, lutall + (type * 4 + h) * 256,
                                              nullptr, nullptr, 0, s0, qfx, nx); known = true;
            float ss = 0.f;
#pragma unroll
            for (int d = 0; d < 4; ++d)
#pragma unroll
                for (int i = 0; i < 2; ++i) { const u32x4 pk = O0L(d * 2 + i);
#pragma unroll
                    for (int e = 0; e < 4; ++e) { const unsigned p = pk[e]; const float a = __uint_as_float(p << 16) - lam * oT[d][8 * i + 2 * e], c2 = __uint_as_float(p & 0xffff0000u) - lam * oT[d][8 * i + 2 * e + 1];
                        oT[d][8 * i + 2 * e] = a; oT[d][8 * i + 2 * e + 1] = c2; ss += a * a + c2 * c2; } }
            const float rstd = rsqrtf(halfswap_sum(ss) * (1.f / 128.f) + EPS);
#pragma unroll
            for (int d = 0; d < 4; ++d)
#pragma unroll
                for (int rr = 0; rr < 16; ++rr) oT[d][rr] *= rstd * gain[32 * d + (rr & 3) + 8 * (rr >> 2) + 4 * hi];
            store_oT<4>(orow + h * 128, oT, hi);
        } else if (type == 1) {
            f32x16 oT[2];
            attn_pass_h64<true, true, 4>(lds, Z + rb * ZP + Z_BQ + h * 64, Z + rb * ZP + Z_BK + h * 64, Z + rb * ZP + Z_BV + h * 64, ZP, ZP, ZP, q0, nt, MASK + rb * 64, cfar, oT, tid, lutall + (type * 4 + h) * 256, pre, s0, qfx, nx); known = true;
            store_oT<2>(MIX + (rb + q0 + 32 * wave + r32) * DM + 512 + h * 64, oT, hi);
        } else {
            f32x16 oT[2];
            attn_pass_h64<false, false, 3>(lds, MLA + rb * MLAP + h * 64, MLA + rb * MLAP + 256 + h * 64, MLA + rb * MLAP + 512 + h * 64, MLAP, MLAP, MLAP, q0, nt, nullptr, cfar, oT, tid, lutall + (type * 4 + h) * 256, pre, s0, qfx, nx); known = true;
            store_oT<2>(MIX + (rb + q0 + 32 * wave + r32) * DM + 768 + h * 64, oT, hi);
        }
    }
}


DI void router_unit(const bf16* XA, const bf16* WRl  , const float* bg, const float* be, int* rt_e, float* rt_g, float* rstd_g, int* cnt_g, LAS unsigned char* lds, int unit, int tid) {
    const int lane = tid & 63, wave = __builtin_amdgcn_readfirstlane(tid >> 6), r32 = lane & 31, hi = lane >> 5;
    LAS int* hist = (LAS int*)(lds + AUX_OFF + 4096);
    LAS float* xch = (LAS float*)lds;
    if (tid < 32) hist[tid] = 0;
    f32x16 a0[4], a1[4]; float ss[4];
#pragma unroll
    for (int tb = 0; tb < 4; ++tb) { a0[tb] = (f32x16){}; a1[tb] = (f32x16){}; ss[tb] = 0.f; }
    const bf16* xg = XA + (size_t)(unit * 128 + r32) * DM + wave * 128 + 32 * hi;
    const bf16* wg = WRl + (size_t)r32 * 1024 + wave * 128 + 32 * hi;
    const bf16* wg2 = WRl + (size_t)(32 + (r32 < 4 ? r32 : 4)) * 1024 + wave * 128 + 32 * hi;
    u32x4 X[2][4]; bf16x8 W[2][4];
#define RT_LD(s, S) do { const int o_ = 64 * ((s) >> 2) + 8 * ((s) & 3); _Pragma("unroll") for (int tb = 0; tb < 4; ++tb) X[S][tb] = *(const u32x4*)(xg + (size_t)tb * 32 * DM + o_); \
        W[S][0] = *(const bf16x8*)(wg + o_); W[S][1] = *(const bf16x8*)(wg + 64 * 1024 + o_); W[S][2] = *(const bf16x8*)(wg2 + o_); W[S][3] = *(const bf16x8*)(wg2 + 64 * 1024 + o_); } while (0)
#define RT_CP(S) do { _Pragma("unroll") for (int tb = 0; tb < 4; ++tb) { \
            const f32x4 xa = {__uint_as_float(X[S][tb].x << 16), __uint_as_float(X[S][tb].x & 0xffff0000u), __uint_as_float(X[S][tb].y << 16), __uint_as_float(X[S][tb].y & 0xffff0000u)}, \
                        xb = {__uint_as_float(X[S][tb].z << 16), __uint_as_float(X[S][tb].z & 0xffff0000u), __uint_as_float(X[S][tb].w << 16), __uint_as_float(X[S][tb].w & 0xffff0000u)}; \
            ss[tb] += (xa[0] * xa[0] + xa[1] * xa[1]) + (xa[2] * xa[2] + xa[3] * xa[3]) + (xb[0] * xb[0] + xb[1] * xb[1]) + (xb[2] * xb[2] + xb[3] * xb[3]); \
            const bf16x8 xh = __builtin_bit_cast(bf16x8, X[S][tb]); \
            a0[tb] = MFMA32(W[S][0], xh, a0[tb]); a0[tb] = MFMA32(W[S][1], xh, a0[tb]); a1[tb] = MFMA32(W[S][2], xh, a1[tb]); a1[tb] = MFMA32(W[S][3], xh, a1[tb]); } } while (0)
    RT_LD(0, 0);
    for (int s = 0; s < 8; s += 2) {
        RT_LD(s + 1, 1);
        RT_CP(0);
        { const int sn = s + 2 < 8 ? s + 2 : 7; RT_LD(sn, 0); }
        RT_CP(1);
    }
#undef RT_LD
#undef RT_CP
#pragma unroll
    for (int r = 4; r >= 1; r >>= 1) {
        if (wave >= r && wave < 2 * r) { LAS float* o = xch + (wave - r) * (84 * 64) + lane;
#pragma unroll
            for (int tb = 0; tb < 4; ++tb) {
#pragma unroll
                for (int i = 0; i < 16; ++i) o[(tb * 21 + i) * 64] = a0[tb][i];
#pragma unroll
                for (int i = 0; i < 4; ++i) o[(tb * 21 + 16 + i) * 64] = a1[tb][i];
                o[(tb * 21 + 20) * 64] = ss[tb]; } }
        __syncthreads();
        if (wave < r) { const LAS float* o = xch + wave * (84 * 64) + lane;
#pragma unroll
            for (int tb = 0; tb < 4; ++tb) {
#pragma unroll
                for (int i = 0; i < 16; ++i) a0[tb][i] += o[(tb * 21 + i) * 64];
#pragma unroll
                for (int i = 0; i < 4; ++i) a1[tb][i] += o[(tb * 21 + 16 + i) * 64];
                ss[tb] += o[(tb * 21 + 20) * 64]; } }
        __syncthreads();
    }
    if (wave == 0) {
#pragma unroll
        for (int tb = 0; tb < 4; ++tb) {
            const int row = unit * 128 + tb * 32 + r32;
            const f32x16 acc0 = a0[tb], acc1 = a1[tb];
            const float rstd = rsqrtf(halfswap_sum(ss[tb]) * (1.f / DM) + EPS);
            float g[4];
#pragma unroll
            for (int r = 0; r < 4; ++r) { const float v = acc1[r] * rstd; const float o2 = __shfl_xor(v, 32); g[r] = (hi ? o2 : v) + bg[r]; }
            int gsel = 0; float gmax = g[0];
#pragma unroll
            for (int r = 1; r < 4; ++r) if (g[r] > gmax) { gmax = g[r]; gsel = r; }
            float gsum = 0.f;
#pragma unroll
            for (int r = 0; r < 4; ++r) gsum += expf(g[r] - gmax);
            const float gpb = 1.f / gsum;
            float part[4], e[8];
#pragma unroll
            for (int k = 0; k < 4; ++k) part[k] = (gsel == 0 ? acc0[k] : (gsel == 1 ? acc0[4 + k] : (gsel == 2 ? acc0[8 + k] : acc0[12 + k]))) * rstd;
#pragma unroll
            for (int k = 0; k < 4; ++k) { const float o2 = __shfl_xor(part[k], 32); e[k] = hi ? o2 : part[k]; e[4 + k] = hi ? part[k] : o2; }
#pragma unroll
            for (int i = 0; i < 8; ++i) e[i] += be[8 * gsel + i];
            int i1 = 0; float e1 = e[0];
#pragma unroll
            for (int i = 1; i < 8; ++i) if (e[i] > e1) { e1 = e[i]; i1 = i; }
            int i2 = -1; float e2 = -INFINITY;
#pragma unroll
            for (int i = 0; i < 8; ++i) if (i != i1 && e[i] > e2) { e2 = e[i]; i2 = i; }
            const float p2 = expf(e2 - e1), den = 1.f / (1.f + p2);
            if (hi == 0) {
                const int ea = 8 * gsel + i1, eb = 8 * gsel + i2;
                rt_e[2 * row] = ea; rt_e[2 * row + 1] = eb; rt_g[2 * row] = gpb * den; rt_g[2 * row + 1] = gpb * p2 * den; rstd_g[row] = rstd;
                atomicAdd((int*)&hist[ea], 1); atomicAdd((int*)&hist[eb], 1);
            }
        }
    }
    __syncthreads();
    if (tid < 32) cnt_g[unit * 32 + tid] = hist[tid];
    __syncthreads();
}

DI void sort_unit(const int* rt_e, int* rt_d, const float* rstd_g, const int* cnt_g, int* blk_e, int* nblk, int* src, float* rs_sorted, LAS unsigned char* lds, int unit, int tid) {
    const int lane = tid & 63, wave = __builtin_amdgcn_readfirstlane(tid >> 6);
    LAS int* pt = (LAS int*)lds; LAS int* pp = pt + 512; LAS int* tot = pp + 512; LAS int* pre = tot + 32; LAS int* base = pre + 32; LAS int* wc = base + 32; LAS int* est = wc + 128;
    { const int e = tid & 31, grp = tid >> 5; int t = 0, p = 0;
#pragma unroll 4
      for (int i = 0; i < 16; ++i) { const int c = grp * 16 + i; const int v = cnt_g[c * 32 + e]; t += v; p += (c < unit) ? v : 0; }
      pt[tid] = t; pp[tid] = p; }
    int ea = -1;
    if (tid < 256) ea = rt_e[unit * 256 + tid];
    __syncthreads();
    if (tid < 32) { int t = 0, p = 0;
#pragma unroll
        for (int g = 0; g < 16; ++g) { t += pt[g * 32 + tid]; p += pp[g * 32 + tid]; }
        tot[tid] = t; pre[tid] = p; }
    int myrank = 0;
    if (wave < 4) { int mycnt = 0;
        for (int e = 0; e < 32; ++e) { const unsigned long long m = __builtin_amdgcn_ballot_w64(ea == e);
            if (ea == e) myrank = __builtin_popcountll(m & ((1ull << lane) - 1ull));
            if (lane == e) mycnt = __builtin_popcountll(m); }
        if (lane < 32) wc[wave * 32 + lane] = mycnt; }
    __syncthreads();
    if (tid == 0) { int s = 0; for (int e = 0; e < 32; ++e) { const int padded = (tot[e] + 255) & ~255; base[e] = s + pre[e]; est[e] = s;
            if (unit == 0) for (int j = s >> 8; j < ((s + padded) >> 8); ++j) blk_e[j] = e;
            s += padded; }
        if (unit == 0) *nblk = s >> 8; }
    __syncthreads();
    if (tid < 256) { int d = base[ea] + myrank; for (int w = 0; w < wave; ++w) d += wc[w * 32 + ea];
        const int tok = unit * 128 + (tid >> 1);
        rt_d[unit * 256 + tid] = d; src[d] = tok; rs_sorted[d] = rstd_g[tok]; }
    if (unit < 32) { const int e = unit, first = est[e] + tot[e], npad = ((tot[e] + 255) & ~255) - tot[e];
        for (int i = tid; i < npad; i += NTHR) { src[first + i] = 0; rs_sorted[first + i] = 0.f; } }
    __syncthreads();
}

constexpr int NPH = 20;
struct Args { In in; float* out; unsigned char* ws; int ph_lo, ph_hi, li, pad; };
__global__ void __launch_bounds__(NTHR, 2) fwd(Args args) {
    extern __shared__ __attribute__((aligned(16))) unsigned char lds_raw[];
    LAS unsigned char* lds = (LAS unsigned char*)lds_raw;
    const int tid0 = threadIdx.x;
    const int wave0 = __builtin_amdgcn_readfirstlane(tid0 >> 6);
    const int G = gridDim.x;
    unsigned char* ws0 = args.ws; const In& I = args.in;
    gu32* ctl = (gu32*)(ws0 + WS_CTL);
    volatile LAS unsigned* MISC = (volatile LAS unsigned*)(lds + MISC_OFF);
    if (tid0 < 64) MISC[tid0] = 0u;
    __syncthreads();
    XcdBarrier bar = xcd_barrier_post((unsigned*)(ctl + CW_BAR) + args.li * XCD_BAR_WORDS, MISC + 8);
    const int lo = args.ph_lo, hi_ph = args.ph_hi;
#ifndef PHMASK
#define PHMASK 0xFFFFF
#endif
#define IN(k) (lo <= (k) && (k) < hi_ph)
#define EN(j) ((PHMASK >> (j)) & 1)
#ifndef REPMASK
#define REPMASK 0
#endif
#define NREP(j) (1 + ((REPMASK >> (j)) & 1))
#define SEAM(k) do { if (IN(k) && IN((k) + 1)) xcd_barrier(bar); } while (0)
#define PHASE_ENV \
    int tid = wave0 * 64 + (int)__builtin_amdgcn_mbcnt_hi(~0u, __builtin_amdgcn_mbcnt_lo(~0u, 0u)); asm volatile("" : "+v"(tid)); GAS unsigned char* wsg_ = (GAS unsigned char*)ws0; asm volatile("" : "+s"(wsg_)); unsigned char* ws = (unsigned char*)wsg_; \
    const int lane = tid & 63, wave = __builtin_amdgcn_readfirstlane(tid >> 6); const int gw = blockIdx.x * NWAVES + wave, NGW = G * NWAVES; \
    bf16* XA = (bf16*)(ws + WS_XA); float* OUT = (float*)(GAS float*)args.out; bf16* XN = (bf16*)(GAS bf16*)args.out; (void)OUT; bf16* Z = (bf16*)(ws + WS_Z); unsigned char* XS = ws + WS_Z; unsigned char* Y = ws + WS_Z; \
    bf16* MLA = (bf16*)(ws + WS_MLA); unsigned char* H = ws + WS_MLA; unsigned long long* MASK = (unsigned long long*)(ws + WS_MASK); \
    unsigned char* WGU = ws + WS_WGU; unsigned char* WD = ws + WS_WD; const float* par = (const float*)(ws + WS_PAR); \
    int* rt_e = (int*)(ws + WS_ROUTE + RT_E); float* rt_g = (float*)(ws + WS_ROUTE + RT_G); int* rt_d = (int*)(ws + WS_ROUTE + RT_D); \
    int* cnt_g = (int*)(ws + WS_ROUTE + RT_CNT); float* rstd_g = (float*)(ws + WS_ROUTE + RT_RSTD); int* blk_e = (int*)(ws + WS_ROUTE + RT_BLK); int* nblk = (int*)(ws + WS_ROUTE + RT_NBLK); \
    (void)lane; (void)gw; (void)NGW; (void)XA; (void)XN; (void)Z; (void)XS; (void)Y; (void)MLA; (void)H; (void)MASK; (void)WGU; (void)WD; (void)par; (void)rt_e; (void)rt_g; (void)rt_d; (void)cnt_g; (void)rstd_g; (void)blk_e; (void)nblk;

    if (EN(0) && IN(0)) { PHASE_ENV for (int rep = 0; rep < NREP(0); ++rep) prologue_phase(I, ws, lds, gw, NGW, lane, wave); }
    if (!(IN(0) && IN(1))) SEAM(0);
    {
        constexpr int l = 0;
        const int pb = 1 + 9 * l;
        if (EN(1) && IN(pb)) { PHASE_ENV
            if (l == 0) { for (int rep = 0; rep < NREP(1); ++rep) norm_phase<0>(I.x, XA, OUT, XN, I.norm_mix, Y, rt_d, rt_g, gw, NGW, lane); }
            else norm_phase<1>(I.x, XA, OUT, XN, I.norm_mix + DM, Y, rt_d, rt_g, gw, NGW, lane);
        }
        SEAM(pb);
        if (EN(2) && IN(pb + 1)) { PHASE_ENV
            pg8::Gemm g{XN, (const bf16*)(ws + WS_WIN) + (size_t)l * ZP * 1024, 1024, 1024}; pg8::StaticOrder S; S.init(M, ZP, G, (int)blockIdx.x); S.rep = NREP(2);
            pg8::EpiZ E{Z, (bf16*)(ws + WS_KIDX)};
            pg8::gemm_phase<pg8::EpiZ, pg8::StaticOrder, true, true>(lds, g, S, E, tid);
        }
        SEAM(pb + 1);
        if (EN(3) && IN(pb + 2)) { PHASE_ENV
            for (int rep = 0; rep < NREP(3); ++rep) {
            if (!((REPMASK >> 12) & 1) || rep == 0) for (int u = gw; u < 2048; u += NGW) mla_prep_unit(Z, (const bf16*)(ws + WS_WUQ) + (size_t)l * 192 * 256, (const bf16*)(ws + WS_WUKV) + (size_t)l * 384 * 128,
                                                               (const float*)(ws + WS_PAR + PAR_COS), (const float*)(ws + WS_PAR + PAR_SIN), MLA, u, lane);
            for (int i = blockIdx.x * NTHR + tid; i < NB * 256 * 4; i += G * NTHR) { const int b = i >> 10, t = (i >> 2) & 255, j = i & 3; MASK[((size_t)b * SEQ + t) * 64 + j] = ~0ull; }
            { const bf16* KX = (const bf16*)(ws + WS_KIDX); DsaOps cur_, nxt_;
              const int R0 = 9 * G <= 3840 ? 9 : 3840 / G, NST = R0 * G;
              gu32* dctr = ctl + CW_QCTR + 64 * (l + 2 * rep) + 32;
              volatile LAS int* dslot = (volatile LAS int*)(lds + MISC_OFF + 128);
              int it = blockIdx.x, r_ = 0;
              if (R0 == 0) { if (tid == 0) *dslot = (int)__hip_atomic_fetch_add(dctr, 1u, RLX_AGENT); __syncthreads(); it = *dslot; __syncthreads(); }
              if (it < 3840) dsa_load_ops(Z, KX, it, wave, lane, cur_);
              while (it < 3840) {
                  int nx;
                  if (++r_ < R0) nx = it + G;
                  else { if (tid == 0) *dslot = NST + (int)__hip_atomic_fetch_add(dctr, 1u, RLX_AGENT); __syncthreads(); nx = *dslot; }
                  dsa_load_ops(Z, KX, nx < 3840 ? nx : it, wave, lane, nxt_); dsa_select_item(Z, KX, MASK, lds, cur_, it, tid); cur_ = nxt_; it = nx; } }
            }
        }
        SEAM(pb + 2);
        if (EN(4) && IN(pb + 3)) { PHASE_ENV for (int rep = 0; rep < NREP(4); ++rep) attn_phase(Z, MLA, XN, MASK, (unsigned*)(ws + WS_O0), par, I.diff_subln, l, ctl + CW_QCTR + 64 * (l + 2 * rep),
                I.w_gate + (size_t)l * NEXP * 1024 * 512, I.w_up + (size_t)l * NEXP * 1024 * 512, I.w_down + (size_t)l * NEXP * 512 * 1024, WGU, WD, lds, tid); }
        SEAM(pb + 3);
        if (EN(5) && IN(pb + 4)) { PHASE_ENV
            pg8::Gemm g{XN, (const bf16*)(ws + WS_WOUT) + (size_t)l * 1024 * 1024, 1024, 1024}; pg8::StaticOrder S; S.init(M, DM, G, (int)blockIdx.x); S.rep = NREP(5);
            pg8::EpiRes<(l != 0)> E{l == 0 ? (const void*)I.x : (const void*)XA, XA, I.norm_ffn + l * DM, ws + WS_XT};
            pg8::gemm_phase<pg8::EpiRes<(l != 0)>, pg8::StaticOrder, true, true>(lds, g, S, E, tid);
        }
        SEAM(pb + 4);
        if (EN(6) && IN(pb + 5)) { PHASE_ENV for (int rep = 0; rep < NREP(6); ++rep) for (int u = blockIdx.x; u < 256; u += G)
            router_unit(XA, (const bf16*)(ws + WS_WR) + (size_t)l * 2 * 64 * 1024, I.b_group + l * 4, I.b_expert + l * 32, rt_e, rt_g, rstd_g, cnt_g, lds, u, tid); }
        SEAM(pb + 5);
        if (EN(7) && IN(pb + 6)) { PHASE_ENV for (int rep = 0; rep < NREP(7); ++rep) for (int u = blockIdx.x; u < 256; u += G) sort_unit(rt_e, rt_d, rstd_g, cnt_g, blk_e, nblk, (int*)(ws + WS_SRC), (float*)(ws + WS_RS), lds, u, tid); }
        SEAM(pb + 6);
        if (EN(8) && IN(pb + 7)) { PHASE_ENV
            pg8::Gemm g{ws + WS_XT, WGU, 1024, 1024}; pg8::MoeOrder S{blk_e, *nblk * 4, G, (int)blockIdx.x, NREP(8), (const int*)(ws + WS_SRC)};
            pg8::EpiGU E{H, (const float*)(ws + WS_RS)};
            pg8::gemm_phase<pg8::EpiGU, pg8::MoeOrder, true, true, 1, true>(lds, g, S, E, tid);
        }
        SEAM(pb + 7);
        if (EN(9) && IN(pb + 8)) { PHASE_ENV
            pg8::Gemm g{H, WD, 512, 512}; pg8::MoeOrder S{blk_e, *nblk * 4, G, (int)blockIdx.x, NREP(9)};
            pg8::EpiF8A E{Y, DM, 16.f / 256.f};
            pg8::gemm_phase<pg8::EpiF8A, pg8::MoeOrder, true, true, 1, false, true>(lds, g, S, E, tid);
        }
        SEAM(pb + 8);
    }
    {
        constexpr int l = 1;
        const int pb = 1 + 9 * l;
        if (EN(1) && IN(pb)) { PHASE_ENV
            if (l == 0) { for (int rep = 0; rep < NREP(1); ++rep) norm_phase<0>(I.x, XA, OUT, XN, I.norm_mix, Y, rt_d, rt_g, gw, NGW, lane); }
            else norm_phase<1>(I.x, XA, OUT, XN, I.norm_mix + DM, Y, rt_d, rt_g, gw, NGW, lane);
        }
        SEAM(pb);
        if (EN(2) && IN(pb + 1)) { PHASE_ENV
            pg8::Gemm g{XN, (const bf16*)(ws + WS_WIN) + (size_t)l * ZP * 1024, 1024, 1024}; pg8::StaticOrder S; S.init(M, ZP, G, (int)blockIdx.x); S.rep = NREP(2);
            pg8::EpiZ E{Z, (bf16*)(ws + WS_KIDX)};
            pg8::gemm_phase<pg8::EpiZ, pg8::StaticOrder, true, true>(lds, g, S, E, tid);
        }
        SEAM(pb + 1);
        if (EN(3) && IN(pb + 2)) { PHASE_ENV
            for (int rep = 0; rep < NREP(3); ++rep) {
            if (!((REPMASK >> 12) & 1) || rep == 0) for (int u = gw; u < 2048; u += NGW) mla_prep_unit(Z, (const bf16*)(ws + WS_WUQ) + (size_t)l * 192 * 256, (const bf16*)(ws + WS_WUKV) + (size_t)l * 384 * 128,
                                                               (const float*)(ws + WS_PAR + PAR_COS), (const float*)(ws + WS_PAR + PAR_SIN), MLA, u, lane);
            for (int i = blockIdx.x * NTHR + tid; i < NB * 256 * 4; i += G * NTHR) { const int b = i >> 10, t = (i >> 2) & 255, j = i & 3; MASK[((size_t)b * SEQ + t) * 64 + j] = ~0ull; }
            { const bf16* KX = (const bf16*)(ws + WS_KIDX); DsaOps cur_, nxt_;
              const int R0 = 9 * G <= 3840 ? 9 : 3840 / G, NST = R0 * G;
              gu32* dctr = ctl + CW_QCTR + 64 * (l + 2 * rep) + 32;
              volatile LAS int* dslot = (volatile LAS int*)(lds + MISC_OFF + 128);
              int it = blockIdx.x, r_ = 0;
              if (R0 == 0) { if (tid == 0) *dslot = (int)__hip_atomic_fetch_add(dctr, 1u, RLX_AGENT); __syncthreads(); it = *dslot; __syncthreads(); }
              if (it < 3840) dsa_load_ops(Z, KX, it, wave, lane, cur_);
              while (it < 3840) {
                  int nx;
                  if (++r_ < R0) nx = it + G;
                  else { if (tid == 0) *dslot = NST + (int)__hip_atomic_fetch_add(dctr, 1u, RLX_AGENT); __syncthreads(); nx = *dslot; }
                  dsa_load_ops(Z, KX, nx < 3840 ? nx : it, wave, lane, nxt_); dsa_select_item(Z, KX, MASK, lds, cur_, it, tid); cur_ = nxt_; it = nx; } }
            }
        }
        SEAM(pb + 2);
        if (EN(4) && IN(pb + 3)) { PHASE_ENV for (int rep = 0; rep < NREP(4); ++rep) attn_phase(Z, MLA, XN, MASK, (unsigned*)(ws + WS_O0), par, I.diff_subln, l, ctl + CW_QCTR + 64 * (l + 2 * rep),
                I.w_gate + (size_t)l * NEXP * 1024 * 512, I.w_up + (size_t)l * NEXP * 1024 * 512, I.w_down + (size_t)l * NEXP * 512 * 1024, WGU, WD, lds, tid); }
        SEAM(pb + 3);
        if (EN(5) && IN(pb + 4)) { PHASE_ENV
            pg8::Gemm g{XN, (const bf16*)(ws + WS_WOUT) + (size_t)l * 1024 * 1024, 1024, 1024}; pg8::StaticOrder S; S.init(M, DM, G, (int)blockIdx.x); S.rep = NREP(5);
            pg8::EpiRes<(l != 0)> E{l == 0 ? (const void*)I.x : (const void*)XA, XA, I.norm_ffn + l * DM, ws + WS_XT};
            pg8::gemm_phase<pg8::EpiRes<(l != 0)>, pg8::StaticOrder, true, true>(lds, g, S, E, tid);
        }
        SEAM(pb + 4);
        if (EN(6) && IN(pb + 5)) { PHASE_ENV for (int rep = 0; rep < NREP(6); ++rep) for (int u = blockIdx.x; u < 256; u += G)
            router_unit(XA, (const bf16*)(ws + WS_WR) + (size_t)l * 2 * 64 * 1024, I.b_group + l * 4, I.b_expert + l * 32, rt_e, rt_g, rstd_g, cnt_g, lds, u, tid); }
        SEAM(pb + 5);
        if (EN(7) && IN(pb + 6)) { PHASE_ENV for (int rep = 0; rep < NREP(7); ++rep) for (int u = blockIdx.x; u < 256; u += G) sort_unit(rt_e, rt_d, rstd_g, cnt_g, blk_e, nblk, (int*)(ws + WS_SRC), (float*)(ws + WS_RS), lds, u, tid); }
        SEAM(pb + 6);
        if (EN(8) && IN(pb + 7)) { PHASE_ENV
            pg8::Gemm g{ws + WS_XT, WGU, 1024, 1024}; pg8::MoeOrder S{blk_e, *nblk * 4, G, (int)blockIdx.x, NREP(8), (const int*)(ws + WS_SRC)};
            pg8::EpiGU E{H, (const float*)(ws + WS_RS)};
            pg8::gemm_phase<pg8::EpiGU, pg8::MoeOrder, true, true, 1, true>(lds, g, S, E, tid);
        }
        SEAM(pb + 7);
        if (EN(9) && IN(pb + 8)) { PHASE_ENV
            pg8::Gemm g{H, WD, 512, 512}; pg8::MoeOrder S{blk_e, *nblk * 4, G, (int)blockIdx.x, NREP(9)};
            pg8::EpiF8A E{Y, DM, 16.f / 256.f};
            pg8::gemm_phase<pg8::EpiF8A, pg8::MoeOrder, true, true, 1, false, true>(lds, g, S, E, tid);
        }
        SEAM(pb + 8);
    }
    if (EN(10) && IN(19)) { PHASE_ENV norm_phase<2>(I.x, XA, OUT, XN, I.norm_final, Y, rt_d, rt_g, gw, NGW, lane); }
#undef IN
#undef SEAM
}

#ifndef MK_SPLIT
#define MK_SPLIT 0
#endif
extern "C" void kernel_launch(void* const* d_in, const int* in_sizes, int n_in, void* d_out, int out_size, void* d_ws, size_t ws_size, hipStream_t stream) {
    static int grid = 0;
    if (grid == 0) {
        if (n_in != 23 || out_size != M * DM || ws_size < WS_END) { fprintf(stderr, "kernel_launch: unexpected shapes (n_in %d out %d ws %zu)\n", n_in, out_size, ws_size); grid = -1; return; }
        int dev = 0, cus = 0, per_cu = 0;
        if (hipGetDevice(&dev) != hipSuccess || hipDeviceGetAttribute(&cus, hipDeviceAttributeMultiprocessorCount, dev) != hipSuccess) { grid = -1; return; }
        if (hipFuncSetAttribute((const void*)fwd, hipFuncAttributeMaxDynamicSharedMemorySize, LDS_BYTES) != hipSuccess) { fprintf(stderr, "kernel_launch: hipFuncSetAttribute failed\n"); grid = -1; return; }
        if (hipOccupancyMaxActiveBlocksPerMultiprocessor(&per_cu, (const void*)fwd, NTHR, LDS_BYTES) != hipSuccess || per_cu < 1) { fprintf(stderr, "kernel_launch: occupancy query says %d\n", per_cu); }
        (void)hipGetLastError();
        grid = cus;
    }
    if (grid < 0) return;
    (void)hipMemsetAsync((char*)d_ws + WS_CTL, 0, CTL_ZERO_BYTES, stream);
    Args a{};
    const float** ip = (const float**)&a.in;
    for (int i = 0; i < 23; ++i) ip[i] = (const float*)d_in[i];
    a.out = (float*)d_out; a.ws = (unsigned char*)d_ws;
#if MK_SPLIT
    for (int p = 0; p < NPH; ++p) { a.ph_lo = p; a.ph_hi = p + 1; a.li = p; hipLaunchKernelGGL(fwd, dim3(grid), dim3(NTHR), LDS_BYTES, stream, a); }
#else
    a.ph_lo = 0; a.ph_hi = NPH; a.li = 0;
    hipLaunchKernelGGL(fwd, dim3(grid), dim3(NTHR), LDS_BYTES, stream, a);
#endif
}
```

```cpp
#include <hip/hip_runtime.h>
#include <cstdio>
#include <cstdint>

#define GAS __attribute__((address_space(1)))
#define LAS __attribute__((address_space(3)))
typedef unsigned short bf16;
typedef short bf16x8 __attribute__((ext_vector_type(8)));
typedef short s16x4 __attribute__((ext_vector_type(4)));
typedef float f32x2 __attribute__((ext_vector_type(2)));
typedef float f32x4 __attribute__((ext_vector_type(4)));
typedef float f32x16 __attribute__((ext_vector_type(16)));
typedef unsigned u32x2 __attribute__((ext_vector_type(2)));
typedef unsigned u32x4 __attribute__((ext_vector_type(4)));
typedef __bf16 bf16x2_t __attribute__((ext_vector_type(2)));
typedef short v4i16_t __attribute__((ext_vector_type(4)));
typedef GAS unsigned gu32;
#define RLX_AGENT __ATOMIC_RELAXED, __HIP_MEMORY_SCOPE_AGENT
#define DI __device__ __forceinline__

constexpr int NB = 8, SEQ = 4096, DM = 1024, M = NB * SEQ;
constexpr int DIN = 3000, ZP = 3072;
constexpr int Z_AQ = 0, Z_AK = 512, Z_AV = 1024, Z_BQ = 1536, Z_BK = 1792, Z_BV = 2048, Z_IQ = 2304, Z_IK = 2560, Z_IW = 2592, Z_CQ = 2600, Z_CKV = 2856, Z_CKR = 2984;
constexpr int NEXP = 32, DEXP = 512, MAXROWS = 2 * M + NEXP * 256;
constexpr int MLAP = 768;
constexpr float EPS = 1e-6f, LOG2E = 1.4426950408889634f;
constexpr int NWAVES = 8, NTHR = 512;

constexpr size_t MiB = 1u << 20;
constexpr size_t WS_CTL = 0, CTL_ZERO_BYTES = 1 * MiB;
constexpr size_t WS_PAR = 1 * MiB;
constexpr size_t WS_WIN = 2 * MiB;
constexpr size_t WS_WOUT = 14 * MiB;
constexpr size_t WS_WUQ = 18 * MiB;
constexpr size_t WS_WUKV = WS_WUQ + 256 * 1024;
constexpr size_t WS_WR = WS_WUQ + 512 * 1024;
constexpr size_t WS_ROUTE = 19 * MiB;
constexpr size_t WS_WGU = 20 * MiB;
constexpr size_t WS_WD = 84 * MiB;
constexpr size_t WS_XA = 116 * MiB;
constexpr size_t WS_XN = 116 * MiB;
constexpr size_t WS_Z = 180 * MiB;
constexpr size_t WS_MLA = 372 * MiB;
constexpr size_t WS_MASK = 444 * MiB;
constexpr size_t WS_KIDX = 460 * MiB;
constexpr size_t WS_O0 = 462 * MiB;
constexpr size_t WS_XT = WS_Z + 128 * MiB;
constexpr size_t WS_SRC = WS_Z + 176 * MiB;
constexpr size_t WS_RS = WS_Z + 177 * MiB;
constexpr size_t WS_END = 478 * MiB;
constexpr size_t PAR_LAM = 0, PAR_LUT = 256, PAR_ORD = 8704, PAR_COS = 16384, PAR_SIN = 16384 + 131072;
constexpr size_t RT_E = 0, RT_G = 262144, RT_D = 524288, RT_CNT = 786432, RT_BLK = 786432 + 32768, RT_NBLK = 786432 + 36864, RT_RSTD = 786432 + 65536;
constexpr int CW_BAR = 4096;
constexpr int CW_QCTR = 200000;
constexpr int RING_BYTES = 131072, AUX_OFF = RING_BYTES, AUX_BYTES = 8192, MISC_OFF = AUX_OFF + AUX_BYTES, PARK_A = 81920, PARK_B = MISC_OFF + 256, ORD_OFF = PARK_B + 16384, LDS_BYTES = ORD_OFF + 6144;

DI float bf2f(bf16 v) { return __builtin_bit_cast(float, (unsigned)v << 16); }
DI unsigned cvtpk(float lo, float hi) { f32x2 v = {lo, hi}; bf16x2_t b = __builtin_convertvector(v, bf16x2_t); return __builtin_bit_cast(unsigned, b); }
DI bf16 f2bf(float f) { return (bf16)(cvtpk(f, 0.f) & 0xffffu); }
DI float wave_sum(float v) {
#pragma unroll
    for (int o = 1; o < 64; o <<= 1) v += __shfl_xor(v, o);
    return v;
}
DI float halfswap_max(float m) { auto rr = __builtin_amdgcn_permlane32_swap(__float_as_uint(m), __float_as_uint(m), false, false); return fmaxf(__uint_as_float(rr[0]), __uint_as_float(rr[1])); }
DI float halfswap_sum(float m) { auto rr = __builtin_amdgcn_permlane32_swap(__float_as_uint(m), __float_as_uint(m), false, false); return __uint_as_float(rr[0]) + __uint_as_float(rr[1]); }
#define MFMA32(a, b, c) __builtin_amdgcn_mfma_f32_32x32x16_bf16((a), (b), (c), 0, 0, 0)
namespace pg8 {
#define PG8_LAS __attribute__((address_space(3)))
typedef unsigned short bf16_t;
constexpr int BM = 256, BK = 64, HALF = 128, HTB = HALF * BK * 2  , STAGE_BYTES = 8 * HTB, NXCD = 8, WGM = 8;

__host__ __device__ __forceinline__ int lds_byte(int r, int c) { const int st = (r >> 4) * 2 + (c >> 5), rr = r & 15, cc = c & 31, ob = rr * 64 + cc * 2; return st * 1024 + (ob ^ (((ob >> 9) & 1) << 5)); }
__host__ __device__ __forceinline__ void stage_rc(int b, int& R, int& C) { const int st = b / 1024, sb = b % 1024, swz = sb ^ (((sb >> 9) & 1) << 5); R = (st >> 1) * 16 + swz / 64; C = (st & 1) * 32 + (swz % 64) / 2; }
__host__ __device__ __forceinline__ int perm32(int rho) { const int n = rho >> 4, i = rho & 15; return 8 * (i >> 2) + 4 * n + (i & 3); }

struct Unit { int pm, pn, pb; };
struct Gemm { const void* A; const void* Bt; int lda, K; };

struct StaticOrder {
    static constexpr const int* src = nullptr;
    int nM, nN, nwg, G, c, rep = 1;
    __host__ __device__ void init(int M_, int N_, int G_, int c_) { nM = M_ / BM; nN = N_ / BM; nwg = nM * nN; G = G_; c = c_; }
    __host__ __device__ bool next(int i, Unit& u) const {
        if (rep > 1) { const int cntU = c < nwg ? (nwg - c + G - 1) / G : 0; if (i >= cntU * rep) return false; i %= cntU; }
        const long L = (long)i * G + c; if (L >= nwg) return false;
        int wgid = (int)L; { const int q = nwg / NXCD, r = nwg % NXCD, xcd = wgid % NXCD, off = wgid / NXCD; wgid = (xcd < r ? xcd * (q + 1) : r * (q + 1) + (xcd - r) * q) + off; }
        const int nig = WGM * nN, gid = wgid / nig, fm = gid * WGM, gsz = (nM - fm) < WGM ? (nM - fm) : WGM;
        u.pm = fm + ((wgid % nig) % gsz); u.pn = (wgid % nig) / gsz; u.pb = u.pn; return true;
    }
    __device__ __forceinline__ void a_ready(const Unit&) const {}
    __device__ __forceinline__ void done(const Unit&) const {}
};
struct MoeOrder {
    const int* blk_e; int nunits, G, c, rep = 1; const int* src = nullptr;
    __device__ __forceinline__ bool next(int i, Unit& u) const {
        if (rep > 1) { const int cntU = c < nunits ? (nunits - c + G - 1) / G : 0; if (i >= cntU * rep) return false; i %= cntU; }
        int pm, pn;
        if ((G & 31) == 0) { const int x = c & 7, j = c >> 3, rpx = G >> 5; pm = i * (G >> 2) + x * rpx + (j >> 2); pn = j & 3; }
        else { const int L = i * G + c; pm = L >> 2; pn = L & 3; }
        if (pm * 4 >= nunits) return false;
        u.pm = pm; u.pn = pn; u.pb = blk_e[pm] * 4 + pn; return true;
    }
    __device__ __forceinline__ void a_ready(const Unit&) const {}
    __device__ __forceinline__ void done(const Unit&) const {}
};

struct EpiBf16 {
    static constexpr bool PERM = true, AFTER_DRAIN = false;
    bf16_t* O; int ldc; float scale = 1.f;
    __device__ __forceinline__ void operator()(const f32x4 (&acc)[2][2][4][2], const Unit& u, int wr, int wc, int fr, int fq) const {
        const int row0 = u.pm * BM + wr * 64 + fr, col0 = u.pn * BM + wc * 32 + 8 * fq;
#pragma unroll
        for (int ai = 0; ai < 2; ++ai)
#pragma unroll
            for (int m = 0; m < 4; ++m) { bf16_t* rowp = O + (size_t)(row0 + ai * HALF + m * 16) * ldc + col0;
#pragma unroll
                for (int bj = 0; bj < 2; ++bj) { const f32x4 v0 = acc[ai][bj][m][0] * scale, v1 = acc[ai][bj][m][1] * scale;
                    u32x4 w; w.x = cvtpk(v0[0], v0[1]); w.y = cvtpk(v0[2], v0[3]); w.z = cvtpk(v1[0], v1[1]); w.w = cvtpk(v1[2], v1[3]);
                    *(u32x4*)(rowp + bj * HALF) = w; } }
    }
};
struct EpiF8 {
    static constexpr bool PERM = true, AFTER_DRAIN = false;
    unsigned char* O; int ldc; float scale;
    __device__ __forceinline__ void operator()(const f32x4 (&acc)[2][2][4][2], const Unit& u, int wr, int wc, int fr, int fq) const {
        const int row0 = u.pm * BM + wr * 64 + fr, col0 = u.pn * BM + wc * 32 + 8 * fq;
#pragma unroll
        for (int ai = 0; ai < 2; ++ai)
#pragma unroll
            for (int m = 0; m < 4; ++m) { unsigned char* rowp = O + (size_t)(row0 + ai * HALF + m * 16) * ldc + col0;
#pragma unroll
                for (int bj = 0; bj < 2; ++bj) { float h[8];
#pragma unroll
                    for (int n = 0; n < 2; ++n)
#pragma unroll
                        for (int e = 0; e < 4; ++e) h[4 * n + e] = __builtin_amdgcn_fmed3f(acc[ai][bj][m][n][e] * scale, -448.f, 448.f);
                    int w0 = 0, w1 = 0;
                    w0 = __builtin_amdgcn_cvt_pk_fp8_f32(h[0], h[1], w0, false); w0 = __builtin_amdgcn_cvt_pk_fp8_f32(h[2], h[3], w0, true);
                    w1 = __builtin_amdgcn_cvt_pk_fp8_f32(h[4], h[5], w1, false); w1 = __builtin_amdgcn_cvt_pk_fp8_f32(h[6], h[7], w1, true);
                    u32x2 w; w.x = (unsigned)w0; w.y = (unsigned)w1; *(u32x2*)(rowp + bj * HALF) = w; } }
    }
};
struct EpiF8A {
    static constexpr bool PERM = true, AFTER_DRAIN = false;
    unsigned char* O; int ldc; float scale;
    __device__ __forceinline__ void operator()(const f32x4 (&acc)[2][2][4][2], const Unit& u, int wr, int wc, int fr, int fq) const {
        const int row0 = u.pm * BM + wr * 64 + fr, col0 = u.pn * BM + wc * 64 + 16 * fq;
#pragma unroll
        for (int ai = 0; ai < 2; ++ai)
#pragma unroll
            for (int m = 0; m < 4; ++m) { unsigned char* rowp = O + (size_t)(row0 + ai * HALF + m * 16) * ldc + col0; u32x4 w;
#pragma unroll
                for (int bj = 0; bj < 2; ++bj) { float h[8];
#pragma unroll
                    for (int n = 0; n < 2; ++n)
#pragma unroll
                        for (int e = 0; e < 4; ++e) h[4 * n + e] = __builtin_amdgcn_fmed3f(acc[ai][bj][m][n][e] * scale, -448.f, 448.f);
                    int w0 = 0, w1 = 0;
                    w0 = __builtin_amdgcn_cvt_pk_fp8_f32(h[0], h[1], w0, false); w0 = __builtin_amdgcn_cvt_pk_fp8_f32(h[2], h[3], w0, true);
                    w1 = __builtin_amdgcn_cvt_pk_fp8_f32(h[4], h[5], w1, false); w1 = __builtin_amdgcn_cvt_pk_fp8_f32(h[6], h[7], w1, true);
                    w[2 * bj] = (unsigned)w0; w[2 * bj + 1] = (unsigned)w1; }
                *(u32x4*)rowp = w; }
    }
};
struct EpiZ {
    static constexpr bool PERM = true, AFTER_DRAIN = false;
    bf16_t* O; bf16_t* KIDX;
    __device__ __forceinline__ void operator()(const f32x4 (&acc)[2][2][4][2], const Unit& u, int wr, int wc, int fr, int fq) const {
        const int row0 = u.pm * BM + wr * 64 + fr, col0 = u.pn * BM + wc * 32 + 8 * fq;
        const bool kx = (u.pn == 10) && (wc == 0);
#pragma unroll
        for (int ai = 0; ai < 2; ++ai)
#pragma unroll
            for (int m = 0; m < 4; ++m) { const int row = row0 + ai * HALF + m * 16; bf16_t* rowp = O + (size_t)row * 3072 + col0;
#pragma unroll
                for (int bj = 0; bj < 2; ++bj) { const f32x4 v0 = acc[ai][bj][m][0], v1 = acc[ai][bj][m][1];
                    u32x4 w; w.x = cvtpk(v0[0], v0[1]); w.y = cvtpk(v0[2], v0[3]); w.z = cvtpk(v1[0], v1[1]); w.w = cvtpk(v1[2], v1[3]);
                    *(u32x4*)(rowp + bj * HALF) = w;
                    if (bj == 0 && kx) *(u32x4*)(KIDX + (size_t)row * 32 + 8 * fq) = w; } }
    }
};
template <bool BASE16>
struct EpiRes {
    static constexpr bool PERM = true, AFTER_DRAIN = false;
    const void* base; bf16_t* out; const float* gain; unsigned char* XT;
    __device__ __forceinline__ void operator()(const f32x4 (&acc)[2][2][4][2], const Unit& u, int wr, int wc, int fr, int fq) const {
        const int row0 = u.pm * BM + wr * 64 + fr, col0 = u.pn * BM + wc * 32 + 8 * fq;
        f32x4 gn[2][2];
#pragma unroll
        for (int bj = 0; bj < 2; ++bj) { gn[bj][0] = *(const f32x4*)(gain + col0 + bj * HALF); gn[bj][1] = *(const f32x4*)(gain + col0 + bj * HALF + 4); }
#pragma unroll
        for (int ai = 0; ai < 2; ++ai)
#pragma unroll
            for (int m = 0; m < 4; ++m) { const size_t off = (size_t)(row0 + ai * HALF + m * 16) * 1024 + col0;
#pragma unroll
                for (int bj = 0; bj < 2; ++bj) { f32x4 b0, b1;
                    if constexpr (BASE16) { const u32x4 bw = *(const u32x4*)((const bf16_t*)base + off + bj * HALF);
                        b0 = (f32x4){__uint_as_float(bw.x << 16), __uint_as_float(bw.x & 0xffff0000u), __uint_as_float(bw.y << 16), __uint_as_float(bw.y & 0xffff0000u)};
                        b1 = (f32x4){__uint_as_float(bw.z << 16), __uint_as_float(bw.z & 0xffff0000u), __uint_as_float(bw.w << 16), __uint_as_float(bw.w & 0xffff0000u)}; }
                    else { b0 = *(const f32x4*)((const float*)base + off + bj * HALF); b1 = *(const f32x4*)((const float*)base + off + bj * HALF + 4); }
                    const f32x4 o0 = b0 + acc[ai][bj][m][0], o1 = b1 + acc[ai][bj][m][1];
                    { u32x4 ow; ow.x = cvtpk(o0[0], o0[1]); ow.y = cvtpk(o0[2], o0[3]); ow.z = cvtpk(o1[0], o1[1]); ow.w = cvtpk(o1[2], o1[3]); *(u32x4*)(out + off + bj * HALF) = ow; }
                    const f32x4 t0 = o0 * gn[bj][0], t1 = o1 * gn[bj][1]; int w0 = 0, w1 = 0;
                    w0 = __builtin_amdgcn_cvt_pk_fp8_f32(t0[0], t0[1], w0, false); w0 = __builtin_amdgcn_cvt_pk_fp8_f32(t0[2], t0[3], w0, true);
                    w1 = __builtin_amdgcn_cvt_pk_fp8_f32(t1[0], t1[1], w1, false); w1 = __builtin_amdgcn_cvt_pk_fp8_f32(t1[2], t1[3], w1, true);
                    u32x2 w8; w8.x = (unsigned)w0; w8.y = (unsigned)w1; *(u32x2*)(XT + off + bj * HALF) = w8; } }
    }
};
struct EpiGU {
    static constexpr bool PERM = true, AFTER_DRAIN = false;
    unsigned char* H; const float* RS;
    __device__ __forceinline__ void operator()(const f32x4 (&acc)[2][2][4][2], const Unit& u, int wr, int wc, int fr, int fq) const {
        const int row0 = u.pm * BM + wr * 64 + fr, col0 = u.pn * HALF + wc * 32 + 8 * fq;
        float rs[2][4];
#pragma unroll
        for (int ai = 0; ai < 2; ++ai)
#pragma unroll
            for (int m = 0; m < 4; ++m) rs[ai][m] = RS[row0 + ai * HALF + m * 16] * 0.03125f;
#pragma unroll
        for (int ai = 0; ai < 2; ++ai)
#pragma unroll
            for (int m = 0; m < 4; ++m) { unsigned char* rowp = H + (size_t)(row0 + ai * HALF + m * 16) * 512 + col0;
                float h[8];
#pragma unroll
                for (int n = 0; n < 2; ++n)
#pragma unroll
                    for (int e = 0; e < 4; ++e) { const float g = acc[ai][0][m][n][e] * rs[ai][m], up = acc[ai][1][m][n][e] * rs[ai][m];
                        const float hv = 8.f * g * __builtin_amdgcn_rcpf(1.f + __builtin_amdgcn_exp2f(-g * 1.4426950408889634f)) * up;
                        h[4 * n + e] = __builtin_amdgcn_fmed3f(hv, -448.f, 448.f); }
                int w0 = 0, w1 = 0;
                w0 = __builtin_amdgcn_cvt_pk_fp8_f32(h[0], h[1], w0, false); w0 = __builtin_amdgcn_cvt_pk_fp8_f32(h[2], h[3], w0, true);
                w1 = __builtin_amdgcn_cvt_pk_fp8_f32(h[4], h[5], w1, false); w1 = __builtin_amdgcn_cvt_pk_fp8_f32(h[6], h[7], w1, true);
                u32x2 w; w.x = (unsigned)w0; w.y = (unsigned)w1; *(u32x2*)rowp = w; }
    }
};

template <class Epi, class Sched, bool ALIGN_EPI = false, bool SP2 = false, int ESZ = 2  ,
          bool GATHER = false  ,
          bool BADJ = false  >
__device__ __forceinline__ void gemm_phase(PG8_LAS unsigned char* lds, const Gemm g, const Sched& S, const Epi& E, const int tid) {
    const int wid = __builtin_amdgcn_readfirstlane(tid >> 6), lane = tid & 63, wr = wid >> 2, wc = wid & 3, fr = lane & 15, fq = lane >> 4;
    const int K = g.K, nt = K * ESZ / (BK * 2);
    unsigned voffA[2], voffB[2], colA[2]; int rowA[2];
#pragma unroll
    for (int i = 0; i < 2; ++i) { int R, C; stage_rc(tid * 16 + i * 8192, R, C); const int c32_ = perm32(R & 31);
        const int Rb = BADJ ? (64 * (R >> 5) + 16 * (c32_ >> 3) + (c32_ & 7)) : (Epi::PERM ? ((R & ~31) + c32_) : R);
        voffA[i] = (unsigned)(R * g.lda * ESZ + C * 2); voffB[i] = (unsigned)(Rb * K * ESZ + C * 2); rowA[i] = R; colA[i] = (unsigned)(C * 2); }
    unsigned vgc[2][2], vgn[2][2];
#define PG8_SRC(u, vg) do { _Pragma("unroll") for (int h_ = 0; h_ < 2; ++h_) _Pragma("unroll") for (int i_ = 0; i_ < 2; ++i_) \
        vg[h_][i_] = (unsigned)S.src[(u).pm * BM + h_ * HALF + rowA[i_]] * (unsigned)(g.lda * ESZ) + colA[i_]; } while (0)
#define PG8_STAGE_A(bufoff, gbase, h, VG) do { if constexpr (GATHER) PG8_STAGE(bufoff, gbase, VG[h]); else PG8_STAGE(bufoff, (gbase) + (h) * hstepA, voffA); } while (0)
    const size_t kstep = (size_t)(BK * 2);
    const size_t hstepA = (size_t)HALF * g.lda * ESZ, hstepB = (size_t)(BADJ ? 8 : HALF) * K * ESZ;
    const size_t tstepA = 2 * hstepA, tstepB = (size_t)BM * K * ESZ;
    const unsigned ldsw = (unsigned)wid * 1024u;
    const int aoff = lds_byte(wr * 64 + fr, fq * 8), boff = lds_byte(wc * 32 + fr, fq * 8);
#define PG8_SA(b, h) (((b) * 2 + (h)) * HTB)
#define PG8_SB(b, h) ((4 + (b) * 2 + (h)) * HTB)
#define PG8_STAGE(bufoff, gbase, voff) do { _Pragma("unroll") for (int _i = 0; _i < 2; ++_i) \
        __builtin_amdgcn_global_load_lds((const unsigned*)((const char*)(gbase) + (voff)[_i]), (PG8_LAS unsigned*)(lds + (bufoff) + ldsw + _i * 8192), 16, 0, 0); } while (0)
#define PG8_LDA(dst, b, h) do { _Pragma("unroll") for (int m = 0; m < 4; ++m) { if constexpr (ESZ == 2) { _Pragma("unroll") for (int k = 0; k < 2; ++k) dst[m][k] = *(const PG8_LAS bf16x8*)(lds + PG8_SA(b, h) + aoff + m * 2048 + k * 1024); } \
        else { const u32x4 lo_ = *(const PG8_LAS u32x4*)(lds + PG8_SA(b, h) + aoff + m * 2048), hi_ = *(const PG8_LAS u32x4*)(lds + PG8_SA(b, h) + aoff + m * 2048 + 1024); dst##8[m] = __builtin_shufflevector(lo_, hi_, 0, 1, 2, 3, 4, 5, 6, 7); } } } while (0)
#define PG8_LDB(dst, b, h) do { _Pragma("unroll") for (int n = 0; n < 2; ++n) { if constexpr (ESZ == 2) { _Pragma("unroll") for (int k = 0; k < 2; ++k) dst[n][k] = *(const PG8_LAS bf16x8*)(lds + PG8_SB(b, h) + boff + n * 2048 + k * 1024); } \
        else { const u32x4 lo_ = *(const PG8_LAS u32x4*)(lds + PG8_SB(b, h) + boff + n * 2048), hi_ = *(const PG8_LAS u32x4*)(lds + PG8_SB(b, h) + boff + n * 2048 + 1024); dst##8[n] = __builtin_shufflevector(lo_, hi_, 0, 1, 2, 3, 4, 5, 6, 7); } } } while (0)
#define PG8_MMA(ai, bj, At, Bt) do { __builtin_amdgcn_s_setprio(1); _Pragma("unroll") for (int m = 0; m < 4; ++m) _Pragma("unroll") for (int n = 0; n < 2; ++n) { \
        if constexpr (ESZ == 2) { _Pragma("unroll") for (int k = 0; k < 2; ++k) acc[ai][bj][m][n] = __builtin_amdgcn_mfma_f32_16x16x32_bf16(Bt[n][k], At[m][k], acc[ai][bj][m][n], 0, 0, 0); } \
        else acc[ai][bj][m][n] = __builtin_amdgcn_mfma_scale_f32_16x16x128_f8f6f4(__builtin_bit_cast(v8i_t, Bt##8[n]), __builtin_bit_cast(v8i_t, At##8[m]), acc[ai][bj][m][n], 0, 0, 0, 0, 0, 0); } \
        __builtin_amdgcn_s_setprio(0); if constexpr (ESZ == 1) { _Pragma("unroll") for (int m = 0; m < 4; ++m) _Pragma("unroll") for (int n = 0; n < 2; ++n) asm volatile("" : "+v"(acc[ai][bj][m][n])); } } while (0)
#define PG8_WAIT_V(n) asm volatile("s_waitcnt vmcnt(" #n ")" ::: "memory")
#define PG8_WAIT_L(n) asm volatile("s_waitcnt lgkmcnt(" #n ")" ::: "memory")
#define PG8_BAR __builtin_amdgcn_s_barrier()
#define PG8_SCHED __builtin_amdgcn_sched_barrier(0)
    Unit cur, nxt; int ui = 0;
    if (!S.next(0, cur)) return;
    f32x4 acc[2][2][4][2];
#pragma unroll
    for (int a = 0; a < 2; ++a)
#pragma unroll
        for (int b = 0; b < 2; ++b)
#pragma unroll
            for (int m = 0; m < 4; ++m)
#pragma unroll
                for (int n = 0; n < 2; ++n) acc[a][b][m][n] = (f32x4){0.f, 0.f, 0.f, 0.f};
    typedef int v8i_t __attribute__((ext_vector_type(8))); typedef unsigned u32x8_t __attribute__((ext_vector_type(8)));
    bf16x8 At[4][2], B0[2][2], B1[2][2]; u32x8_t At8[4], B08[2], B18[2];
    const char* cA = (const char*)g.A + (GATHER ? (size_t)0 : (size_t)cur.pm * tstepA); const char* cB = (const char*)g.Bt + (size_t)cur.pb * tstepB;
    if constexpr (GATHER) PG8_SRC(cur, vgc);
    S.a_ready(cur);
    if constexpr (SP2) {
        PG8_STAGE(PG8_SB(0, 0), cB, voffB); PG8_STAGE(PG8_SB(0, 1), cB + hstepB, voffB); PG8_STAGE_A(PG8_SA(0, 0), cA, 0, vgc); PG8_STAGE_A(PG8_SA(0, 1), cA, 1, vgc);
        if (wr == 1) PG8_BAR;
        PG8_WAIT_V(2); PG8_BAR;
        PG8_STAGE(PG8_SB(1, 0), cB + kstep, voffB); PG8_STAGE_A(PG8_SA(1, 0), cA + kstep, 0, vgc); PG8_STAGE(PG8_SB(1, 1), cB + hstepB + kstep, voffB);
        PG8_WAIT_V(6); PG8_BAR;
    } else {
        PG8_STAGE(PG8_SB(0, 0), cB, voffB); PG8_STAGE(PG8_SA(0, 0), cA, voffA); PG8_STAGE(PG8_SB(0, 1), cB + hstepB, voffB); PG8_STAGE(PG8_SA(0, 1), cA + hstepA, voffA);
        if (wr == 1) PG8_BAR;
        PG8_WAIT_V(4); PG8_BAR;
        PG8_STAGE(PG8_SB(1, 0), cB + kstep, voffB); PG8_STAGE(PG8_SA(1, 0), cA + kstep, voffA); PG8_STAGE(PG8_SB(1, 1), cB + hstepB + kstep, voffB);
        PG8_WAIT_V(6); PG8_BAR;
    }
    for (;;) {
        const bool has_next = S.next(ui + 1, nxt);
        const char* nA = (has_next && !GATHER) ? (const char*)g.A + (size_t)nxt.pm * tstepA : cA; const char* nB = has_next ? (const char*)g.Bt + (size_t)nxt.pb * tstepB : cB;
        if constexpr (GATHER) { static_assert(!GATHER || SP2, "GATHER is wired into the SP2 loop only"); if (has_next) PG8_SRC(nxt, vgn); else { _Pragma("unroll") for (int h_ = 0; h_ < 2; ++h_) _Pragma("unroll") for (int i_ = 0; i_ < 2; ++i_) vgn[h_][i_] = vgc[h_][i_]; } }
#pragma unroll 1
        for (int t = 0; t < nt; t += 2) {
            const bool last = (t == nt - 2);
            const char* a1 = cA + (size_t)(t + 1) * kstep;
            const char* a2 = last ? nA : cA + (size_t)(t + 2) * kstep; const char* b2 = last ? nB : cB + (size_t)(t + 2) * kstep;
            const char* a3 = a2 + kstep; const char* b3 = b2 + kstep;
            if (last && has_next) S.a_ready(nxt);
            unsigned vg2[2][2];
            if constexpr (GATHER) { _Pragma("unroll") for (int h_ = 0; h_ < 2; ++h_) _Pragma("unroll") for (int i_ = 0; i_ < 2; ++i_) vg2[h_][i_] = last ? vgn[h_][i_] : vgc[h_][i_]; }
            if constexpr (SP2) {
            PG8_LDB(B0, 0, 0); PG8_LDB(B1, 0, 1); PG8_SCHED; PG8_LDA(At, 0, 0); PG8_STAGE_A(PG8_SA(1, 1), a1, 1, vgc);
            PG8_WAIT_V(8); PG8_WAIT_L(0); PG8_BAR; PG8_MMA(0, 0, At, B0); PG8_MMA(0, 1, At, B1); PG8_BAR; PG8_SCHED;
            PG8_LDA(At, 0, 1); PG8_STAGE(PG8_SB(0, 0), b2, voffB); PG8_STAGE(PG8_SB(0, 1), b2 + hstepB, voffB); PG8_STAGE_A(PG8_SA(0, 0), a2, 0, vg2);
            PG8_WAIT_V(8); PG8_WAIT_L(0); PG8_BAR; PG8_MMA(1, 0, At, B0); PG8_MMA(1, 1, At, B1); PG8_BAR; PG8_SCHED;
            PG8_LDB(B0, 1, 0); PG8_LDB(B1, 1, 1); PG8_SCHED; PG8_LDA(At, 1, 0); PG8_STAGE_A(PG8_SA(0, 1), a2, 1, vg2);
            PG8_WAIT_V(8); PG8_WAIT_L(0); PG8_BAR; PG8_MMA(0, 0, At, B0); PG8_MMA(0, 1, At, B1); PG8_BAR; PG8_SCHED;
            PG8_LDA(At, 1, 1); PG8_STAGE(PG8_SB(1, 0), b3, voffB); PG8_STAGE(PG8_SB(1, 1), b3 + hstepB, voffB); PG8_STAGE_A(PG8_SA(1, 0), a3, 0, vg2);
            PG8_WAIT_V(8); PG8_WAIT_L(0); PG8_BAR; PG8_MMA(1, 0, At, B0); PG8_MMA(1, 1, At, B1); PG8_BAR; PG8_SCHED;
            } else {
            PG8_LDB(B0, 0, 0); PG8_SCHED; PG8_LDA(At, 0, 0); PG8_STAGE(PG8_SA(1, 1), a1 + hstepA, voffA);
            PG8_WAIT_L(8); PG8_BAR; PG8_WAIT_L(0); PG8_MMA(0, 0, At, B0); PG8_BAR; PG8_SCHED;
            PG8_LDB(B1, 0, 1); PG8_STAGE(PG8_SB(0, 0), b2, voffB);
            PG8_BAR; PG8_WAIT_L(0); PG8_MMA(0, 1, At, B1); PG8_BAR;
            PG8_LDA(At, 0, 1); PG8_STAGE(PG8_SA(0, 0), a2, voffA);
            PG8_BAR; PG8_WAIT_L(0); PG8_MMA(1, 0, At, B0); PG8_BAR; PG8_SCHED;
            PG8_STAGE(PG8_SB(0, 1), b2 + hstepB, voffB);
            PG8_WAIT_V(6); PG8_BAR; PG8_MMA(1, 1, At, B1); PG8_BAR;
            PG8_LDB(B0, 1, 0); PG8_SCHED; PG8_LDA(At, 1, 0); PG8_STAGE(PG8_SA(0, 1), a2 + hstepA, voffA);
            PG8_WAIT_L(8); PG8_BAR; PG8_WAIT_L(0); PG8_MMA(0, 0, At, B0); PG8_BAR; PG8_SCHED;
            PG8_LDB(B1, 1, 1); PG8_STAGE(PG8_SB(1, 0), b3, voffB);
            PG8_BAR; PG8_WAIT_L(0); PG8_MMA(0, 1, At, B1); PG8_BAR;
            PG8_LDA(At, 1, 1); PG8_STAGE(PG8_SA(1, 0), a3, voffA);
            PG8_BAR; PG8_WAIT_L(0); PG8_MMA(1, 0, At, B0); PG8_BAR; PG8_SCHED;
            PG8_STAGE(PG8_SB(1, 1), b3 + hstepB, voffB);
            PG8_WAIT_V(6); PG8_BAR; PG8_MMA(1, 1, At, B1); PG8_BAR;
            }
        }
        if constexpr (ALIGN_EPI) { if (wr == 0) PG8_BAR; }
        if constexpr (!Epi::AFTER_DRAIN) { E(acc, cur, wr, wc, fr, fq); S.done(cur); }
        if (!has_next) break;
#pragma unroll
        for (int a = 0; a < 2; ++a)
#pragma unroll
            for (int b = 0; b < 2; ++b)
#pragma unroll
                for (int m = 0; m < 4; ++m)
#pragma unroll
                    for (int n = 0; n < 2; ++n) acc[a][b][m][n] = (f32x4){0.f, 0.f, 0.f, 0.f};
        cur = nxt; cA = nA; cB = nB; ++ui;
        if constexpr (GATHER) { _Pragma("unroll") for (int h_ = 0; h_ < 2; ++h_) _Pragma("unroll") for (int i_ = 0; i_ < 2; ++i_) vgc[h_][i_] = vgn[h_][i_]; }
        if constexpr (ALIGN_EPI) { if (wr == 1) PG8_BAR; }
    }
    PG8_WAIT_V(0);
    if constexpr (!ALIGN_EPI) { if (wr == 0) PG8_BAR; }
    PG8_BAR;
    if constexpr (Epi::AFTER_DRAIN) { E.fused(acc, cur, wr, wc, fr, fq, lds, wid, lane); S.done(cur); }
#undef PG8_SA
#undef PG8_SB
#undef PG8_STAGE
#undef PG8_STAGE_A
#undef PG8_SRC
#undef PG8_LDA
#undef PG8_LDB
#undef PG8_MMA
#undef PG8_WAIT_V
#undef PG8_WAIT_L
#undef PG8_BAR
#undef PG8_SCHED
}
}

#define XB_TMO      128
#define XB_XCNT(j)  (256  + 64 * (j))
#define XB_XSUB(j)  (1280 + 64 * (j))
#define XB_XGEN(j)  (2304 + 64 * (j))
#define XB_TOP      3328
#define XB_TOPGEN   3392
#define XCD_BAR_WORDS 3456
#define XB_SPIN_CAP (1u << 18)

__device__ __forceinline__ unsigned xb_ld(unsigned* p)              { return __hip_atomic_load(p, __ATOMIC_RELAXED, __HIP_MEMORY_SCOPE_AGENT); }
__device__ __forceinline__ unsigned xb_add(unsigned* p, unsigned v) { return __hip_atomic_fetch_add(p, v, __ATOMIC_RELAXED, __HIP_MEMORY_SCOPE_AGENT); }
__device__ __forceinline__ unsigned xb_xcc_id() { return (unsigned)__builtin_amdgcn_s_getreg((3 << 11) | 20) & 0xFu; }
#define XB_SPIN(cond, bar) do { unsigned _sp = 0; while (cond) { __builtin_amdgcn_s_sleep(1); \
    if ((++_sp & 255u) == 0u) { if (xb_ld(&(bar)[XB_TMO])) break; if (_sp > XB_SPIN_CAP) { atomicAdd(&(bar)[XB_TMO], 1u); break; } } } } while (0)

struct XcdBarrier {
    unsigned* bar; unsigned x;
    volatile LAS unsigned* st;
};

__device__ __forceinline__ XcdBarrier xcd_barrier_post(unsigned* bar, volatile LAS unsigned* st) {
    XcdBarrier b; b.bar = bar; b.x = xb_xcc_id(); b.st = st;
    if (threadIdx.x == 0) (void)xb_add(&bar[XB_XCNT(b.x)], 1u);
    return b;
}
__device__ __forceinline__ void xcd_barrier_complete(unsigned* bar, unsigned x, unsigned& nloc, unsigned& nx) {
    const unsigned G = gridDim.x * gridDim.y * gridDim.z;
    unsigned sum, cnt, mine, sp = 0u;
    for (;;) {
        sum = 0u; cnt = 0u; mine = 0u;
#pragma unroll
        for (unsigned j = 0; j < 16; ++j) { const unsigned c = xb_ld(&bar[XB_XCNT(j)]); sum += c; cnt += (c > 0u) ? 1u : 0u; mine = (j == x) ? c : mine; }
        if (sum == G) break;
        __builtin_amdgcn_s_sleep(1);
        if ((++sp & 255u) == 0u) { if (xb_ld(&bar[XB_TMO])) break; if (sp > XB_SPIN_CAP) { atomicAdd(&bar[XB_TMO], 1u); break; } }
    }
    nloc = mine > 0u ? mine : 1u; nx = cnt > 0u ? cnt : 1u;
}

__device__ __forceinline__ void xcd_barrier(const XcdBarrier& b) {
    asm volatile("s_waitcnt vmcnt(0)" ::: "memory");
    __syncthreads();
    if (threadIdx.x == 0) {
        unsigned* bar = b.bar;
        __builtin_amdgcn_s_waitcnt(0);
        unsigned nloc = b.st[0], nx = b.st[1];
        if (nloc == 0u) { xcd_barrier_complete(bar, b.x, nloc, nx); b.st[0] = nloc; b.st[1] = nx; }
        const unsigned old = xb_add(&bar[XB_XSUB(b.x)], 1u);
        const unsigned gen = old / nloc;
        if (old + 1u == (gen + 1u) * nloc) {
            __builtin_amdgcn_fence(__ATOMIC_RELEASE, "agent");
            asm volatile("s_waitcnt vmcnt(0)" ::: "memory");
            const unsigned og = xb_add(&bar[XB_TOP], 1u);
            const unsigned tg = og / nx;
            if (og + 1u == (tg + 1u) * nx) xb_add(&bar[XB_TOPGEN], 1u);
            else XB_SPIN(xb_ld(&bar[XB_TOPGEN]) == tg, bar);
            __builtin_amdgcn_fence(__ATOMIC_ACQUIRE, "agent");
            xb_add(&bar[XB_XGEN(b.x)], 1u);
            asm volatile("s_waitcnt vmcnt(0)" ::: "memory");
        } else {
            XB_SPIN(xb_ld(&bar[XB_XGEN(b.x)]) == gen, bar);
            __builtin_amdgcn_fence(__ATOMIC_ACQUIRE, "agent");
            asm volatile("s_waitcnt vmcnt(0)" ::: "memory");
        }
    }
    __syncthreads();
}

template <class Fetch, class Dst>
DI void tr_item(LAS float* scr, int k0, int n0, int lane, const Fetch& fetch, const Dst& dst) {
#pragma unroll 8
    for (int i = 0; i < 32; ++i) { const int kk = 2 * i + (lane >> 5); scr[kk * 33 + (lane & 31)] = fetch(k0 + kk, n0 + (lane & 31)); }
    asm volatile("s_waitcnt lgkmcnt(0)" ::: "memory");
    const int c = lane & 7;
#pragma unroll
    for (int j = 0; j < 4; ++j) { const int n = (lane >> 3) + 8 * j; const LAS float* s = scr + (8 * c) * 33 + n;
        u32x4 o; o.x = cvtpk(s[0], s[33]); o.y = cvtpk(s[66], s[99]); o.z = cvtpk(s[132], s[165]); o.w = cvtpk(s[198], s[231]);
        *(u32x4*)(dst(n0 + n) + k0 + 8 * c) = o; }
    asm volatile("s_waitcnt lgkmcnt(0)" ::: "memory");
}

DI int t5_bucket(int rel) {
    const int n = rel < 0 ? -rel : rel; const int ret = rel > 0 ? 16 : 0;
    int v;
    if (n < 8) v = n; else if (n < 12) v = 8; else if (n < 16) v = 9; else if (n < 23) v = 10; else if (n < 32) v = 11; else if (n < 46) v = 12; else if (n < 64) v = 13; else if (n < 91) v = 14; else v = 15;
    return ret + v;
}

struct MoeItem { const float* src; unsigned char* dst; int ns, kd; };
DI MoeItem moe_item_of(const float* w_gate, const float* w_up, const float* w_down, unsigned char* WGU, unsigned char* WD, int it) {
    constexpr int I_GU = NEXP * 16 * 16 * 2;
    MoeItem m;
    if (it < I_GU) { const int up = it & 1, r = it >> 1, nb = r & 15, kb = (r >> 4) & 15, e = r >> 8; const int n0 = nb * 32;
        m.src = (up ? w_up : w_gate) + (size_t)e * 1024 * 512 + (size_t)(kb * 64) * 512 + n0; m.ns = 512; m.kd = 1024;
        m.dst = WGU + (size_t)e * 1024 * 1024 + (size_t)((up ? 128 : 0) + ((n0 >> 7) << 8) + (n0 & 127)) * 1024 + kb * 64;
    } else { const int r = it - I_GU, nb = r & 31, kb = (r >> 5) & 7, e = r >> 8;
        m.src = w_down + (size_t)e * 512 * 1024 + (size_t)(kb * 64) * 1024 + nb * 32; m.ns = 1024; m.kd = 512;
        m.dst = WD + (size_t)e * 1024 * 512 + (size_t)(nb * 32) * 512 + kb * 64; }
    return m;
}
DI void moe_item_load(const MoeItem& m, f32x4 (&r)[8], int lane) {
#pragma unroll
    for (int i = 0; i < 8; ++i) r[i] = __builtin_nontemporal_load((const f32x4*)(m.src + (size_t)(8 * i + (lane >> 3)) * m.ns + 4 * (lane & 7)));
}
DI void moe_item_store(const MoeItem& m, const f32x4 (&r)[8], LAS float* scr, int lane) {
#pragma unroll
    for (int i = 0; i < 8; ++i) { LAS float* p = scr + (8 * i + (lane >> 3)) * 33 + 4 * (lane & 7); p[0] = r[i][0]; p[1] = r[i][1]; p[2] = r[i][2]; p[3] = r[i][3]; }
    asm volatile("s_waitcnt lgkmcnt(0)" ::: "memory");
    const int c = lane & 3;
#pragma unroll
    for (int j = 0; j < 2; ++j) { const int n = (lane >> 2) + 16 * j; const LAS float* s = scr + (16 * c) * 33 + n;
        u32x4 o;
#pragma unroll
        for (int q = 0; q < 4; ++q) { int w = 0;
            w = __builtin_amdgcn_cvt_pk_fp8_f32(s[(4 * q) * 33] * 32.f, s[(4 * q + 1) * 33] * 32.f, w, false);
            w = __builtin_amdgcn_cvt_pk_fp8_f32(s[(4 * q + 2) * 33] * 32.f, s[(4 * q + 3) * 33] * 32.f, w, true); o[q] = (unsigned)w; }
        *(u32x4*)(m.dst + (size_t)n * m.kd + 16 * c) = o; }
    asm volatile("s_waitcnt lgkmcnt(0)" ::: "memory");
}
template <int NI>
DI void moe_convert_items(const float* w_gate, const float* w_up, const float* w_down, unsigned char* WGU, unsigned char* WD, LAS float* scr, int it0, int lane) {
    f32x4 ra[NI][8]; MoeItem ma[NI];
#pragma unroll
    for (int i = 0; i < NI; ++i) { ma[i] = moe_item_of(w_gate, w_up, w_down, WGU, WD, it0 + i); moe_item_load(ma[i], ra[i], lane); }
#pragma unroll
    for (int i = 0; i < NI; ++i) moe_item_store(ma[i], ra[i], scr, lane);
}
constexpr int MOE_CONV_ITEMS = NEXP * 16 * 16 * 2 + NEXP * 8 * 32;

struct In {
    const float *x, *w_in, *w_out, *norm_mix, *norm_ffn, *rel_bias, *lam_q1, *lam_k1, *lam_q2, *lam_k2, *diff_subln, *mla_q_norm, *mla_kv_norm, *w_uq, *w_ukv,
                *w_group, *b_group, *w_expert, *b_expert, *w_gate, *w_up, *w_down, *norm_final;
};

DI void prologue_phase(const In& I, unsigned char* ws, LAS unsigned char* lds, int gw, int NGW, int lane, int wave) {
    LAS float* scr = (LAS float*)(lds + wave * 16384);
    bf16* WinT = (bf16*)(ws + WS_WIN); bf16* WoT = (bf16*)(ws + WS_WOUT); bf16* WuqT = (bf16*)(ws + WS_WUQ); bf16* WukvT = (bf16*)(ws + WS_WUKV); bf16* WR = (bf16*)(ws + WS_WR);
    constexpr int I1 = 2 * 16 * 96, I2 = 2 * 16 * 32, I3 = 2 * 4 * 6, I4 = 2 * 2 * 12, I5 = 2 * 2 * 16 * 2;
    for (int it = gw; it < I1 + I2 + I3 + I4 + I5; it += NGW) {
        int r = it;
        if (r < I1) { const int l = r / 1536, q = r % 1536, kb = q / 96, nb = q % 96; const float* W = I.w_in + (size_t)l * 1024 * DIN; bf16* D = WinT + (size_t)l * ZP * 1024;
            tr_item(scr, kb * 64, nb * 32, lane, [=](int k, int n) { if (n >= DIN) return 0.f; float s = 1.f; if (n < 512 || (n >= Z_BQ && n < Z_BK)) s = 0.125f * LOG2E; else if (n >= Z_IW && n < Z_CQ) s = 0.0625f; return W[(size_t)k * DIN + n] * s; },
                    [=](int n) { return D + (size_t)n * 1024; }); continue; }
        r -= I1;
        if (r < I2) { const int l = r / 512, q = r % 512, kb = q / 32, nb = q % 32; const float* W = I.w_out + (size_t)l * 1024 * 1024; bf16* D = WoT + (size_t)l * 1024 * 1024;
            tr_item(scr, kb * 64, nb * 32, lane, [=](int k, int n) { return W[(size_t)k * 1024 + n]; }, [=](int n) { return D + (size_t)n * 1024; }); continue; }
        r -= I2;
        if (r < I3) { const int l = r / 24, q = r % 24, kb = q / 6, nb = q % 6; const float* W = I.w_uq + (size_t)l * 256 * 192; const float* g = I.mla_q_norm + l * 256; bf16* D = WuqT + (size_t)l * 192 * 256;
            const float qs = 0.14433756729740643f * LOG2E;
            tr_item(scr, kb * 64, nb * 32, lane, [=](int k, int n) { const int o = n < 128 ? (n >> 5) * 48 + (n & 31) : ((n - 128) >> 4) * 48 + 32 + ((n - 128) & 15); return W[(size_t)k * 192 + o] * g[k] * qs; },
                    [=](int n) { return D + (size_t)n * 256; }); continue; }
        r -= I3;
        if (r < I4) { const int l = r / 24, q = r % 24, kb = q / 12, nb = q % 12; const float* W = I.w_ukv + (size_t)l * 128 * 384; const float* g = I.mla_kv_norm + l * 128; bf16* D = WukvT + (size_t)l * 384 * 128;
            tr_item(scr, kb * 64, nb * 32, lane, [=](int k, int n) { const int o = n < 128 ? (n >> 5) * 96 + (n & 31) : ((n - 128) >> 6) * 96 + 32 + ((n - 128) & 63); return W[(size_t)k * 384 + o] * g[k]; },
                    [=](int n) { return D + (size_t)n * 128; }); continue; }
        r -= I4;
        { const int lo = r & 1, q = r >> 1, nb = q & 1, kb = (q >> 1) & 15, l = q >> 5; const float* We = I.w_expert + (size_t)l * 1024 * 32; const float* Wg = I.w_group + (size_t)l * 1024 * 4; const float* gf = I.norm_ffn + (size_t)l * DM;
          bf16* D = WR + ((size_t)(l * 2 + lo) * 64) * 1024;
          tr_item(scr, kb * 64, nb * 32, lane, [=](int k, int n) { float w = (n < 32 ? We[(size_t)k * 32 + n] : (n < 36 ? Wg[(size_t)k * 4 + (n - 32)] : 0.f)) * gf[k]; if (lo) w = w - bf2f(f2bf(w)); return w; },
                  [=](int n) { return D + (size_t)n * 1024; }); }
    }
    float* par = (float*)(ws + WS_PAR);
    const int gt = gw * 64 + lane, NGT = NGW * 64;
    for (int i = gt; i < SEQ * 8; i += NGT) { const int t = i >> 3, f = i & 7; const float inv = powf(10000.f, -(float)(2 * f) / 16.f); const float ang = (float)t * inv;
        ((float*)(ws + WS_PAR + PAR_COS))[i] = cosf(ang); ((float*)(ws + WS_PAR + PAR_SIN))[i] = sinf(ang); }
    for (int i = gt; i < 8 * 256; i += NGT) { const int hh = i >> 8, rel = (i & 255) - 192; ((float*)(ws + WS_PAR + PAR_LUT))[i] = I.rel_bias[t5_bucket(rel) * 8 + hh] * LOG2E; }
    if (gw == 2 && lane == 0) {
        unsigned* ord = (unsigned*)(ws + WS_PAR + PAR_ORD); int n = 0;
        for (int c = 32; c >= 1; --c) {
            if (c % 2 == 0 && c / 2 - 1 <= 15) for (int bh = 0; bh < 32; ++bh) ord[n++] = (0u << 16) | ((unsigned)(c / 2 - 1) << 8) | (unsigned)bh;
            if (c <= 16) for (int ty = 1; ty < 3; ++ty) for (int bh = 0; bh < 32; ++bh) ord[n++] = ((unsigned)ty << 16) | ((unsigned)(c - 1) << 8) | (unsigned)bh; }
    }
    if (gw < 2) { const int l = gw; const float a = wave_sum(I.lam_q1[l * 64 + lane] * I.lam_k1[l * 64 + lane]), b = wave_sum(I.lam_q2[l * 64 + lane] * I.lam_k2[l * 64 + lane]);
        const float li = 0.8f - 0.6f * expf(-0.3f * (float)l); if (lane == 0) { par[l] = expf(a) - expf(b) + li; par[2 + l] = 1.f - li; } }
}

template <int MODE>
DI void norm_phase(const float* src, bf16* XA, float* OUT, bf16* XN, const float* gain, const unsigned char* Y  , const int* rt_d, const float* rt_g, int gw, int NGW, int lane) {
    f32x4 g4[4];
#pragma unroll
    for (int j = 0; j < 4; ++j) g4[j] = *(const f32x4*)(gain + 4 * lane + 256 * j);
    for (int m = gw; m < M; m += NGW) {
        f32x4 v[4];
        if (MODE == 0) {
#pragma unroll
            for (int j = 0; j < 4; ++j) v[j] = *(const f32x4*)(src + (size_t)m * DM + 4 * lane + 256 * j);
        } else {
#pragma unroll
            for (int j = 0; j < 4; ++j) { const u32x2 w = *(const u32x2*)(XA + (size_t)m * DM + 4 * lane + 256 * j);
                v[j] = (f32x4){__uint_as_float(w.x << 16), __uint_as_float(w.x & 0xffff0000u), __uint_as_float(w.y << 16), __uint_as_float(w.y & 0xffff0000u)}; }
        }
        if (MODE != 0) {
            const int d0 = rt_d[2 * m], d1 = rt_d[2 * m + 1]; const float w0 = rt_g[2 * m] * 0.0625f, w1 = rt_g[2 * m + 1] * 0.0625f;
            const unsigned char* y0 = Y + (size_t)d0 * DM, * y1 = Y + (size_t)d1 * DM;
#pragma unroll
            for (int j = 0; j < 4; ++j) { const int a = *(const int*)(y0 + 4 * lane + 256 * j), b = *(const int*)(y1 + 4 * lane + 256 * j);
                const f32x2 a01 = __builtin_amdgcn_cvt_pk_f32_fp8(a, false), a23 = __builtin_amdgcn_cvt_pk_f32_fp8(a, true), b01 = __builtin_amdgcn_cvt_pk_f32_fp8(b, false), b23 = __builtin_amdgcn_cvt_pk_f32_fp8(b, true);
                v[j][0] += w0 * a01[0] + w1 * b01[0]; v[j][1] += w0 * a01[1] + w1 * b01[1]; v[j][2] += w0 * a23[0] + w1 * b23[0]; v[j][3] += w0 * a23[1] + w1 * b23[1]; }
        }
        float ss = 0.f;
#pragma unroll
        for (int j = 0; j < 4; ++j) ss += (v[j][0] * v[j][0] + v[j][1] * v[j][1]) + (v[j][2] * v[j][2] + v[j][3] * v[j][3]);
        const float rstd = rsqrtf(wave_sum(ss) * (1.f / DM) + EPS);
        if (MODE == 1) {
#pragma unroll
            for (int j = 0; j < 4; ++j) { u32x2 w; w.x = cvtpk(v[j][0], v[j][1]); w.y = cvtpk(v[j][2], v[j][3]); *(u32x2*)(XA + (size_t)m * DM + 4 * lane + 256 * j) = w; }
        }
        if (MODE == 2) {
#pragma unroll
            for (int j = 0; j < 4; ++j) *(f32x4*)(OUT + (size_t)m * DM + 4 * lane + 256 * j) = v[j] * rstd * g4[j];
        } else {
#pragma unroll
            for (int j = 0; j < 4; ++j) { const f32x4 o = v[j] * rstd * g4[j]; u32x2 w; w.x = cvtpk(o[0], o[1]); w.y = cvtpk(o[2], o[3]); *(u32x2*)(XN + (size_t)m * DM + 4 * lane + 256 * j) = w; }
        }
    }
}

DI void st4(bf16* p, float a, float b, float c, float d) { u32x2 w; w.x = cvtpk(a, b); w.y = cvtpk(c, d); *(u32x2*)p = w; }
DI void mla_prep_unit(const bf16* Z, const bf16* WuqT, const bf16* WukvT, const float* cosT, const float* sinT, bf16* MLA, int unit, int lane) {
    const int slice = unit >> 1, part = unit & 1, r32 = lane & 31, hi = lane >> 5;
    const int row = slice * 32 + r32, t = row & (SEQ - 1);
    const bf16* zr = Z + (size_t)row * ZP; bf16* orow = MLA + (size_t)row * MLAP;
    const f32x4 cs = *(const f32x4*)(cosT + t * 8 + 4 * hi), sn = *(const f32x4*)(sinT + t * 8 + 4 * hi);
    const u32x4 zero4 = {0u, 0u, 0u, 0u};
    if (part == 0) {
        bf16x8 bq[16]; float ss = 0.f;
#pragma unroll
        for (int s = 0; s < 16; ++s) { bq[s] = *(const bf16x8*)(zr + Z_CQ + 16 * s + 8 * hi);
#pragma unroll
            for (int j = 0; j < 8; ++j) { const float f = bf2f((bf16)bq[s][j]); ss += f * f; } }
        const float rstd = rsqrtf(halfswap_sum(ss) * (1.f / 256.f) + EPS);
        auto epi_q = [&](const int nb, const f32x16& acc) __attribute__((always_inline)) {
            if (nb < 4) {
#pragma unroll
                for (int g = 0; g < 4; ++g) st4(orow + nb * 64 + 8 * g + 4 * hi, acc[4 * g] * rstd, acc[4 * g + 1] * rstd, acc[4 * g + 2] * rstd, acc[4 * g + 3] * rstd);
            } else {
#pragma unroll
                for (int hb = 0; hb < 2; ++hb) { const int head = 2 * (nb - 4) + hb; float o1[4], o2[4];
#pragma unroll
                    for (int j = 0; j < 4; ++j) { const float x1 = acc[8 * hb + j] * rstd, x2 = acc[8 * hb + 4 + j] * rstd; o1[j] = x1 * cs[j] - x2 * sn[j]; o2[j] = x1 * sn[j] + x2 * cs[j]; }
                    st4(orow + head * 64 + 32 + 4 * hi, o1[0], o1[1], o1[2], o1[3]); st4(orow + head * 64 + 40 + 4 * hi, o2[0], o2[1], o2[2], o2[3]);
                    *(u32x4*)(orow + head * 64 + 48 + 8 * hi) = zero4; }
            }
        };
        bf16x8 wA[16], wB[16];
#define MLA_WLOAD(W, nbx) do { const bf16* wp_ = WuqT + (size_t)((nbx) * 32 + r32) * 256 + 8 * hi; _Pragma("unroll") for (int s = 0; s < 16; ++s) W[s] = *(const bf16x8*)(wp_ + 16 * s); } while (0)
        MLA_WLOAD(wA, 0);
#pragma unroll 1
        for (int nb = 0; nb < 6; nb += 2) {
            MLA_WLOAD(wB, nb + 1);
            { f32x16 acc = {};
#pragma unroll
              for (int s = 0; s < 16; ++s) acc = MFMA32(wA[s], bq[s], acc);
              epi_q(nb, acc); }
            MLA_WLOAD(wA, nb + 2 < 6 ? nb + 2 : 5);
            { f32x16 acc = {};
#pragma unroll
              for (int s = 0; s < 16; ++s) acc = MFMA32(wB[s], bq[s], acc);
              epi_q(nb + 1, acc); }
        }
#undef MLA_WLOAD
    } else {
        bf16x8 bk[8]; float ss = 0.f;
#pragma unroll
        for (int s = 0; s < 8; ++s) { bk[s] = *(const bf16x8*)(zr + Z_CKV + 16 * s + 8 * hi);
#pragma unroll
            for (int j = 0; j < 8; ++j) { const float f = bf2f((bf16)bk[s][j]); ss += f * f; } }
        const float rstd = rsqrtf(halfswap_sum(ss) * (1.f / 128.f) + EPS);
        auto epi_kv = [&](const int nb, const f32x16& acc) __attribute__((always_inline)) {
            bf16* o = nb < 4 ? orow + 256 + nb * 64 : orow + 512 + ((nb - 4) >> 1) * 64 + ((nb - 4) & 1) * 32;
#pragma unroll
            for (int g = 0; g < 4; ++g) st4(o + 8 * g + 4 * hi, acc[4 * g] * rstd, acc[4 * g + 1] * rstd, acc[4 * g + 2] * rstd, acc[4 * g + 3] * rstd);
        };
        bf16x8 wA[8], wB[8];
#define MLA_WLOAD(W, nbx) do { const bf16* wp_ = WukvT + (size_t)((nbx) * 32 + r32) * 128 + 8 * hi; _Pragma("unroll") for (int s = 0; s < 8; ++s) W[s] = *(const bf16x8*)(wp_ + 16 * s); } while (0)
        MLA_WLOAD(wA, 0);
#pragma unroll 1
        for (int nb = 0; nb < 12; nb += 2) {
            MLA_WLOAD(wB, nb + 1);
            { f32x16 acc = {};
#pragma unroll
              for (int s = 0; s < 8; ++s) acc = MFMA32(wA[s], bk[s], acc);
              epi_kv(nb, acc); }
            MLA_WLOAD(wA, nb + 2 < 12 ? nb + 2 : 11);
            { f32x16 acc = {};
#pragma unroll
              for (int s = 0; s < 8; ++s) acc = MFMA32(wB[s], bk[s], acc);
              epi_kv(nb + 1, acc); }
        }
#undef MLA_WLOAD
        const u32x2 a = *(const u32x2*)(zr + Z_CKR + 4 * hi), b = *(const u32x2*)(zr + Z_CKR + 8 + 4 * hi);
        const float x1[4] = {__uint_as_float(a.x << 16), __uint_as_float(a.x & 0xffff0000u), __uint_as_float(a.y << 16), __uint_as_float(a.y & 0xffff0000u)};
        const float x2[4] = {__uint_as_float(b.x << 16), __uint_as_float(b.x & 0xffff0000u), __uint_as_float(b.y << 16), __uint_as_float(b.y & 0xffff0000u)};
        float o1[4], o2[4];
#pragma unroll
        for (int j = 0; j < 4; ++j) { o1[j] = x1[j] * cs[j] - x2[j] * sn[j]; o2[j] = x1[j] * sn[j] + x2[j] * cs[j]; }
#pragma unroll
        for (int h = 0; h < 4; ++h) { st4(orow + 256 + h * 64 + 32 + 4 * hi, o1[0], o1[1], o1[2], o1[3]); st4(orow + 256 + h * 64 + 40 + 4 * hi, o2[0], o2[1], o2[2], o2[3]);
            *(u32x4*)(orow + 256 + h * 64 + 48 + 8 * hi) = zero4; }
    }
}

DI int wave_sum_i(int v) {
    v += __builtin_amdgcn_update_dpp(0, v, 0x111, 0xf, 0xf, false); v += __builtin_amdgcn_update_dpp(0, v, 0x112, 0xf, 0xf, false);
    v += __builtin_amdgcn_update_dpp(0, v, 0x114, 0xf, 0xf, false); v += __builtin_amdgcn_update_dpp(0, v, 0x118, 0xf, 0xf, false);
    return __builtin_amdgcn_readlane(v, 15) + __builtin_amdgcn_readlane(v, 31) + __builtin_amdgcn_readlane(v, 47) + __builtin_amdgcn_readlane(v, 63);
}
DI float wave_max_f(float f) {
    const int ninf = (int)0xff800000u; int v = __float_as_int(f);
#define WMX(ctrl) v = __float_as_int(fmaxf(__int_as_float(v), __int_as_float(__builtin_amdgcn_update_dpp(ninf, v, ctrl, 0xf, 0xf, false))))
    WMX(0x111); WMX(0x112); WMX(0x114); WMX(0x118);
#undef WMX
    return fmaxf(fmaxf(__int_as_float(__builtin_amdgcn_readlane(v, 15)), __int_as_float(__builtin_amdgcn_readlane(v, 31))), fmaxf(__int_as_float(__builtin_amdgcn_readlane(v, 47)), __int_as_float(__builtin_amdgcn_readlane(v, 63))));
}
DI float relu_i(float x) { const int i = __float_as_int(x); return __int_as_float(i > 0 ? i : 0); }
DI unsigned fkey(float f) { const unsigned u = __float_as_uint(f); return (u & 0x80000000u) ? ~u : (u | 0x80000000u); }

struct DsaOps { bf16x8 af[2][2]; bf16x8 w8[2][2]; bf16x8 cb[2][2]; };
DI void dsa_load_ops(const bf16* Z, const bf16* KIDX, int item, int wave, int lane, DsaOps& o) {
    const int r32 = lane & 31, hi = lane >> 5;
    const int c = 63 - (item >> 6), rem = item & 63, b = rem >> 3, sg = rem & 7;
    const int n = 64 * (c + 1), t0 = 64 * c + 8 * sg; const size_t rowbase = (size_t)b * SEQ;
    const int ql = ((r32 >> 4) & 1) * 2 + ((r32 >> 2) & 1), hh = ((r32 >> 3) & 1) * 4 + (r32 & 3);
#pragma unroll
    for (int rb = 0; rb < 2; ++rb) {
#pragma unroll
        for (int s = 0; s < 2; ++s) o.af[rb][s] = *(const bf16x8*)(Z + (rowbase + t0 + 4 * rb + ql) * ZP + Z_IQ + hh * 32 + 16 * s + 8 * hi);
#pragma unroll
        for (int q2 = 0; q2 < 2; ++q2) o.w8[rb][q2] = *(const bf16x8*)(Z + (rowbase + t0 + 4 * rb + 2 * q2 + hi) * ZP + Z_IW);
    }
    const int nkb = n >> 5;
    const bf16* kp0 = KIDX + (rowbase + r32) * 32 + 8 * hi;
#pragma unroll
    for (int u = 0; u < 2; ++u) { const int k2 = wave + 8 * u; const int kk = k2 < nkb ? k2 : wave; const bf16* kp = kp0 + (size_t)(32 * kk) * 32; o.cb[u][0] = *(const bf16x8*)kp; o.cb[u][1] = *(const bf16x8*)(kp + 16); }
}
DI void dsa_select_item(const bf16* Z, const bf16* KIDX, unsigned long long* MASK, LAS unsigned char* lds, const DsaOps& ops, int item, int tid) {
    const int lane = tid & 63, wave = __builtin_amdgcn_readfirstlane(tid >> 6), r32 = lane & 31, hi = lane >> 5;
    const int c = 63 - (item >> 6), rem = item & 63, b = rem >> 3, sg = rem & 7;
    const int n = 64 * (c + 1), t0 = 64 * c + 8 * sg; const size_t rowbase = (size_t)b * SEQ;
    LAS float* sc = (LAS float*)lds;
    bf16x8 af[2][2]; float wv[2][16];
#pragma unroll
    for (int rb = 0; rb < 2; ++rb) {
#pragma unroll
        for (int s = 0; s < 2; ++s) af[rb][s] = ops.af[rb][s];
#pragma unroll
        for (int q2 = 0; q2 < 2; ++q2) {
#pragma unroll
            for (int j = 0; j < 8; ++j) wv[rb][8 * q2 + j] = bf2f((bf16)ops.w8[rb][q2][j]); }
    }
    {
        const int nkb = n >> 5;
        const bf16* kp0 = KIDX + (rowbase + r32) * 32 + 8 * hi;
        bf16x8 cb[2][2], nb[2][2];
#pragma unroll
        for (int u = 0; u < 2; ++u) { cb[u][0] = ops.cb[u][0]; cb[u][1] = ops.cb[u][1]; }
        for (int kb = wave; kb < nkb; kb += 2 * NWAVES) {
#pragma unroll
            for (int u = 0; u < 2; ++u) { const int k2 = kb + 16 + 8 * u; const int kk = k2 < nkb ? k2 : wave; const bf16* kp = kp0 + (size_t)(32 * kk) * 32; nb[u][0] = *(const bf16x8*)kp; nb[u][1] = *(const bf16x8*)(kp + 16); }
#pragma unroll
            for (int u = 0; u < 2; ++u) if (kb + 8 * u < nkb) {
                const int key = 32 * (kb + 8 * u) + r32;
#pragma unroll
                for (int rb = 0; rb < 2; ++rb) {
                    f32x16 acc = {};
                    acc = MFMA32(af[rb][0], cb[u][0], acc); acc = MFMA32(af[rb][1], cb[u][1], acc);
                    float s0 = 0.f, s1 = 0.f;
#pragma unroll
                    for (int r = 0; r < 8; ++r) { s0 = fmaf(wv[rb][r], relu_i(acc[r]), s0); s1 = fmaf(wv[rb][8 + r], relu_i(acc[8 + r]), s1); }
                    sc[(4 * rb + hi) * n + key] = s0; sc[(4 * rb + 2 + hi) * n + key] = s1;
                }
            }
#pragma unroll
            for (int u = 0; u < 2; ++u) { cb[u][0] = nb[u][0]; cb[u][1] = nb[u][1]; }
        }
    }
    __syncthreads();
    {
        const int nreg = c + 1, ngrp = (nreg + 7) >> 3;
        float v[64];
#pragma unroll
        for (int g = 0; g < 8; ++g) {
#pragma unroll
            for (int jj = 0; jj < 8; ++jj) v[8 * g + jj] = -INFINITY;
            if (g < ngrp) {
#pragma unroll
                for (int jj = 0; jj < 8; ++jj) { const int j = 8 * g + jj; if (j < nreg) v[j] = sc[wave * n + 64 * j + lane]; } } }
        float mxl = v[0], mnl = fminf(fminf(v[0], v[1]), fminf(v[2], v[3]));
#pragma unroll
        for (int g = 0; g < 8; ++g) if (g < ngrp) {
#pragma unroll
            for (int jj = 0; jj < 8; ++jj) mxl = fmaxf(mxl, v[8 * g + jj]);
            if (8 * g + 8 <= nreg) {
#pragma unroll
                for (int jj = 0; jj < 8; ++jj) mnl = fminf(mnl, v[8 * g + jj]); } }
        const float mx = wave_max_f(mxl), mn = -wave_max_f(-mnl);
        unsigned T = 0u; bool haveT = false; int c_hi = 0, neq = -1;
        if (mx > mn) {
            const float scale = 126.5f / (mx - mn);
            unsigned w[16];
#pragma unroll
            for (int q = 0; q < 16; ++q) { unsigned x = 0x80808080u;
                if (q < 2 * ngrp) {
#pragma unroll
                    for (int k = 0; k < 4; ++k) { const unsigned cc = (unsigned)((v[4 * q + k] - mn) * scale); x |= cc << (8 * k); } }
                w[q] = x; }
            unsigned p = 0u;
#pragma unroll
            for (int bit = 6; bit >= 0; --bit) { const unsigned cand = p | (1u << bit), rep = cand * 0x01010101u; int cl = 0;
#pragma unroll
                for (int g = 0; g < 8; ++g) if (g < ngrp) { cl += __builtin_popcount((w[2 * g] - rep) & 0x80808080u); cl += __builtin_popcount((w[2 * g + 1] - rep) & 0x80808080u); }
                const int cnt = wave_sum_i(cl);
                if (cnt >= 256) p = cand; else c_hi = cnt; }
            LAS unsigned* cand_l = (LAS unsigned*)(lds + AUX_OFF + wave * 512);
            int off = 0;
#pragma unroll
            for (int g = 0; g < 8; ++g) if (g < ngrp) {
#pragma unroll
                for (int jj = 0; jj < 8; ++jj) { const int j = 8 * g + jj; const bool isc = ((w[j >> 2] >> (8 * (j & 3))) & 0xffu) == (p | 0x80u); const unsigned long long bal = __builtin_amdgcn_ballot_w64(isc);
                    if (bal) { const int pos = off + (int)__builtin_amdgcn_mbcnt_hi((unsigned)(bal >> 32), __builtin_amdgcn_mbcnt_lo((unsigned)bal, 0u));
                        if (isc && pos < 128) cand_l[pos] = fkey(v[j]);
                        off += __builtin_popcountll(bal); } } }
            const int need = 256 - c_hi;
            if (off <= 128) {
                const unsigned ck0 = lane < off ? cand_l[lane] : 0u, ck1 = lane + 64 < off ? cand_l[lane + 64] : 0u;
                unsigned prefix = 0u;
                for (int bit = 31; bit >= 0; --bit) { const unsigned cd = prefix | (1u << bit);
                    const int cnt = __builtin_popcountll(__builtin_amdgcn_ballot_w64(ck0 >= cd)) + __builtin_popcountll(__builtin_amdgcn_ballot_w64(ck1 >= cd));
                    if (cnt >= need) prefix = cd; }
                T = prefix; haveT = true;
                c_hi += __builtin_popcountll(__builtin_amdgcn_ballot_w64(ck0 > T)) + __builtin_popcountll(__builtin_amdgcn_ballot_w64(ck1 > T));
                neq = __builtin_popcountll(__builtin_amdgcn_ballot_w64(ck0 == T)) + __builtin_popcountll(__builtin_amdgcn_ballot_w64(ck1 == T));
            }
        }
        if (!haveT) {
            unsigned prefix = 0u;
            for (int bit = 31; bit >= 0; --bit) { const unsigned cd = prefix | (1u << bit); int cnt = 0;
#pragma unroll
                for (int g = 0; g < 8; ++g) if (g < ngrp) {
#pragma unroll
                    for (int jj = 0; jj < 8; ++jj) cnt += __builtin_popcountll(__builtin_amdgcn_ballot_w64(fkey(v[8 * g + jj]) >= cd)); }
                if (cnt >= 256) prefix = cd; }
            T = prefix; c_hi = 0;
#pragma unroll
            for (int g = 0; g < 8; ++g) if (g < ngrp) {
#pragma unroll
                for (int jj = 0; jj < 8; ++jj) c_hi += __builtin_popcountll(__builtin_amdgcn_ballot_w64(fkey(v[8 * g + jj]) > T)); }
        }
        int remn = 256 - c_hi; unsigned mlo = 0u, mhi = 0u;
        if (neq == remn) {
            const float Tf = __uint_as_float((T & 0x80000000u) ? (T & 0x7fffffffu) : ~T);
#pragma unroll
            for (int g = 0; g < 8; ++g) if (g < ngrp) {
#pragma unroll
                for (int jj = 0; jj < 8; ++jj) { const int j = 8 * g + jj; const unsigned long long ww = __builtin_amdgcn_ballot_w64(v[j] >= Tf); const unsigned wl = (unsigned)ww, wh2 = (unsigned)(ww >> 32);
                    asm volatile("s_nop 4\n\tv_writelane_b32 %0, %1, %2" : "+v"(mlo) : "s"(wl), "n"(j));
                    asm volatile("v_writelane_b32 %0, %1, %2" : "+v"(mhi) : "s"(wh2), "n"(j)); } }
        } else {
#pragma unroll
            for (int g = 0; g < 8; ++g) if (g < ngrp) {
#pragma unroll
                for (int jj = 0; jj < 8; ++jj) { const int j = 8 * g + jj;
                    const unsigned kj = fkey(v[j]);
                    const unsigned long long gt = __builtin_amdgcn_ballot_w64(kj > T); unsigned long long eq = __builtin_amdgcn_ballot_w64(kj == T);
                    if (eq) { const int ne = __builtin_popcountll(eq);
                        if (ne > remn) { unsigned long long tk = 0ull; for (int i = 0; i < remn; ++i) { const unsigned long long lb = eq & (0ull - eq); tk |= lb; eq ^= lb; } eq = tk; remn = 0; }
                        else remn -= ne; }
                    const unsigned long long ww = gt | eq; const unsigned wl = (unsigned)ww, wh2 = (unsigned)(ww >> 32);
                    asm volatile("s_nop 4\n\tv_writelane_b32 %0, %1, %2" : "+v"(mlo) : "s"(wl), "n"(j));
                    asm volatile("v_writelane_b32 %0, %1, %2" : "+v"(mhi) : "s"(wh2), "n"(j)); } }
        }
        if (lane < nreg) MASK[(rowbase + t0 + wave) * 64 + lane] = ((unsigned long long)mhi << 32) | mlo;
    }
    __syncthreads();
}

DI s16x4 vtr(const LAS unsigned char* p) { return __builtin_bit_cast(s16x4, __builtin_amdgcn_ds_read_tr16_b64_v4i16((LAS v4i16_t*)p)); }

template <int DV, bool BIAS, bool MASK, int KS = 4  >
DI void attn_pass(LAS unsigned char* lds, const bf16* Q, const bf16* K, const bf16* V, int pq, int pk, int pv, int q0, int nt, const unsigned long long* maskb, float cfar, f32x16 (&oT)[DV / 32], int tid) {
    constexpr int ND = DV / 32, NV = DV / 64;
    asm volatile("" : "+v"(tid));
    const int lane = tid & 63, wave = __builtin_amdgcn_readfirstlane(tid >> 6), r32 = lane & 31, hi = lane >> 5;
    const int qw0 = q0 + 32 * wave, mylimit = (qw0 >> 6) + 1;
    const LAS float* lut = (const LAS float*)(lds + AUX_OFF);
    float m_ref = -64.f;
    constexpr bool LMF = (DV == 64);
    f32x16 lacc = {}; float l_run = 0.f;
    const short one_hi0 = hi == 0 ? (short)0x3F80 : (short)0;
    const bf16x8 kx = {one_hi0, one_hi0, one_hi0, 0, 0, 0, 0, 0};
    bf16x8 qx;
#define SET_QX() do { const float c_ = cfar - m_ref; const unsigned b1_ = cvtpk(c_, 0.f) & 0xffffu; const float r1_ = c_ - __uint_as_float(b1_ << 16); const unsigned b2_ = cvtpk(r1_, 0.f) & 0xffffu; \
        const float r2_ = r1_ - __uint_as_float(b2_ << 16); const unsigned b3_ = cvtpk(r2_, 0.f) & 0xffffu; \
        qx = (bf16x8){(short)(hi == 0 ? b1_ : 0u), (short)(hi == 0 ? b2_ : 0u), (short)(hi == 0 ? b3_ : 0u), 0, 0, 0, 0, 0}; } while (0)
    SET_QX();
    const bf16x8 ones = {0x3F80, 0x3F80, 0x3F80, 0x3F80, 0x3F80, 0x3F80, 0x3F80, 0x3F80};
#pragma unroll
    for (int d = 0; d < ND; ++d) oT[d] = (f32x16){};
    bf16x8 qf[4];
#pragma unroll
    for (int d0 = 0; d0 < 4; ++d0) qf[d0] = *(const bf16x8*)(Q + (size_t)(qw0 + r32) * pq + 16 * d0 + 8 * hi);
    LAS bf16x8* qpark = (LAS bf16x8*)(lds + 49152 + wave * 4096) + lane;
    if constexpr (ND == 4) {
#pragma unroll
        for (int d0 = 0; d0 < 4; ++d0) qpark[d0 * 64] = qf[d0];
    }
    const bf16* ksrc = K + (size_t)lane * pk + wave * 8;
    const bf16* vsrc[NV];
#pragma unroll
    for (int i = 0; i < NV; ++i) { const int p = wave + 8 * i, dh = p >> 2, rg = p & 3; vsrc[i] = V + (size_t)(rg * 16 + (lane >> 2)) * pv + dh * 32 + (lane & 3) * 8; }
    LAS unsigned char* kdst = lds + wave * 1024 + lane * 16;
    LAS unsigned char* vdst = lds + 16384 + wave * 1024 + lane * 16;
    const LAS unsigned char* kfr = lds + hi * 1024 + r32 * 16;
    const LAS unsigned char* vfr = lds + 16384 + ((lane >> 4) & 1) * 32 + (lane & 3) * 8 + (4 * hi + ((lane & 15) >> 2)) * 64;
    u32x4 kA, vA[NV], kB, vB[NV];
#define AT_LOAD(t, KR, VR) do { KR = *(const u32x4*)(ksrc + (size_t)(t) * 64 * pk); _Pragma("unroll") for (int i = 0; i < NV; ++i) VR[i] = *(const u32x4*)(vsrc[i] + (size_t)(t) * 64 * pv); } while (0)
#define AT_STORE(buf, KR, VR) do { *(LAS u32x4*)(kdst + (buf) * 8192) = KR; _Pragma("unroll") for (int i = 0; i < NV; ++i) *(LAS u32x4*)(vdst + (buf) * 16384 + i * 8192) = VR[i]; } while (0)
    AT_LOAD(0, kA, vA); AT_LOAD(1, kB, vB);
    AT_STORE(0, kA, vA);
    __syncthreads();
#define SB() __builtin_amdgcn_sched_barrier(0)
#define VFRAG(SET, d) do { _Pragma("unroll") for (int ks = 0; ks < 4; ++ks) { SET[2 * ks] = vtr(vb + (d) * 4096 + ks * 1024); SET[2 * ks + 1] = vtr(vb + (d) * 4096 + ks * 1024 + 512); } } while (0)
#define VMMA(SET, d) do { _Pragma("unroll") for (int ks = 0; ks < 4; ++ks) { const bf16x8 vf = {SET[2 * ks][0], SET[2 * ks][1], SET[2 * ks][2], SET[2 * ks][3], SET[2 * ks + 1][0], SET[2 * ks + 1][1], SET[2 * ks + 1][2], SET[2 * ks + 1][3]}; \
        oT[d] = MFMA32(vf, __builtin_bit_cast(bf16x8, pw[ks]), oT[d]); } } while (0)
    auto compute = [&](const int kt, const int cur) __attribute__((always_inline)) {
        if (kt < mylimit) {
            unsigned long long mw = 0ull;
            if (MASK) mw = maskb[(size_t)(qw0 + r32) * 64 + kt];
            const int relb = kt * 64 - qw0;
            const bool nearb = BIAS && (relb + 63 > -91);
            f32x16 p0, p1;
            const LAS unsigned char* kb = kfr + cur * 8192;
            const LAS unsigned char* vb = vfr + cur * 16384;
            if constexpr (ND == 2) {
                bf16x8 kf[8];
#pragma unroll
                for (int d0 = 0; d0 < KS; ++d0) { kf[2 * d0] = *(const LAS bf16x8*)(kb + d0 * 2048); kf[2 * d0 + 1] = *(const LAS bf16x8*)(kb + d0 * 2048 + 512); }
                SB();
                p0 = MFMA32(kx, qx, (f32x16){}); p1 = MFMA32(kx, qx, (f32x16){});
#pragma unroll
                for (int d0 = 0; d0 < KS; ++d0) { p0 = MFMA32(kf[2 * d0], qf[d0], p0); p1 = MFMA32(kf[2 * d0 + 1], qf[d0], p1); }
            } else {
                bf16x8 kf[4], qh[2];
#pragma unroll
                for (int d0 = 0; d0 < 2; ++d0) { kf[2 * d0] = *(const LAS bf16x8*)(kb + d0 * 2048); kf[2 * d0 + 1] = *(const LAS bf16x8*)(kb + d0 * 2048 + 512); qh[d0] = qpark[d0 * 64]; }
                SB();
                p0 = MFMA32(kx, qx, (f32x16){}); p1 = MFMA32(kx, qx, (f32x16){});
                p0 = MFMA32(kf[0], qh[0], p0); p1 = MFMA32(kf[1], qh[0], p1); p0 = MFMA32(kf[2], qh[1], p0); p1 = MFMA32(kf[3], qh[1], p1);
                SB();
#pragma unroll
                for (int d0 = 0; d0 < 2; ++d0) { kf[2 * d0] = *(const LAS bf16x8*)(kb + (d0 + 2) * 2048); kf[2 * d0 + 1] = *(const LAS bf16x8*)(kb + (d0 + 2) * 2048 + 512); qh[d0] = qpark[(d0 + 2) * 64]; }
                SB();
                p0 = MFMA32(kf[0], qh[0], p0); p1 = MFMA32(kf[1], qh[0], p1); p0 = MFMA32(kf[2], qh[1], p0); p1 = MFMA32(kf[3], qh[1], p1);
            }
            SB();
            s16x4 vs0[8], vs1[8];
            VFRAG(vs0, 0); if constexpr (ND == 2) VFRAG(vs1, 1);
            SB();
            if (BIAS) { if (nearb) { const LAS float* lb = lut + (relb + 192 - r32 + 4 * hi);
#pragma unroll
                for (int r = 0; r < 16; ++r) { const int cc = (r & 3) + 8 * (r >> 2); p0[r] += lb[cc]; p1[r] += lb[cc + 32]; } } }
#pragma unroll
            for (int r = 0; r < 16; ++r) { p0[r] = __builtin_amdgcn_exp2f(p0[r]); p1[r] = __builtin_amdgcn_exp2f(p1[r]); }
            if (MASK) { const unsigned mlo = (unsigned)mw >> (4 * hi), mhi = (unsigned)(mw >> 32) >> (4 * hi);
#pragma unroll
                for (int r = 0; r < 16; ++r) { const int cc = (r & 3) + 8 * (r >> 2);
                    p0[r] = __int_as_float(__float_as_int(p0[r]) & ((int)(mlo << (31 - cc)) >> 31)); p1[r] = __int_as_float(__float_as_int(p1[r]) & ((int)(mhi << (31 - cc)) >> 31)); } }
            float em = fmaxf(p0[0], p1[0]);
#pragma unroll
            for (int r = 1; r < 16; ++r) em = fmaxf(em, fmaxf(p0[r], p1[r]));
            em = halfswap_max(em);
            if (__any(em > 256.f)) {
                const float dl = fmaxf(__builtin_amdgcn_logf(em), 0.f), alpha = __builtin_amdgcn_exp2f(-dl); m_ref += dl; SET_QX();
#pragma unroll
                for (int r = 0; r < 16; ++r) { p0[r] *= alpha; p1[r] *= alpha; if (LMF) lacc[r] *= alpha; }
                l_run *= alpha;
#pragma unroll
                for (int d = 0; d < ND; ++d)
#pragma unroll
                    for (int r = 0; r < 16; ++r) oT[d][r] *= alpha; }
            if (!LMF) {
#pragma unroll
                for (int r = 0; r < 16; ++r) l_run += p0[r] + p1[r]; }
            u32x4 pw[4];
#pragma unroll
            for (int s = 0; s < 2; ++s) { pw[s] = (u32x4){cvtpk(p0[8 * s], p0[8 * s + 1]), cvtpk(p0[8 * s + 2], p0[8 * s + 3]), cvtpk(p0[8 * s + 4], p0[8 * s + 5]), cvtpk(p0[8 * s + 6], p0[8 * s + 7])};
                pw[2 + s] = (u32x4){cvtpk(p1[8 * s], p1[8 * s + 1]), cvtpk(p1[8 * s + 2], p1[8 * s + 3]), cvtpk(p1[8 * s + 4], p1[8 * s + 5]), cvtpk(p1[8 * s + 6], p1[8 * s + 7])}; }
            SB();
            if constexpr (ND == 2) {
                VMMA(vs0, 0); VMMA(vs1, 1);
#pragma unroll
                for (int ks = 0; ks < 4; ++ks) if (LMF) lacc = MFMA32(ones, __builtin_bit_cast(bf16x8, pw[ks]), lacc);
            } else {
                VFRAG(vs1, 1); SB();
                VMMA(vs0, 0); SB();
                VFRAG(vs0, 2); SB();
                VMMA(vs1, 1); SB();
                VFRAG(vs1, 3); SB();
                VMMA(vs0, 2); SB();
                VMMA(vs1, 3);
            }
            SB();
        }
    };
    for (int kt = 0; kt < nt; kt += 2) {
        { const int t2 = kt + 2 < nt ? kt + 2 : nt - 1; AT_LOAD(t2, kA, vA); }
        compute(kt, 0);
        AT_STORE(1, kB, vB);
        __syncthreads();
        { const int t3 = kt + 3 < nt ? kt + 3 : nt - 1; AT_LOAD(t3, kB, vB); }
        compute(kt + 1, 1);
        AT_STORE(0, kA, vA);
        __syncthreads();
    }
#undef SET_QX
#undef AT_LOAD
#undef AT_STORE
#undef SB
#undef VFRAG
#undef VMMA
    const float inv = 1.f / (LMF ? lacc[0] : halfswap_sum(l_run));
#pragma unroll
    for (int d = 0; d < ND; ++d)
#pragma unroll
        for (int r = 0; r < 16; ++r) oT[d][r] *= inv;
}

#define H64_SBAR() __builtin_amdgcn_sched_barrier(0)
DI void glds16s(const void* base, unsigned voff, unsigned lds_base) {
    unsigned sv; asm volatile("s_mov_b32 %0, m0\n\ts_mov_b32 m0, %3\n\ts_nop 0\n\tglobal_load_lds_dwordx4 %1, %2\n\ts_mov_b32 m0, %0" : "=&s"(sv) : "v"(voff), "s"(base), "s"(lds_base) : "memory"); }
DI const bf16* uniform_ptr(const bf16* p) { const unsigned long long v = (unsigned long long)p; const unsigned lo = (unsigned)__builtin_amdgcn_readfirstlane((int)(unsigned)v), hi2 = (unsigned)__builtin_amdgcn_readfirstlane((int)(unsigned)(v >> 32));
    return (const bf16*)(((unsigned long long)hi2 << 32) | lo); }
DI void glds4s(const void* base, unsigned voff, unsigned lds_base) {
    unsigned sv; asm volatile("s_mov_b32 %0, m0\n\ts_mov_b32 m0, %3\n\ts_nop 0\n\tglobal_load_lds_dword %1, %2\n\ts_mov_b32 m0, %0" : "=&s"(sv) : "v"(voff), "s"(base), "s"(lds_base) : "memory"); }
DI void gld64s(unsigned long long& dst, const void* base, unsigned voff) { asm volatile("global_load_dwordx2 %0, %1, %2" : "=&v"(dst) : "v"(voff), "s"(base) : "memory"); }
#define H64_PIN(x) asm volatile("" : "+v"(x))
struct DynNext {
    gu32* qctr; volatile LAS int* slot2; const LAS unsigned* ordl; const bf16* Z; const bf16* MLA; const unsigned long long* Mk; int tid, qrow, hi;
    int popv, uqn; bool valid; const bf16* Kn; const bf16* Vn; const bf16* qnl; const unsigned long long* maskn; int pkn, typen, q0n;
    DI void pop() { if (tid == 0) popv = (int)__hip_atomic_fetch_add(qctr, 1u, RLX_AGENT); }
    DI void publish() { if (tid == 0) *slot2 = popv; }
    DI void decode() {
        uqn = __builtin_amdgcn_readfirstlane(*slot2);
        valid = __builtin_amdgcn_readfirstlane((uqn < 2304 && (uqn % 3) != 2) ? 1 : 0) != 0;
        Kn = Z; Vn = Z; qnl = Z; maskn = Mk; pkn = ZP; typen = 2; q0n = 0;
        if (valid) {
            const int u = (uqn / 3) * 2 + (uqn % 3);
            const unsigned ue = (unsigned)__builtin_amdgcn_readfirstlane((int)ordl[u]);
            const int type = (int)(ue >> 16), qb = (int)((ue >> 8) & 0xffu), bh = (int)(ue & 0xffu), b = bh >> 2, h = bh & 3;
            const size_t rb = (size_t)b * SEQ, qr = rb + (size_t)(qb * 256 + qrow); typen = type; q0n = qb * 256; maskn = Mk + rb * 64;
            if (type == 0)      { Kn = Z + rb * ZP + Z_AK + (h * 2) * 64; qnl = Z + qr * ZP + Z_AQ + (h * 2) * 64 + 8 * hi; pkn = ZP; Vn = Z + rb * ZP + Z_AV + h * 128; }
            else if (type == 1) { Kn = Z + rb * ZP + Z_BK + h * 64;       qnl = Z + qr * ZP + Z_BQ + h * 64 + 8 * hi;       pkn = ZP; Vn = Z + rb * ZP + Z_BV + h * 64; }
            else                { Kn = MLA + rb * MLAP + 256 + h * 64;    qnl = MLA + qr * MLAP + h * 64 + 8 * hi;          pkn = MLAP; Vn = MLA + rb * MLAP + 512 + h * 64; }
        }
    }
};

template <bool BIAS, bool MASK, int KS>
DI void attn_pass_h64(LAS unsigned char* lds, const bf16* Q, const bf16* K, const bf16* V, int pq, int pk, int pv, int q0, int nt, const unsigned long long* maskb, float cfar, f32x16 (&oT)[2], int tid, const LAS float* lut, int pre, int& s0, bf16x8 (&qf)[4], DynNext& nx) {
    asm volatile("" : "+v"(tid));
    const int lane = tid & 63, wave = __builtin_amdgcn_readfirstlane(tid >> 6), r32 = lane & 31, hi = lane >> 5;
    const int qw0 = q0 + 32 * wave, mylimit = (qw0 >> 6) + 1, NT = nt;
    constexpr int SLOTB = 8192, LDS_V = 3 * SLOTB;
    const unsigned koff = (unsigned)(lane * pk + wave * 8) * 2u, voff = (unsigned)((16 * (wave & 3) + (lane >> 2)) * pv + (wave >> 2) * 32 + (lane & 3) * 8) * 2u;
    const unsigned kdst_u = (unsigned)(unsigned long)(lds + wave * 1024), vdst_u = (unsigned)(unsigned long)(lds + LDS_V + wave * 1024);
#define DMA_K(t, slot) glds16s(K + (size_t)(t) * 64 * pk, koff, (unsigned)__builtin_amdgcn_readfirstlane((int)(kdst_u + (unsigned)(slot))))
#define DMA_KX(t, slot) glds16s(uniform_ptr(nx.Kn + (size_t)(t) * 64 * nx.pkn), koffn, (unsigned)__builtin_amdgcn_readfirstlane((int)(kdst_u + (unsigned)(slot))))
#define DMA_V(t, slot) glds16s(V + (size_t)(t) * 64 * pv, voff, (unsigned)__builtin_amdgcn_readfirstlane((int)(vdst_u + (unsigned)(slot))))
#define WAIT_BAR(N) asm volatile("s_waitcnt vmcnt(" #N ") lgkmcnt(0)\n\ts_barrier" ::: "memory")
    const LAS unsigned char* vp0 = lds + LDS_V + ((lane >> 4) & 1) * 32 + (lane & 3) * 8 + (4 * hi + ((lane & 15) >> 2)) * 64;
    const LAS unsigned char* kp0 = lds + hi * 1024 + r32 * 16;
    const unsigned moff = (unsigned)(qw0 + r32) * 512u + 4u * (unsigned)hi;
    const unsigned mdst_u = (unsigned)(unsigned long)(lds + AUX_OFF + 4096 + wave * 512);
    const LAS unsigned* mrd = (const LAS unsigned*)(lds + AUX_OFF + 4096 + wave * 512) + r32;
#define DMA_M(t) glds4s(maskb + (t), moff, (unsigned)__builtin_amdgcn_readfirstlane((int)(mdst_u + 256u * ((unsigned)(t) & 1u))))
#define MREAD(t) do { const LAS unsigned* p_ = mrd + 64 * ((t) & 1); mwc = (unsigned long long)p_[0] | ((unsigned long long)p_[32] << 32); } while (0)
    unsigned long long mwc = ~0ull;
#define NXS(x) ((x) == 2 * SLOTB ? 0 : (x) + SLOTB)
    const int b0 = pre ? s0 : 0, b1 = NXS(b0), b2 = NXS(b1);
    if (!pre) { DMA_K(0, b0); DMA_V(0, b0); DMA_K(1, b1); if (MASK) DMA_M(0); }
    if (!pre) {
#pragma unroll
        for (int d0 = 0; d0 < KS; ++d0) qf[d0] = *(const bf16x8*)(Q + (size_t)(qw0 + r32) * pq + 16 * d0 + 8 * hi);
    }
    float m_ref = 0.f, l_reg = 0.f, fsc = 1.f; bool resc = false;
    const short one_hi0 = hi == 0 ? (short)0x3F80 : (short)0;
    const bf16x8 kx = {one_hi0, one_hi0, one_hi0, 0, 0, 0, 0, 0};
    bf16x8 qx;
#define SET_QX() do { const float c_ = cfar - m_ref; const unsigned b1_ = cvtpk(c_, 0.f) & 0xffffu; const float r1_ = c_ - __uint_as_float(b1_ << 16); const unsigned b2_ = cvtpk(r1_, 0.f) & 0xffffu; \
        const float r2_ = r1_ - __uint_as_float(b2_ << 16); const unsigned b3_ = cvtpk(r2_, 0.f) & 0xffffu; \
        qx = (bf16x8){(short)(hi == 0 ? b1_ : 0u), (short)(hi == 0 ? b2_ : 0u), (short)(hi == 0 ? b3_ : 0u), 0, 0, 0, 0, 0}; } while (0)
    SET_QX();
    oT[0] = (f32x16){}; oT[1] = (f32x16){};
    f32x16 pA0, pA1, pB0, pB1; bf16x8 kf[8]; s16x4 vlo[4], vhi[4]; u32x4 pw0, pw1, pw2, pw3;
    int sl_prev = b0, sl_cur = b0, sl_next = b1;
#define ROT() do { sl_prev = sl_cur; sl_cur = sl_next; sl_next = (sl_next == 2 * SLOTB) ? 0 : sl_next + SLOTB; } while (0)
#define KLOAD2(kp, d0) do { kf[2 * (d0)] = *(const LAS bf16x8*)((kp) + (d0) * 2048); kf[2 * (d0) + 1] = *(const LAS bf16x8*)((kp) + (d0) * 2048 + 512); } while (0)
#define MX3(a, b, c) fmaxf(fmaxf((a), (b)), (c))
#define ROWMAX(p0, p1, out) do { float a_ = MX3(p0[0], p0[1], p1[0]), b_ = MX3(p0[2], p0[3], p1[1]); a_ = MX3(a_, p1[2], p1[3]); \
        _Pragma("unroll") for (int r = 4; r < 16; r += 4) { a_ = MX3(a_, p0[r], p0[r + 1]); b_ = MX3(b_, p0[r + 2], p0[r + 3]); a_ = MX3(a_, p1[r], p1[r + 1]); b_ = MX3(b_, p1[r + 2], p1[r + 3]); } \
        out = halfswap_max(fmaxf(a_, b_)); } while (0)
#define MBIT(mw_, cc) __builtin_amdgcn_sbfe((int)(mw_), (cc), 1)
#define CROW(r) (((r) & 3) + 8 * ((r) >> 2))
#define EXM(X, i, mw_) do { X[i] = __builtin_amdgcn_exp2f(X[i]); if (MASK) X[i] = __int_as_float(__float_as_int(X[i]) & MBIT(mw_, CROW(i))); } while (0)
#define BIASADD(C0, C1, t) do { if (BIAS) { const int relb = (t) * 64 - qw0; if (relb + 63 > -91) { const LAS float* lb = lut + (relb + 192 - r32 + 4 * hi); \
        _Pragma("unroll") for (int r = 0; r < 16; ++r) { C0[r] += lb[CROW(r)]; C1[r] += lb[CROW(r) + 32]; } } } } while (0)
    if (!pre) { DMA_K(2, b2); asm volatile("s_waitcnt vmcnt(3)" ::: "memory"); }
    else { asm volatile("s_waitcnt vmcnt(12)" ::: "memory"); }
    asm volatile("s_waitcnt lgkmcnt(0)\n\ts_barrier" ::: "memory");
    if (MASK) MREAD(0);
#pragma unroll
    for (int d0 = 0; d0 < KS; ++d0) KLOAD2(kp0 + b0, d0);
    pA0 = MFMA32(kx, qx, (f32x16){}); pA1 = MFMA32(kx, qx, (f32x16){});
#pragma unroll
    for (int d0 = 0; d0 < KS; ++d0) { pA0 = MFMA32(kf[2 * d0], qf[d0], pA0); pA1 = MFMA32(kf[2 * d0 + 1], qf[d0], pA1); }
    BIASADD(pA0, pA1, 0);
    { float rm; ROWMAX(pA0, pA1, rm); m_ref = rm;
      const unsigned mlo0 = (unsigned)mwc >> (4 * hi), mhi0 = (unsigned)(mwc >> 32) >> (4 * hi);
#pragma unroll
      for (int r = 0; r < 16; ++r) { pA0[r] -= rm; pA1[r] -= rm; EXM(pA0, r, mlo0); EXM(pA1, r, mhi0); } }
    SET_QX();
    if (MASK) DMA_M(1);
    WAIT_BAR(0);
    DMA_K(3, b0); DMA_V(1, b1); ROT();
#pragma unroll
    for (int d0 = 0; d0 < KS; ++d0) KLOAD2(kp0 + sl_cur, d0);
    WAIT_BAR(2);
#define PKW(P, i) cvtpk(P[i], P[i + 1])
#define PAF(k) __builtin_bit_cast(bf16x8, pw##k)
#define VFR(j) (bf16x8){vlo[(j) & 3][0], vlo[(j) & 3][1], vlo[(j) & 3][2], vlo[(j) & 3][3], vhi[(j) & 3][0], vhi[(j) & 3][1], vhi[(j) & 3][2], vhi[(j) & 3][3]}
#define VRD(j) do { vlo[(j) & 3] = vtr(vp_ + (((j) & 1) * 4096 + ((j) >> 1) * 1024)); vhi[(j) & 3] = vtr(vp_ + (((j) & 1) * 4096 + ((j) >> 1) * 1024 + 512)); } while (0)
#define KRD(G, d0) do { if ((G) && (d0) < KS) { KLOAD2(kp0 + sl_next, d0); H64_SBAR(); } } while (0)
#define GAPA(MF, a0, a1, a2, a3, W0, W1, PW) do { MF; sacc += a0; sacc += a1; sacc += a2; sacc += a3; W0; W1; H64_PIN(PW); H64_PIN(sacc); H64_SBAR(); } while (0)
#define GAPB(MF, X, i, mw_) do { MF; EXM(X, i, mw_); EXM(X, (i) + 1, mw_); EXM(X, (i) + 2, mw_); EXM(X, (i) + 3, mw_); H64_PIN(X); H64_SBAR(); } while (0)
#define QKA(C0, C1, g) (KS == 4 ? ((g) & 1 ? (C1 = MFMA32(kf[g], qf[(g) >> 1], C1)) : (C0 = MFMA32(kf[g], qf[(g) >> 1], C0))) \
                                : ((g) < 2 ? ((g) & 1 ? (C1 = MFMA32(kx, qx, (f32x16){})) : (C0 = MFMA32(kx, qx, (f32x16){}))) \
                                           : ((g) & 1 ? (C1 = MFMA32(kf[(g) - 2], qf[((g) - 2) >> 1], C1)) : (C0 = MFMA32(kf[(g) - 2], qf[((g) - 2) >> 1], C0)))))
#define STEP(C0, C1, P0, P1, t, BAND, GK, GV, GL, GQ) do { H64_SBAR(); \
    if (MASK) { MREAD(t); if (GV) DMA_M((t) + 1); } \
    const LAS unsigned char* vp_ = vp0 + sl_prev; \
    if (KS == 4) { C0 = MFMA32(kx, qx, (f32x16){}); C1 = MFMA32(kx, qx, (f32x16){}); H64_SBAR(); } \
    VRD(0); H64_SBAR(); float sacc = P0[0] + P0[1]; \
                        GAPA(QKA(C0, C1, 0), P0[2], P0[3], P0[4], P0[5],     pw0[0] = PKW(P0, 0),  pw0[1] = PKW(P0, 2),  pw0); \
    VRD(1); H64_SBAR(); GAPA(QKA(C0, C1, 1), P0[6], P0[7], P0[8], P0[9],     pw0[2] = PKW(P0, 4),  pw0[3] = PKW(P0, 6),  pw0); \
    VRD(2); H64_SBAR(); GAPA(QKA(C0, C1, 2), P0[10], P0[11], P0[12], P0[13], pw1[0] = PKW(P0, 8),  pw1[1] = PKW(P0, 10), pw1); \
    VRD(3); H64_SBAR(); GAPA(QKA(C0, C1, 3), P0[14], P0[15], P1[0], P1[1],   pw1[2] = PKW(P0, 12), pw1[3] = PKW(P0, 14), pw1); \
                        GAPA(QKA(C0, C1, 4), P1[2], P1[3], P1[4], P1[5],     pw2[0] = PKW(P1, 0),  pw2[1] = PKW(P1, 2),  pw2); \
                        GAPA(QKA(C0, C1, 5), P1[6], P1[7], P1[8], P1[9],     pw2[2] = PKW(P1, 4),  pw2[3] = PKW(P1, 6),  pw2); \
                        GAPA(QKA(C0, C1, 6), P1[10], P1[11], P1[12], P1[13], pw3[0] = PKW(P1, 8),  pw3[1] = PKW(P1, 10), pw3); \
                        GAPA(QKA(C0, C1, 7), P1[14], P1[15], 0.f, 0.f,       pw3[2] = PKW(P1, 12), pw3[3] = PKW(P1, 14), pw3); \
    l_reg += sacc; \
    if (GK) DMA_K((t) + 3, sl_cur); if (GV) DMA_V((t) + 1, sl_next); \
    if (GQ) { if (nx.valid) { _Pragma("unroll") for (int d0 = 0; d0 < 4; ++d0) qf[d0] = *(const bf16x8*)(nx.qnl + 16 * d0); } } \
    if (BAND) { if ((t) >= mylimit) { _Pragma("unroll") for (int r = 0; r < 16; ++r) { C0[r] = -INFINITY; C1[r] = -INFINITY; } } } \
    BIASADD(C0, C1, t); \
    { float rm; ROWMAX(C0, C1, rm); resc = false; \
      if (__builtin_expect(__any(rm > 8.f), 0)) { const float dl = fmaxf(rm, 0.f); m_ref += dl; fsc = __builtin_amdgcn_exp2f(-dl); l_reg *= fsc; resc = true; SET_QX(); \
          _Pragma("unroll") for (int r = 0; r < 16; ++r) { C0[r] -= dl; C1[r] -= dl; } } } \
    const unsigned mlo_ = (unsigned)mwc >> (4 * hi), mhi_ = (unsigned)(mwc >> 32) >> (4 * hi); H64_SBAR(); \
    GAPB(oT[0] = MFMA32(VFR(0), PAF(0), oT[0]), C0, 0, mlo_);  VRD(4); H64_SBAR(); GAPB(oT[1] = MFMA32(VFR(1), PAF(0), oT[1]), C0, 4, mlo_);  VRD(5); H64_SBAR(); \
    KRD(GL, 0); GAPB(oT[0] = MFMA32(VFR(2), PAF(1), oT[0]), C0, 8, mlo_);  VRD(6); H64_SBAR(); KRD(GL, 1); GAPB(oT[1] = MFMA32(VFR(3), PAF(1), oT[1]), C0, 12, mlo_); VRD(7); H64_SBAR(); \
    KRD(GL, 2); GAPB(oT[0] = MFMA32(VFR(4), PAF(2), oT[0]), C1, 0, mhi_);  KRD(GL, 3); GAPB(oT[1] = MFMA32(VFR(5), PAF(2), oT[1]), C1, 4, mhi_); \
    GAPB(oT[0] = MFMA32(VFR(6), PAF(3), oT[0]), C1, 8, mhi_);              GAPB(oT[1] = MFMA32(VFR(7), PAF(3), oT[1]), C1, 12, mhi_); \
    } while (0)
#define RESC() do { if (resc) { _Pragma("unroll") for (int r = 0; r < 16; ++r) { oT[0][r] *= fsc; oT[1][r] *= fsc; } } } while (0)
    int t = 1;
    for (; t + 5 < NT; t += 2) {
        STEP(pB0, pB1, pA0, pA1, t, false, true, true, true, false);     WAIT_BAR(2); RESC(); ROT();
        STEP(pA0, pA1, pB0, pB1, t + 1, false, true, true, true, false); WAIT_BAR(2); RESC(); ROT();
    }
#define ENDW(tt) do { if ((tt) + 3 < NT) { WAIT_BAR(2); } else if ((tt) + 2 < NT) { WAIT_BAR(1); } else { WAIT_BAR(0); } } while (0)
    for (; t + 1 < NT; t += 2) {
        if (t + 3 >= NT) nx.pop();
        STEP(pB0, pB1, pA0, pA1, t, true, (t + 3 < NT), (t + 1 < NT), (t + 1 < NT), false);         ENDW(t);     RESC(); ROT();
        STEP(pA0, pA1, pB0, pB1, t + 1, true, (t + 4 < NT), (t + 2 < NT), (t + 2 < NT), false);     if (t + 3 >= NT) nx.publish();
        ENDW(t + 1); RESC(); ROT();
    }
    nx.decode();
    if (nx.valid) { const int n0 = sl_next, n1 = NXS(n0), n2 = NXS(n1); const unsigned koffn = (unsigned)(lane * nx.pkn + wave * 8) * 2u, voffn = (unsigned)((16 * (wave & 3) + (lane >> 2)) * nx.pkn + (wave >> 2) * 32 + (lane & 3) * 8) * 2u;
        DMA_KX(0, n0); glds16s(uniform_ptr(nx.Vn), voffn, (unsigned)__builtin_amdgcn_readfirstlane((int)(vdst_u + (unsigned)n0)));
        if (nx.typen == 0) glds16s(uniform_ptr(nx.Vn + 64), voffn, (unsigned)__builtin_amdgcn_readfirstlane((int)(vdst_u + (unsigned)n0 + 24576u)));
        DMA_KX(1, n1); DMA_KX(2, n2);
        if (nx.typen == 1) glds4s(nx.maskn, (unsigned)(nx.q0n + nx.qrow) * 512u + 4u * (unsigned)hi, (unsigned)__builtin_amdgcn_readfirstlane((int)(unsigned)(unsigned long)(lds + AUX_OFF + 4096 + wave * 512)));
        s0 = n0; }
    STEP(pB0, pB1, pA0, pA1, NT - 1, true, false, false, false, true); RESC();
    { float sacc = pB0[0] + pB0[1];
#pragma unroll
      for (int r = 2; r < 16; ++r) sacc += pB0[r];
#pragma unroll
      for (int r = 0; r < 16; ++r) sacc += pB1[r];
      l_reg += sacc;
      pw0 = (u32x4){PKW(pB0, 0), PKW(pB0, 2), PKW(pB0, 4), PKW(pB0, 6)}; pw1 = (u32x4){PKW(pB0, 8), PKW(pB0, 10), PKW(pB0, 12), PKW(pB0, 14)};
      pw2 = (u32x4){PKW(pB1, 0), PKW(pB1, 2), PKW(pB1, 4), PKW(pB1, 6)}; pw3 = (u32x4){PKW(pB1, 8), PKW(pB1, 10), PKW(pB1, 12), PKW(pB1, 14)};
      const LAS unsigned char* vp_ = vp0 + sl_cur;
      VRD(0); VRD(1); VRD(2); VRD(3);
      oT[0] = MFMA32(VFR(0), PAF(0), oT[0]); oT[1] = MFMA32(VFR(1), PAF(0), oT[1]); oT[0] = MFMA32(VFR(2), PAF(1), oT[0]); oT[1] = MFMA32(VFR(3), PAF(1), oT[1]); H64_SBAR();
      VRD(4); VRD(5); VRD(6); VRD(7);
      oT[0] = MFMA32(VFR(4), PAF(2), oT[0]); oT[1] = MFMA32(VFR(5), PAF(2), oT[1]); oT[0] = MFMA32(VFR(6), PAF(3), oT[0]); oT[1] = MFMA32(VFR(7), PAF(3), oT[1]); }
    const float inv = 1.f / halfswap_sum(l_reg);
#pragma unroll
    for (int d = 0; d < 2; ++d)
#pragma unroll
        for (int r = 0; r < 16; ++r) oT[d][r] *= inv;
    asm volatile("s_waitcnt lgkmcnt(0)\n\ts_barrier" ::: "memory");
#undef DMA_M
#undef MREAD
#undef DMA_K
#undef DMA_V
#undef DMA_KX
#undef NXS
#undef WAIT_BAR
#undef SET_QX
#undef ROT
#undef KLOAD2
#undef MX3
#undef ROWMAX
#undef MBIT
#undef CROW
#undef EXM
#undef BIASADD
#undef PKW
#undef PAF
#undef VFR
#undef VRD
#undef KRD
#undef GAPA
#undef GAPB
#undef QKA
#undef STEP
#undef RESC
#undef ENDW
}

template <bool BIAS, bool PRE, bool NEXT>
DI void attn_pass_h128(LAS unsigned char* lds, const bf16* Q, const bf16* K, const bf16* V, int pq, int pk, int pv, int q0, int nt, const unsigned long long* maskb, float cfar, f32x16 (&oT)[4], int tid, const LAS float* lut,
                       const bf16* Qn, const bf16* Kn, int pre, int& s0, bf16x8 (&qf)[4], DynNext& nx) {
    constexpr bool MASK = false; constexpr int KS = 4;
    asm volatile("" : "+v"(tid));
    const int lane = tid & 63, wave = __builtin_amdgcn_readfirstlane(tid >> 6), r32 = lane & 31, hi = lane >> 5;
    const int qw0 = q0 + 32 * wave, mylimit = (qw0 >> 6) + 1, NT = nt;
    constexpr int SLOTB = 8192, VSLOTB = 16384, LDS_V = 3 * SLOTB;
    const unsigned koff = (unsigned)(lane * pk + wave * 8) * 2u, voff = (unsigned)((16 * (wave & 3) + (lane >> 2)) * pv + (wave >> 2) * 32 + (lane & 3) * 8) * 2u;
    const unsigned kdst_u = (unsigned)(unsigned long)(lds + wave * 1024), vdst_u = (unsigned)(unsigned long)(lds + LDS_V + wave * 1024);
#define DMA_K(t, slot) glds16s(K + (size_t)(t) * 64 * pk, koff, (unsigned)__builtin_amdgcn_readfirstlane((int)(kdst_u + (unsigned)(slot))))
#define DMA_KN(t, slot) glds16s(Kn + (size_t)(t) * 64 * pk, koff, (unsigned)__builtin_amdgcn_readfirstlane((int)(kdst_u + (unsigned)(slot))))
#define DMA_KX(t, slot) glds16s(uniform_ptr(nx.Kn + (size_t)(t) * 64 * nx.pkn), koffn, (unsigned)__builtin_amdgcn_readfirstlane((int)(kdst_u + (unsigned)(slot))))
#define DMA_V(t, slot) do { glds16s(V + (size_t)(t) * 64 * pv, voff, (unsigned)__builtin_amdgcn_readfirstlane((int)(vdst_u + (unsigned)(slot)))); \
        glds16s(V + (size_t)(t) * 64 * pv + 64, voff, (unsigned)__builtin_amdgcn_readfirstlane((int)(vdst_u + (unsigned)(slot) + 24576u))); } while (0)
#define WAIT_BAR(N) do { if (MASK) asm volatile("s_waitcnt vmcnt(" #N ") lgkmcnt(0)\n\ts_barrier" : "+v"(mwc), "+v"(mwn) :: "memory"); else asm volatile("s_waitcnt vmcnt(" #N ") lgkmcnt(0)\n\ts_barrier" ::: "memory"); } while (0)
    const LAS unsigned char* vp0 = lds + LDS_V + ((lane >> 4) & 1) * 32 + (lane & 3) * 8 + (4 * hi + ((lane & 15) >> 2)) * 64;
    const LAS unsigned char* kp0 = lds + hi * 1024 + r32 * 16;
    const unsigned moff = (unsigned)(qw0 + r32) * 512u;
#define MLOAD(dst, t) gld64s(dst, maskb + (t), moff)
    unsigned long long mwc = ~0ull, mwn = ~0ull;
#define NXS(x) ((x) == 2 * SLOTB ? 0 : (x) + SLOTB)
    const int b0 = (PRE || pre) ? s0 : 0, b1 = NXS(b0), b2 = NXS(b1);
    if (!PRE && !pre) { DMA_K(0, b0); DMA_V(0, b0); DMA_K(1, b1); }
    if (!PRE && !pre) {
#pragma unroll
        for (int d0 = 0; d0 < KS; ++d0) qf[d0] = *(const bf16x8*)(Q + (size_t)(qw0 + r32) * pq + 16 * d0 + 8 * hi);
    }
    float m_ref = 0.f, l_reg = 0.f, fsc = 1.f; bool resc = false;
    const short one_hi0 = hi == 0 ? (short)0x3F80 : (short)0;
    const bf16x8 kx = {one_hi0, one_hi0, one_hi0, 0, 0, 0, 0, 0};
    bf16x8 qx;
#define SET_QX() do { const float c_ = cfar - m_ref; const unsigned b1_ = cvtpk(c_, 0.f) & 0xffffu; const float r1_ = c_ - __uint_as_float(b1_ << 16); const unsigned b2_ = cvtpk(r1_, 0.f) & 0xffffu; \
        const float r2_ = r1_ - __uint_as_float(b2_ << 16); const unsigned b3_ = cvtpk(r2_, 0.f) & 0xffffu; \
        qx = (bf16x8){(short)(hi == 0 ? b1_ : 0u), (short)(hi == 0 ? b2_ : 0u), (short)(hi == 0 ? b3_ : 0u), 0, 0, 0, 0, 0}; } while (0)
    SET_QX();
    oT[0] = (f32x16){}; oT[1] = (f32x16){}; oT[2] = (f32x16){}; oT[3] = (f32x16){};
    f32x16 C0, C1; bf16x8 kf[8]; s16x4 vlo[4], vhi[4]; u32x4 pw0, pw1, pw2, pw3;
    int sl_prev = b0, sl_cur = b0, sl_next = b1;
#define ROT() do { sl_prev = sl_cur; sl_cur = sl_next; sl_next = (sl_next == 2 * SLOTB) ? 0 : sl_next + SLOTB; } while (0)
#define KLOAD2(kp, d0) do { kf[2 * (d0)] = *(const LAS bf16x8*)((kp) + (d0) * 2048); kf[2 * (d0) + 1] = *(const LAS bf16x8*)((kp) + (d0) * 2048 + 512); } while (0)
#define MX3(a, b, c) fmaxf(fmaxf((a), (b)), (c))
#define ROWMAX(p0, p1, out) do { float a_ = MX3(p0[0], p0[1], p1[0]), b_ = MX3(p0[2], p0[3], p1[1]); a_ = MX3(a_, p1[2], p1[3]); \
        _Pragma("unroll") for (int r = 4; r < 16; r += 4) { a_ = MX3(a_, p0[r], p0[r + 1]); b_ = MX3(b_, p0[r + 2], p0[r + 3]); a_ = MX3(a_, p1[r], p1[r + 1]); b_ = MX3(b_, p1[r + 2], p1[r + 3]); } \
        out = halfswap_max(fmaxf(a_, b_)); } while (0)
#define MBIT(mw_, cc) ((int)((mw_) << (31 - (cc))) >> 31)
#define CROW(r) (((r) & 3) + 8 * ((r) >> 2))
#define EXM(X, i, mw_) do { X[i] = __builtin_amdgcn_exp2f(X[i]); if (MASK) X[i] = __int_as_float(__float_as_int(X[i]) & MBIT(mw_, CROW(i))); } while (0)
#define BIASADD(C0, C1, t) do { if (BIAS) { const int relb = (t) * 64 - qw0; if (relb + 63 > -91) { const LAS float* lb = lut + (relb + 192 - r32 + 4 * hi); \
        _Pragma("unroll") for (int r = 0; r < 16; ++r) { C0[r] += lb[CROW(r)]; C1[r] += lb[CROW(r) + 32]; } } } } while (0)
    if (!PRE && !pre) DMA_K(2, b2);
    if (!PRE && pre) { asm volatile("s_waitcnt vmcnt(12)" ::: "memory"); } else { asm volatile("s_waitcnt vmcnt(4)" ::: "memory"); }
    asm volatile("s_waitcnt lgkmcnt(0)\n\ts_barrier" ::: "memory");
#pragma unroll
    for (int d0 = 0; d0 < KS; ++d0) KLOAD2(kp0 + b0, d0);
    C0 = MFMA32(kx, qx, (f32x16){}); C1 = MFMA32(kx, qx, (f32x16){});
#pragma unroll
    for (int d0 = 0; d0 < KS; ++d0) { C0 = MFMA32(kf[2 * d0], qf[d0], C0); C1 = MFMA32(kf[2 * d0 + 1], qf[d0], C1); }
    BIASADD(C0, C1, 0);
    { float rm; ROWMAX(C0, C1, rm); m_ref = rm; float sacc = 0.f;
#pragma unroll
      for (int r = 0; r < 16; ++r) { C0[r] = __builtin_amdgcn_exp2f(C0[r] - rm); C1[r] = __builtin_amdgcn_exp2f(C1[r] - rm); sacc += C0[r] + C1[r]; }
      l_reg = sacc;
      pw0 = (u32x4){cvtpk(C0[0], C0[1]), cvtpk(C0[2], C0[3]), cvtpk(C0[4], C0[5]), cvtpk(C0[6], C0[7])}; pw1 = (u32x4){cvtpk(C0[8], C0[9]), cvtpk(C0[10], C0[11]), cvtpk(C0[12], C0[13]), cvtpk(C0[14], C0[15])};
      pw2 = (u32x4){cvtpk(C1[0], C1[1]), cvtpk(C1[2], C1[3]), cvtpk(C1[4], C1[5]), cvtpk(C1[6], C1[7])}; pw3 = (u32x4){cvtpk(C1[8], C1[9]), cvtpk(C1[10], C1[11]), cvtpk(C1[12], C1[13]), cvtpk(C1[14], C1[15])}; }
    SET_QX();
    if (MASK) MLOAD(mwn, 1);
    WAIT_BAR(0);
    if (MASK) mwc = mwn;
    DMA_K(3, b0); DMA_V(1, b1); ROT();
#pragma unroll
    for (int d0 = 0; d0 < KS; ++d0) KLOAD2(kp0 + sl_cur, d0);
    WAIT_BAR(3);
#define PKW(P, i) cvtpk(P[i], P[i + 1])
#define PAF(k) __builtin_bit_cast(bf16x8, pw##k)
#define VFR(i) (bf16x8){vlo[i][0], vlo[i][1], vlo[i][2], vlo[i][3], vhi[i][0], vhi[i][1], vhi[i][2], vhi[i][3]}
#define VOF(i) (((i) & 1) * 4096 + (((i) >> 1) & 1) * 24576 + ((i) >> 2) * 1024)
#define VRD(i) do { vlo[(i) & 3] = vtr(vp_ + VOF(i)); vhi[(i) & 3] = vtr(vp_ + (VOF(i) + 512)); } while (0)
#define KRD(G, d0) do { if ((G) && (d0) < KS) { KLOAD2(kp0 + sl_next, d0); H64_SBAR(); } } while (0)
#define GAPA(MF, a0, a1, a2, a3, W0, W1, PW) do { MF; sacc += a0; sacc += a1; sacc += a2; sacc += a3; W0; W1; H64_PIN(PW); H64_PIN(sacc); H64_SBAR(); } while (0)
#define GAPB2(MF, X, i) do { MF; X[i] = __builtin_amdgcn_exp2f(X[i]); X[(i) + 1] = __builtin_amdgcn_exp2f(X[(i) + 1]); H64_PIN(X); H64_SBAR(); } while (0)
#define GAPB(MF, X, i, mw_) do { MF; EXM(X, i, mw_); EXM(X, (i) + 1, mw_); EXM(X, (i) + 2, mw_); EXM(X, (i) + 3, mw_); H64_PIN(X); H64_SBAR(); } while (0)
#define STEP(t, BAND, GK, GV, GL, GQ) do { H64_SBAR(); \
    const LAS unsigned char* vp_ = vp0 + sl_prev; \
    C0 = MFMA32(kx, qx, (f32x16){}); C1 = MFMA32(kx, qx, (f32x16){}); H64_SBAR(); \
    VRD(0); H64_SBAR(); C0 = MFMA32(kf[0], qf[0], C0); H64_SBAR(); VRD(1); H64_SBAR(); C1 = MFMA32(kf[1], qf[0], C1); H64_SBAR(); \
    VRD(2); H64_SBAR(); C0 = MFMA32(kf[2], qf[1], C0); H64_SBAR(); VRD(3); H64_SBAR(); C1 = MFMA32(kf[3], qf[1], C1); H64_SBAR(); \
    C0 = MFMA32(kf[4], qf[2], C0); H64_SBAR(); C1 = MFMA32(kf[5], qf[2], C1); H64_SBAR(); \
    C0 = MFMA32(kf[6], qf[3], C0); H64_SBAR(); C1 = MFMA32(kf[7], qf[3], C1); H64_SBAR(); \
    if (GK) DMA_K((t) + 3, sl_cur); if (GV) DMA_V((t) + 1, sl_next); \
    if (NEXT && (GQ)) { _Pragma("unroll") for (int d0 = 0; d0 < KS; ++d0) qf[d0] = *(const bf16x8*)(Qn + (size_t)(qw0 + r32) * pq + 16 * d0 + 8 * hi); } \
    if (PRE && (GQ)) { if (nx.valid) { _Pragma("unroll") for (int d0 = 0; d0 < 4; ++d0) qf[d0] = *(const bf16x8*)(nx.qnl + 16 * d0); } } \
    if (BAND) { if ((t) >= mylimit) { _Pragma("unroll") for (int r = 0; r < 16; ++r) { C0[r] = -INFINITY; C1[r] = -INFINITY; } } } \
    BIASADD(C0, C1, t); \
    { float rm; ROWMAX(C0, C1, rm); resc = false; \
      if (__builtin_expect(__any(rm > 8.f), 0)) { const float dl = fmaxf(rm, 0.f); m_ref += dl; fsc = __builtin_amdgcn_exp2f(-dl); l_reg *= fsc; resc = true; SET_QX(); \
          _Pragma("unroll") for (int r = 0; r < 16; ++r) { C0[r] -= dl; C1[r] -= dl; } } } \
    float sacc = 0.f; H64_SBAR(); \
    oT[0] = MFMA32(VFR(0), PAF(0), oT[0]); C0[0] = __builtin_amdgcn_exp2f(C0[0]); C0[1] = __builtin_amdgcn_exp2f(C0[1]); C0[2] = __builtin_amdgcn_exp2f(C0[2]); H64_PIN(C0); H64_SBAR(); VRD(4); H64_SBAR(); \
    oT[1] = MFMA32(VFR(1), PAF(0), oT[1]); C0[3] = __builtin_amdgcn_exp2f(C0[3]); C0[4] = __builtin_amdgcn_exp2f(C0[4]); C0[5] = __builtin_amdgcn_exp2f(C0[5]); sacc += C0[0]; sacc += C0[1]; H64_PIN(C0); H64_PIN(sacc); H64_SBAR(); VRD(5); H64_SBAR(); \
    oT[2] = MFMA32(VFR(2), PAF(0), oT[2]); C0[6] = __builtin_amdgcn_exp2f(C0[6]); C0[7] = __builtin_amdgcn_exp2f(C0[7]); C0[8] = __builtin_amdgcn_exp2f(C0[8]); sacc += C0[2]; sacc += C0[3]; H64_PIN(C0); H64_PIN(sacc); H64_SBAR(); VRD(6); H64_SBAR(); \
    oT[3] = MFMA32(VFR(3), PAF(0), oT[3]); C0[9] = __builtin_amdgcn_exp2f(C0[9]); C0[10] = __builtin_amdgcn_exp2f(C0[10]); C0[11] = __builtin_amdgcn_exp2f(C0[11]); sacc += C0[4]; sacc += C0[5]; H64_PIN(C0); H64_PIN(sacc); H64_SBAR(); VRD(7); H64_SBAR(); \
    oT[0] = MFMA32(VFR(0), PAF(1), oT[0]); C0[12] = __builtin_amdgcn_exp2f(C0[12]); C0[13] = __builtin_amdgcn_exp2f(C0[13]); C0[14] = __builtin_amdgcn_exp2f(C0[14]); sacc += C0[6]; sacc += C0[7]; pw0[0] = cvtpk(C0[0], C0[1]); H64_PIN(C0); H64_PIN(pw0); H64_PIN(sacc); H64_SBAR(); VRD(8); H64_SBAR(); \
    oT[1] = MFMA32(VFR(1), PAF(1), oT[1]); C0[15] = __builtin_amdgcn_exp2f(C0[15]); C1[0] = __builtin_amdgcn_exp2f(C1[0]); C1[1] = __builtin_amdgcn_exp2f(C1[1]); sacc += C0[8]; sacc += C0[9]; pw0[1] = cvtpk(C0[2], C0[3]); H64_PIN(C0); H64_PIN(C1); H64_PIN(pw0); H64_PIN(sacc); H64_SBAR(); VRD(9); H64_SBAR(); \
    oT[2] = MFMA32(VFR(2), PAF(1), oT[2]); C1[2] = __builtin_amdgcn_exp2f(C1[2]); C1[3] = __builtin_amdgcn_exp2f(C1[3]); C1[4] = __builtin_amdgcn_exp2f(C1[4]); sacc += C0[10]; sacc += C0[11]; pw0[2] = cvtpk(C0[4], C0[5]); H64_PIN(C1); H64_PIN(pw0); H64_PIN(sacc); H64_SBAR(); VRD(10); H64_SBAR(); \
    oT[3] = MFMA32(VFR(3), PAF(1), oT[3]); C1[5] = __builtin_amdgcn_exp2f(C1[5]); C1[6] = __builtin_amdgcn_exp2f(C1[6]); C1[7] = __builtin_amdgcn_exp2f(C1[7]); sacc += C0[12]; sacc += C0[13]; pw0[3] = cvtpk(C0[6], C0[7]); H64_PIN(C1); H64_PIN(pw0); H64_PIN(sacc); H64_SBAR(); VRD(11); H64_SBAR(); \
    KRD(GL, 0); oT[0] = MFMA32(VFR(0), PAF(2), oT[0]); C1[8] = __builtin_amdgcn_exp2f(C1[8]); C1[9] = __builtin_amdgcn_exp2f(C1[9]); C1[10] = __builtin_amdgcn_exp2f(C1[10]); sacc += C0[14]; sacc += C0[15]; pw1[0] = cvtpk(C0[8], C0[9]); H64_PIN(C1); H64_PIN(pw1); H64_PIN(sacc); H64_SBAR(); VRD(12); H64_SBAR(); \
    oT[1] = MFMA32(VFR(1), PAF(2), oT[1]); C1[11] = __builtin_amdgcn_exp2f(C1[11]); C1[12] = __builtin_amdgcn_exp2f(C1[12]); C1[13] = __builtin_amdgcn_exp2f(C1[13]); sacc += C1[0]; sacc += C1[1]; pw1[1] = cvtpk(C0[10], C0[11]); H64_PIN(C1); H64_PIN(pw1); H64_PIN(sacc); H64_SBAR(); VRD(13); H64_SBAR(); \
    KRD(GL, 1); oT[2] = MFMA32(VFR(2), PAF(2), oT[2]); C1[14] = __builtin_amdgcn_exp2f(C1[14]); C1[15] = __builtin_amdgcn_exp2f(C1[15]); sacc += C1[2]; sacc += C1[3]; pw1[2] = cvtpk(C0[12], C0[13]); H64_PIN(C1); H64_PIN(pw1); H64_PIN(sacc); H64_SBAR(); VRD(14); H64_SBAR(); \
    oT[3] = MFMA32(VFR(3), PAF(2), oT[3]); sacc += C1[4]; sacc += C1[5]; pw1[3] = cvtpk(C0[14], C0[15]); H64_PIN(pw1); H64_PIN(sacc); H64_SBAR(); VRD(15); H64_SBAR(); \
    KRD(GL, 2); oT[0] = MFMA32(VFR(0), PAF(3), oT[0]); sacc += C1[6]; sacc += C1[7]; pw2[0] = cvtpk(C1[0], C1[1]); H64_PIN(pw2); H64_PIN(sacc); H64_SBAR(); \
    oT[1] = MFMA32(VFR(1), PAF(3), oT[1]); sacc += C1[8]; sacc += C1[9]; pw2[1] = cvtpk(C1[2], C1[3]); H64_PIN(pw2); H64_PIN(sacc); H64_SBAR(); \
    KRD(GL, 3); oT[2] = MFMA32(VFR(2), PAF(3), oT[2]); sacc += C1[10]; sacc += C1[11]; pw2[2] = cvtpk(C1[4], C1[5]); H64_PIN(pw2); H64_PIN(sacc); H64_SBAR(); \
    oT[3] = MFMA32(VFR(3), PAF(3), oT[3]); sacc += C1[12]; sacc += C1[13]; pw2[3] = cvtpk(C1[6], C1[7]); H64_PIN(pw2); H64_PIN(sacc); H64_SBAR(); \
    sacc += C1[14]; sacc += C1[15]; l_reg += sacc; \
    pw3[0] = cvtpk(C1[8], C1[9]); pw3[1] = cvtpk(C1[10], C1[11]); pw3[2] = cvtpk(C1[12], C1[13]); pw3[3] = cvtpk(C1[14], C1[15]); \
    } while (0)
#define RESC() do { if (resc) { _Pragma("unroll") for (int r = 0; r < 16; ++r) { oT[0][r] *= fsc; oT[1][r] *= fsc; oT[2][r] *= fsc; oT[3][r] *= fsc; } } } while (0)
    int t = 1;
    for (; t + 4 < NT; ++t) { STEP(t, false, true, true, true, false); WAIT_BAR(3); RESC(); ROT(); }
#define ENDW(tt) do { if ((tt) + 3 < NT) { WAIT_BAR(3); } else if ((tt) + 2 < NT) { WAIT_BAR(2); } else { WAIT_BAR(0); } } while (0)
    for (; t + 1 < NT; ++t) { if (PRE && t + 3 == NT) nx.pop(); STEP(t, true, (t + 3 < NT), (t + 1 < NT), (t + 1 < NT), false); if (PRE && t + 2 == NT) nx.publish(); ENDW(t); RESC(); ROT(); }
    if (NEXT) { const int n0 = sl_next, n1 = NXS(n0), n2 = NXS(n1); DMA_KN(0, n0); DMA_V(0, n0); DMA_KN(1, n1); DMA_KN(2, n2); s0 = n0; }
    if (PRE) { nx.decode(); if (nx.valid) { const int n0 = sl_next, n1 = NXS(n0), n2 = NXS(n1); const unsigned koffn = (unsigned)(lane * nx.pkn + wave * 8) * 2u, voffn = (unsigned)((16 * (wave & 3) + (lane >> 2)) * nx.pkn + (wave >> 2) * 32 + (lane & 3) * 8) * 2u;
        DMA_KX(0, n0); glds16s(uniform_ptr(nx.Vn), voffn, (unsigned)__builtin_amdgcn_readfirstlane((int)(vdst_u + (unsigned)n0)));
        if (nx.typen == 0) glds16s(uniform_ptr(nx.Vn + 64), voffn, (unsigned)__builtin_amdgcn_readfirstlane((int)(vdst_u + (unsigned)n0 + 24576u)));
        DMA_KX(1, n1); DMA_KX(2, n2);
        if (nx.typen == 1) glds4s(nx.maskn, (unsigned)(nx.q0n + nx.qrow) * 512u + 4u * (unsigned)hi, (unsigned)__builtin_amdgcn_readfirstlane((int)(unsigned)(unsigned long)(lds + AUX_OFF + 4096 + wave * 512)));
        s0 = n0; } }
    STEP(NT - 1, true, false, false, false, true); RESC();
    { const LAS unsigned char* vp_ = vp0 + sl_cur;
      VRD(0); VRD(1); VRD(2); VRD(3);
      oT[0] = MFMA32(VFR(0), PAF(0), oT[0]); oT[1] = MFMA32(VFR(1), PAF(0), oT[1]); oT[2] = MFMA32(VFR(2), PAF(0), oT[2]); oT[3] = MFMA32(VFR(3), PAF(0), oT[3]); H64_SBAR();
      VRD(4); VRD(5); VRD(6); VRD(7);
      oT[0] = MFMA32(VFR(0), PAF(1), oT[0]); oT[1] = MFMA32(VFR(1), PAF(1), oT[1]); oT[2] = MFMA32(VFR(2), PAF(1), oT[2]); oT[3] = MFMA32(VFR(3), PAF(1), oT[3]); H64_SBAR();
      VRD(8); VRD(9); VRD(10); VRD(11);
      oT[0] = MFMA32(VFR(0), PAF(2), oT[0]); oT[1] = MFMA32(VFR(1), PAF(2), oT[1]); oT[2] = MFMA32(VFR(2), PAF(2), oT[2]); oT[3] = MFMA32(VFR(3), PAF(2), oT[3]); H64_SBAR();
      VRD(12); VRD(13); VRD(14); VRD(15);
      oT[0] = MFMA32(VFR(0), PAF(3), oT[0]); oT[1] = MFMA32(VFR(1), PAF(3), oT[1]); oT[2] = MFMA32(VFR(2), PAF(3), oT[2]); oT[3] = MFMA32(VFR(3), PAF(3), oT[3]); H64_SBAR();
    }
    const float inv = 1.f / halfswap_sum(l_reg);
#pragma unroll
    for (int d = 0; d < 4; ++d)
#pragma unroll
        for (int r = 0; r < 16; ++r) oT[d][r] *= inv;
    asm volatile("s_waitcnt lgkmcnt(0)\n\ts_barrier" ::: "memory");
#undef MLOAD
#undef DMA_K
#undef DMA_V
#undef DMA_KN
#undef DMA_KX
#undef VOF
#undef NXS
#undef WAIT_BAR
#undef SET_QX
#undef ROT
#undef KLOAD2
#undef MX3
#undef ROWMAX
#undef MBIT
#undef CROW
#undef EXM
#undef BIASADD
#undef PKW
#undef PAF
#undef VFR
#undef VRD
#undef KRD
#undef GAPA
#undef GAPB
#undef GAPB2
#undef STEP
#undef RESC
#undef ENDW
}

template <int ND>
DI void store_oT(bf16* orow, const f32x16 (&oT)[ND], int hi) {
#pragma unroll
    for (int d = 0; d < ND; ++d)
#pragma unroll
        for (int g = 0; g < 4; ++g) st4(orow + 32 * d + 8 * g + 4 * hi, oT[d][4 * g], oT[d][4 * g + 1], oT[d][4 * g + 2], oT[d][4 * g + 3]);
}

DI void attn_phase(const bf16* Z, const bf16* MLA, bf16* MIX, const unsigned long long* MASK, unsigned* O0, const float* par, const float* subln, int layer, gu32* qctr,
                   const float* w_gate, const float* w_up, const float* w_down, unsigned char* WGU, unsigned char* WD, LAS unsigned char* lds, int tid) {
    const int lane = tid & 63, wave = __builtin_amdgcn_readfirstlane(tid >> 6), r32 = lane & 31, hi = lane >> 5;
    volatile LAS int* slot = (volatile LAS int*)(lds + AUX_OFF + 2048);
    LAS float* lutall = (LAS float*)(lds + 73728);
    LAS float* gain = (LAS float*)(lds + AUX_OFF + 1024);
    const float lam = par[layer], omli = par[2 + layer];
    for (int i = tid; i < 2048; i += NTHR) lutall[i] = par[(PAR_LUT / 4) + i] - par[(PAR_LUT / 4) + (i & ~255)];
    if (tid < 128) gain[tid] = subln[layer * 128 + tid] * omli;
    LAS unsigned* ordl = (LAS unsigned*)(lds + ORD_OFF);
    for (int i = tid; i < 1536; i += NTHR) ordl[i] = ((const unsigned*)par)[(PAR_ORD / 4) + i];
    __syncthreads();
    DynNext nx; nx.qctr = qctr; nx.slot2 = slot + 16; nx.ordl = ordl; nx.Z = Z; nx.MLA = MLA; nx.Mk = MASK; nx.Vn = Z; nx.maskn = MASK; nx.typen = 2; nx.q0n = 0; nx.tid = tid; nx.qrow = 32 * wave + r32; nx.hi = hi; nx.popv = 0; nx.uqn = 0; nx.valid = false; nx.Kn = Z; nx.qnl = Z; nx.pkn = ZP;
    bool known = false; int s0 = 0; bf16x8 qfx[4];
    for (;;) {
        int uq, pre = 0;
        if (known) { uq = __builtin_amdgcn_readfirstlane(nx.uqn); pre = __builtin_amdgcn_readfirstlane(nx.valid ? 1 : 0); }
        else { if (tid == 0) *slot = (int)__hip_atomic_fetch_add(qctr, 1u, RLX_AGENT); __syncthreads(); uq = *slot; }
        known = false;
        if (uq >= 2304) break;
        if (uq % 3 == 2) {
            const int grp = uq / 3;
            moe_convert_items<4>(w_gate, w_up, w_down, WGU, WD, (LAS float*)(lds + wave * 8448), grp * 32 + wave * 4, lane);
            __syncthreads();
            continue;
        }
        const int u = (uq / 3) * 2 + (uq % 3);
        const unsigned ue = (unsigned)__builtin_amdgcn_readfirstlane((int)ordl[u]);
        const int type = (int)(ue >> 16), qb = (int)((ue >> 8) & 0xffu), bh = (int)(ue & 0xffu), b = bh >> 2, h = bh & 3;
        const int q0 = qb * 256, nt = 4 * qb + 4; const size_t rb = (size_t)b * SEQ;
        const float cfar = type < 2 ? par[(PAR_LUT / 4) + (type * 4 + h) * 256] : 0.f;
        if (type == 0) {
            bf16* orow = MIX + (rb + q0 + 32 * wave + r32) * DM;
            f32x16 oT[4];
#define O0L(j) (*(LAS u32x4*)(lds + ((j) < 6 ? PARK_A + (j) * 8192 : PARK_B + ((j) - 6) * 8192) + tid * 16))
            const bf16* Vp = Z + rb * ZP + Z_AV + h * 128;
            attn_pass_h128<true, false, true>(lds, Z + rb * ZP + Z_AQ + (h * 2) * 64, Z + rb * ZP + Z_AK + (h * 2) * 64, Vp, ZP, ZP, ZP, q0, nt, nullptr, cfar, oT, tid, lutall + (type * 4 + h) * 256,
                                              Z + rb * ZP + Z_AQ + (h * 2 + 1) * 64, Z + rb * ZP + Z_AK + (h * 2 + 1) * 64, pre, s0, qfx, nx);
#pragma unroll
            for (int d = 0; d < 4; ++d)
#pragma unroll
                for (int i = 0; i < 2; ++i) O0L(d * 2 + i) = (u32x4){cvtpk(oT[d][8 * i], oT[d][8 * i + 1]), cvtpk(oT[d][8 * i + 2], oT[d][8 * i + 3]), cvtpk(oT[d][8 * i + 4], oT[d][8 * i + 5]), cvtpk(oT[d][8 * i + 6], oT[d][8 * i + 7])};
            attn_pass_h128<true, true, false>(lds, Z + rb * ZP + Z_AQ + (h * 2 + 1) * 64, Z + rb * ZP + Z_AK + (h * 2 + 1) * 64, Vp, ZP, ZP, ZP, q0, nt, nullptr, cfar, oT, tid, lutall + (type * 4 + h) * 256,
                                              nullptr, nullptr, 0, s0, qfx, nx); known = true;
            float ss = 0.f;
#pragma unroll
            for (int d = 0; d < 4; ++d)
#pragma unroll
                for (int i = 0; i < 2; ++i) { const u32x4 pk = O0L(d * 2 + i);
#pragma unroll
                    for (int e = 0; e < 4; ++e) { const unsigned p = pk[e]; const float a = __uint_as_float(p << 16) - lam * oT[d][8 * i + 2 * e], c2 = __uint_as_float(p & 0xffff0000u) - lam * oT[d][8 * i + 2 * e + 1];
                        oT[d][8 * i + 2 * e] = a; oT[d][8 * i + 2 * e + 1] = c2; ss += a * a + c2 * c2; } }
            const float rstd = rsqrtf(halfswap_sum(ss) * (1.f / 128.f) + EPS);
#pragma unroll
            for (int d = 0; d < 4; ++d)
#pragma unroll
                for (int rr = 0; rr < 16; ++rr) oT[d][rr] *= rstd * gain[32 * d + (rr & 3) + 8 * (rr >> 2) + 4 * hi];
            store_oT<4>(orow + h * 128, oT, hi);
        } else if (type == 1) {
            f32x16 oT[2];
            attn_pass_h64<true, true, 4>(lds, Z + rb * ZP + Z_BQ + h * 64, Z + rb * ZP + Z_BK + h * 64, Z + rb * ZP + Z_BV + h * 64, ZP, ZP, ZP, q0, nt, MASK + rb * 64, cfar, oT, tid, lutall + (type * 4 + h) * 256, pre, s0, qfx, nx); known = true;
            store_oT<2>(MIX + (rb + q0 + 32 * wave + r32) * DM + 512 + h * 64, oT, hi);
        } else {
            f32x16 oT[2];
            attn_pass_h64<false, false, 3>(lds, MLA + rb * MLAP + h * 64, MLA + rb * MLAP + 256 + h * 64, MLA + rb * MLAP + 512 + h * 64, MLAP, MLAP, MLAP, q0, nt, nullptr, cfar, oT, tid, lutall + (type * 4 + h) * 256, pre, s0, qfx, nx); known = true;
            store_oT<2>(MIX + (rb + q0 + 32 * wave + r32) * DM + 768 + h * 64, oT, hi);
        }
    }
}


DI void router_unit(const bf16* XA, const bf16* WRl  , const float* bg, const float* be, int* rt_e, float* rt_g, float* rstd_g, int* cnt_g, LAS unsigned char* lds, int unit, int tid) {
    const int lane = tid & 63, wave = __builtin_amdgcn_readfirstlane(tid >> 6), r32 = lane & 31, hi = lane >> 5;
    LAS int* hist = (LAS int*)(lds + AUX_OFF + 4096);
    LAS float* xch = (LAS float*)lds;
    if (tid < 32) hist[tid] = 0;
    f32x16 a0[4], a1[4]; float ss[4];
#pragma unroll
    for (int tb = 0; tb < 4; ++tb) { a0[tb] = (f32x16){}; a1[tb] = (f32x16){}; ss[tb] = 0.f; }
    const bf16* xg = XA + (size_t)(unit * 128 + r32) * DM + wave * 128 + 32 * hi;
    const bf16* wg = WRl + (size_t)r32 * 1024 + wave * 128 + 32 * hi;
    const bf16* wg2 = WRl + (size_t)(32 + (r32 < 4 ? r32 : 4)) * 1024 + wave * 128 + 32 * hi;
    u32x4 X[2][4]; bf16x8 W[2][4];
#define RT_LD(s, S) do { const int o_ = 64 * ((s) >> 2) + 8 * ((s) & 3); _Pragma("unroll") for (int tb = 0; tb < 4; ++tb) X[S][tb] = *(const u32x4*)(xg + (size_t)tb * 32 * DM + o_); \
        W[S][0] = *(const bf16x8*)(wg + o_); W[S][1] = *(const bf16x8*)(wg + 64 * 1024 + o_); W[S][2] = *(const bf16x8*)(wg2 + o_); W[S][3] = *(const bf16x8*)(wg2 + 64 * 1024 + o_); } while (0)
#define RT_CP(S) do { _Pragma("unroll") for (int tb = 0; tb < 4; ++tb) { \
            const f32x4 xa = {__uint_as_float(X[S][tb].x << 16), __uint_as_float(X[S][tb].x & 0xffff0000u), __uint_as_float(X[S][tb].y << 16), __uint_as_float(X[S][tb].y & 0xffff0000u)}, \
                        xb = {__uint_as_float(X[S][tb].z << 16), __uint_as_float(X[S][tb].z & 0xffff0000u), __uint_as_float(X[S][tb].w << 16), __uint_as_float(X[S][tb].w & 0xffff0000u)}; \
            ss[tb] += (xa[0] * xa[0] + xa[1] * xa[1]) + (xa[2] * xa[2] + xa[3] * xa[3]) + (xb[0] * xb[0] + xb[1] * xb[1]) + (xb[2] * xb[2] + xb[3] * xb[3]); \
            const bf16x8 xh = __builtin_bit_cast(bf16x8, X[S][tb]); \
            a0[tb] = MFMA32(W[S][0], xh, a0[tb]); a0[tb] = MFMA32(W[S][1], xh, a0[tb]); a1[tb] = MFMA32(W[S][2], xh, a1[tb]); a1[tb] = MFMA32(W[S][3], xh, a1[tb]); } } while (0)
    RT_LD(0, 0);
    for (int s = 0; s < 8; s += 2) {
        RT_LD(s + 1, 1);
        RT_CP(0);
        { const int sn = s + 2 < 8 ? s + 2 : 7; RT_LD(sn, 0); }
        RT_CP(1);
    }
#undef RT_LD
#undef RT_CP
#pragma unroll
    for (int r = 4; r >= 1; r >>= 1) {
        if (wave >= r && wave < 2 * r) { LAS float* o = xch + (wave - r) * (84 * 64) + lane;
#pragma unroll
            for (int tb = 0; tb < 4; ++tb) {
#pragma unroll
                for (int i = 0; i < 16; ++i) o[(tb * 21 + i) * 64] = a0[tb][i];
#pragma unroll
                for (int i = 0; i < 4; ++i) o[(tb * 21 + 16 + i) * 64] = a1[tb][i];
                o[(tb * 21 + 20) * 64] = ss[tb]; } }
        __syncthreads();
        if (wave < r) { const LAS float* o = xch + wave * (84 * 64) + lane;
#pragma unroll
            for (int tb = 0; tb < 4; ++tb) {
#pragma unroll
                for (int i = 0; i < 16; ++i) a0[tb][i] += o[(tb * 21 + i) * 64];
#pragma unroll
                for (int i = 0; i < 4; ++i) a1[tb][i] += o[(tb * 21 + 16 + i) * 64];
                ss[tb] += o[(tb * 21 + 20) * 64]; } }
        __syncthreads();
    }
    if (wave == 0) {
#pragma unroll
        for (int tb = 0; tb < 4; ++tb) {
            const int row = unit * 128 + tb * 32 + r32;
            const f32x16 acc0 = a0[tb], acc1 = a1[tb];
            const float rstd = rsqrtf(halfswap_sum(ss[tb]) * (1.f / DM) + EPS);
            float g[4];
#pragma unroll
            for (int r = 0; r < 4; ++r) { const float v = acc1[r] * rstd; const float o2 = __shfl_xor(v, 32); g[r] = (hi ? o2 : v) + bg[r]; }
            int gsel = 0; float gmax = g[0];
#pragma unroll
            for (int r = 1; r < 4; ++r) if (g[r] > gmax) { gmax = g[r]; gsel = r; }
            float gsum = 0.f;
#pragma unroll
            for (int r = 0; r < 4; ++r) gsum += expf(g[r] - gmax);
            const float gpb = 1.f / gsum;
            float part[4], e[8];
#pragma unroll
            for (int k = 0; k < 4; ++k) part[k] = (gsel == 0 ? acc0[k] : (gsel == 1 ? acc0[4 + k] : (gsel == 2 ? acc0[8 + k] : acc0[12 + k]))) * rstd;
#pragma unroll
            for (int k = 0; k < 4; ++k) { const float o2 = __shfl_xor(part[k], 32); e[k] = hi ? o2 : part[k]; e[4 + k] = hi ? part[k] : o2; }
#pragma unroll
            for (int i = 0; i < 8; ++i) e[i] += be[8 * gsel + i];
            int i1 = 0; float e1 = e[0];
#pragma unroll
            for (int i = 1; i < 8; ++i) if (e[i] > e1) { e1 = e[i]; i1 = i; }
            int i2 = -1; float e2 = -INFINITY;
#pragma unroll
            for (int i = 0; i < 8; ++i) if (i != i1 && e[i] > e2) { e2 = e[i]; i2 = i; }
            const float p2 = expf(e2 - e1), den = 1.f / (1.f + p2);
            if (hi == 0) {
                const int ea = 8 * gsel + i1, eb = 8 * gsel + i2;
                rt_e[2 * row] = ea; rt_e[2 * row + 1] = eb; rt_g[2 * row] = gpb * den; rt_g[2 * row + 1] = gpb * p2 * den; rstd_g[row] = rstd;
                atomicAdd((int*)&hist[ea], 1); atomicAdd((int*)&hist[eb], 1);
            }
        }
    }
    __syncthreads();
    if (tid < 32) cnt_g[unit * 32 + tid] = hist[tid];
    __syncthreads();
}

DI void sort_unit(const int* rt_e, int* rt_d, const float* rstd_g, const int* cnt_g, int* blk_e, int* nblk, int* src, float* rs_sorted, LAS unsigned char* lds, int unit, int tid) {
    const int lane = tid & 63, wave = __builtin_amdgcn_readfirstlane(tid >> 6);
    LAS int* pt = (LAS int*)lds; LAS int* pp = pt + 512; LAS int* tot = pp + 512; LAS int* pre = tot + 32; LAS int* base = pre + 32; LAS int* wc = base + 32; LAS int* est = wc + 128;
    { const int e = tid & 31, grp = tid >> 5; int t = 0, p = 0;
#pragma unroll 4
      for (int i = 0; i < 16; ++i) { const int c = grp * 16 + i; const int v = cnt_g[c * 32 + e]; t += v; p += (c < unit) ? v : 0; }
      pt[tid] = t; pp[tid] = p; }
    int ea = -1;
    if (tid < 256) ea = rt_e[unit * 256 + tid];
    __syncthreads();
    if (tid < 32) { int t = 0, p = 0;
#pragma unroll
        for (int g = 0; g < 16; ++g) { t += pt[g * 32 + tid]; p += pp[g * 32 + tid]; }
        tot[tid] = t; pre[tid] = p; }
    int myrank = 0;
    if (wave < 4) { int mycnt = 0;
        for (int e = 0; e < 32; ++e) { const unsigned long long m = __builtin_amdgcn_ballot_w64(ea == e);
            if (ea == e) myrank = __builtin_popcountll(m & ((1ull << lane) - 1ull));
            if (lane == e) mycnt = __builtin_popcountll(m); }
        if (lane < 32) wc[wave * 32 + lane] = mycnt; }
    __syncthreads();
    if (tid == 0) { int s = 0; for (int e = 0; e < 32; ++e) { const int padded = (tot[e] + 255) & ~255; base[e] = s + pre[e]; est[e] = s;
            if (unit == 0) for (int j = s >> 8; j < ((s + padded) >> 8); ++j) blk_e[j] = e;
            s += padded; }
        if (unit == 0) *nblk = s >> 8; }
    __syncthreads();
    if (tid < 256) { int d = base[ea] + myrank; for (int w = 0; w < wave; ++w) d += wc[w * 32 + ea];
        const int tok = unit * 128 + (tid >> 1);
        rt_d[unit * 256 + tid] = d; src[d] = tok; rs_sorted[d] = rstd_g[tok]; }
    if (unit < 32) { const int e = unit, first = est[e] + tot[e], npad = ((tot[e] + 255) & ~255) - tot[e];
        for (int i = tid; i < npad; i += NTHR) { src[first + i] = 0; rs_sorted[first + i] = 0.f; } }
    __syncthreads();
}

constexpr int NPH = 20;
struct Args { In in; float* out; unsigned char* ws; int ph_lo, ph_hi, li, pad; };
__global__ void __launch_bounds__(NTHR, 2) fwd(Args args) {
    extern __shared__ __attribute__((aligned(16))) unsigned char lds_raw[];
    LAS unsigned char* lds = (LAS unsigned char*)lds_raw;
    const int tid0 = threadIdx.x;
    const int wave0 = __builtin_amdgcn_readfirstlane(tid0 >> 6);
    const int G = gridDim.x;
    unsigned char* ws0 = args.ws; const In& I = args.in;
    gu32* ctl = (gu32*)(ws0 + WS_CTL);
    volatile LAS unsigned* MISC = (volatile LAS unsigned*)(lds + MISC_OFF);
    if (tid0 < 64) MISC[tid0] = 0u;
    __syncthreads();
    XcdBarrier bar = xcd_barrier_post((unsigned*)(ctl + CW_BAR) + args.li * XCD_BAR_WORDS, MISC + 8);
    const int lo = args.ph_lo, hi_ph = args.ph_hi;
#ifndef PHMASK
#define PHMASK 0xFFFFF
#endif
#define IN(k) (lo <= (k) && (k) < hi_ph)
#define EN(j) ((PHMASK >> (j)) & 1)
#ifndef REPMASK
#define REPMASK 0
#endif
#define NREP(j) (1 + ((REPMASK >> (j)) & 1))
#define SEAM(k) do { if (IN(k) && IN((k) + 1)) xcd_barrier(bar); } while (0)
#define PHASE_ENV \
    int tid = wave0 * 64 + (int)__builtin_amdgcn_mbcnt_hi(~0u, __builtin_amdgcn_mbcnt_lo(~0u, 0u)); asm volatile("" : "+v"(tid)); GAS unsigned char* wsg_ = (GAS unsigned char*)ws0; asm volatile("" : "+s"(wsg_)); unsigned char* ws = (unsigned char*)wsg_; \
    const int lane = tid & 63, wave = __builtin_amdgcn_readfirstlane(tid >> 6); const int gw = blockIdx.x * NWAVES + wave, NGW = G * NWAVES; \
    bf16* XA = (bf16*)(ws + WS_XA); float* OUT = (float*)(GAS float*)args.out; bf16* XN = (bf16*)(GAS bf16*)args.out; (void)OUT; bf16* Z = (bf16*)(ws + WS_Z); unsigned char* XS = ws + WS_Z; unsigned char* Y = ws + WS_Z; \
    bf16* MLA = (bf16*)(ws + WS_MLA); unsigned char* H = ws + WS_MLA; unsigned long long* MASK = (unsigned long long*)(ws + WS_MASK); \
    unsigned char* WGU = ws + WS_WGU; unsigned char* WD = ws + WS_WD; const float* par = (const float*)(ws + WS_PAR); \
    int* rt_e = (int*)(ws + WS_ROUTE + RT_E); float* rt_g = (float*)(ws + WS_ROUTE + RT_G); int* rt_d = (int*)(ws + WS_ROUTE + RT_D); \
    int* cnt_g = (int*)(ws + WS_ROUTE + RT_CNT); float* rstd_g = (float*)(ws + WS_ROUTE + RT_RSTD); int* blk_e = (int*)(ws + WS_ROUTE + RT_BLK); int* nblk = (int*)(ws + WS_ROUTE + RT_NBLK); \
    (void)lane; (void)gw; (void)NGW; (void)XA; (void)XN; (void)Z; (void)XS; (void)Y; (void)MLA; (void)H; (void)MASK; (void)WGU; (void)WD; (void)par; (void)rt_e; (void)rt_g; (void)rt_d; (void)cnt_g; (void)rstd_g; (void)blk_e; (void)nblk;

    if (EN(0) && IN(0)) { PHASE_ENV for (int rep = 0; rep < NREP(0); ++rep) prologue_phase(I, ws, lds, gw, NGW, lane, wave); }
    if (!(IN(0) && IN(1))) SEAM(0);
    {
        constexpr int l = 0;
        const int pb = 1 + 9 * l;
        if (EN(1) && IN(pb)) { PHASE_ENV
            if (l == 0) { for (int rep = 0; rep < NREP(1); ++rep) norm_phase<0>(I.x, XA, OUT, XN, I.norm_mix, Y, rt_d, rt_g, gw, NGW, lane); }
            else norm_phase<1>(I.x, XA, OUT, XN, I.norm_mix + DM, Y, rt_d, rt_g, gw, NGW, lane);
        }
        SEAM(pb);
        if (EN(2) && IN(pb + 1)) { PHASE_ENV
            pg8::Gemm g{XN, (const bf16*)(ws + WS_WIN) + (size_t)l * ZP * 1024, 1024, 1024}; pg8::StaticOrder S; S.init(M, ZP, G, (int)blockIdx.x); S.rep = NREP(2);
            pg8::EpiZ E{Z, (bf16*)(ws + WS_KIDX)};
            pg8::gemm_phase<pg8::EpiZ, pg8::StaticOrder, true, true>(lds, g, S, E, tid);
        }
        SEAM(pb + 1);
        if (EN(3) && IN(pb + 2)) { PHASE_ENV
            for (int rep = 0; rep < NREP(3); ++rep) {
            if (!((REPMASK >> 12) & 1) || rep == 0) for (int u = gw; u < 2048; u += NGW) mla_prep_unit(Z, (const bf16*)(ws + WS_WUQ) + (size_t)l * 192 * 256, (const bf16*)(ws + WS_WUKV) + (size_t)l * 384 * 128,
                                                               (const float*)(ws + WS_PAR + PAR_COS), (const float*)(ws + WS_PAR + PAR_SIN), MLA, u, lane);
            for (int i = blockIdx.x * NTHR + tid; i < NB * 256 * 4; i += G * NTHR) { const int b = i >> 10, t = (i >> 2) & 255, j = i & 3; MASK[((size_t)b * SEQ + t) * 64 + j] = ~0ull; }
            { const bf16* KX = (const bf16*)(ws + WS_KIDX); DsaOps cur_, nxt_;
              const int R0 = 9 * G <= 3840 ? 9 : 3840 / G, NST = R0 * G;
              gu32* dctr = ctl + CW_QCTR + 64 * (l + 2 * rep) + 32;
              volatile LAS int* dslot = (volatile LAS int*)(lds + MISC_OFF + 128);
              int it = blockIdx.x, r_ = 0;
              if (R0 == 0) { if (tid == 0) *dslot = (int)__hip_atomic_fetch_add(dctr, 1u, RLX_AGENT); __syncthreads(); it = *dslot; __syncthreads(); }
              if (it < 3840) dsa_load_ops(Z, KX, it, wave, lane, cur_);
              while (it < 3840) {
                  int nx;
                  if (++r_ < R0) nx = it + G;
                  else { if (tid == 0) *dslot = NST + (int)__hip_atomic_fetch_add(dctr, 1u, RLX_AGENT); __syncthreads(); nx = *dslot; }
                  dsa_load_ops(Z, KX, nx < 3840 ? nx : it, wave, lane, nxt_); dsa_select_item(Z, KX, MASK, lds, cur_, it, tid); cur_ = nxt_; it = nx; } }
            }
        }
        SEAM(pb + 2);
        if (EN(4) && IN(pb + 3)) { PHASE_ENV for (int rep = 0; rep < NREP(4); ++rep) attn_phase(Z, MLA, XN, MASK, (unsigned*)(ws + WS_O0), par, I.diff_subln, l, ctl + CW_QCTR + 64 * (l + 2 * rep),
                I.w_gate + (size_t)l * NEXP * 1024 * 512, I.w_up + (size_t)l * NEXP * 1024 * 512, I.w_down + (size_t)l * NEXP * 512 * 1024, WGU, WD, lds, tid); }
        SEAM(pb + 3);
        if (EN(5) && IN(pb + 4)) { PHASE_ENV
            pg8::Gemm g{XN, (const bf16*)(ws + WS_WOUT) + (size_t)l * 1024 * 1024, 1024, 1024}; pg8::StaticOrder S; S.init(M, DM, G, (int)blockIdx.x); S.rep = NREP(5);
            pg8::EpiRes<(l != 0)> E{l == 0 ? (const void*)I.x : (const void*)XA, XA, I.norm_ffn + l * DM, ws + WS_XT};
            pg8::gemm_phase<pg8::EpiRes<(l != 0)>, pg8::StaticOrder, true, true>(lds, g, S, E, tid);
        }
        SEAM(pb + 4);
        if (EN(6) && IN(pb + 5)) { PHASE_ENV for (int rep = 0; rep < NREP(6); ++rep) for (int u = blockIdx.x; u < 256; u += G)
            router_unit(XA, (const bf16*)(ws + WS_WR) + (size_t)l * 2 * 64 * 1024, I.b_group + l * 4, I.b_expert + l * 32, rt_e, rt_g, rstd_g, cnt_g, lds, u, tid); }
        SEAM(pb + 5);
        if (EN(7) && IN(pb + 6)) { PHASE_ENV for (int rep = 0; rep < NREP(7); ++rep) for (int u = blockIdx.x; u < 256; u += G) sort_unit(rt_e, rt_d, rstd_g, cnt_g, blk_e, nblk, (int*)(ws + WS_SRC), (float*)(ws + WS_RS), lds, u, tid); }
        SEAM(pb + 6);
        if (EN(8) && IN(pb + 7)) { PHASE_ENV
            pg8::Gemm g{ws + WS_XT, WGU, 1024, 1024}; pg8::MoeOrder S{blk_e, *nblk * 4, G, (int)blockIdx.x, NREP(8), (const int*)(ws + WS_SRC)};
            pg8::EpiGU E{H, (const float*)(ws + WS_RS)};
            pg8::gemm_phase<pg8::EpiGU, pg8::MoeOrder, true, true, 1, true>(lds, g, S, E, tid);
        }
        SEAM(pb + 7);
        if (EN(9) && IN(pb + 8)) { PHASE_ENV
            pg8::Gemm g{H, WD, 512, 512}; pg8::MoeOrder S{blk_e, *nblk * 4, G, (int)blockIdx.x, NREP(9)};
            pg8::EpiF8A E{Y, DM, 16.f / 256.f};
            pg8::gemm_phase<pg8::EpiF8A, pg8::MoeOrder, true, true, 1, false, true>(lds, g, S, E, tid);
        }
        SEAM(pb + 8);
    }
    {
        constexpr int l = 1;
        const int pb = 1 + 9 * l;
        if (EN(1) && IN(pb)) { PHASE_ENV
            if (l == 0) { for (int rep = 0; rep < NREP(1); ++rep) norm_phase<0>(I.x, XA, OUT, XN, I.norm_mix, Y, rt_d, rt_g, gw, NGW, lane); }
            else norm_phase<1>(I.x, XA, OUT, XN, I.norm_mix + DM, Y, rt_d, rt_g, gw, NGW, lane);
        }
        SEAM(pb);
        if (EN(2) && IN(pb + 1)) { PHASE_ENV
            pg8::Gemm g{XN, (const bf16*)(ws + WS_WIN) + (size_t)l * ZP * 1024, 1024, 1024}; pg8::StaticOrder S; S.init(M, ZP, G, (int)blockIdx.x); S.rep = NREP(2);
            pg8::EpiZ E{Z, (bf16*)(ws + WS_KIDX)};
            pg8::gemm_phase<pg8::EpiZ, pg8::StaticOrder, true, true>(lds, g, S, E, tid);
        }
        SEAM(pb + 1);
        if (EN(3) && IN(pb + 2)) { PHASE_ENV
            for (int rep = 0; rep < NREP(3); ++rep) {
            if (!((REPMASK >> 12) & 1) || rep == 0) for (int u = gw; u < 2048; u += NGW) mla_prep_unit(Z, (const bf16*)(ws + WS_WUQ) + (size_t)l * 192 * 256, (const bf16*)(ws + WS_WUKV) + (size_t)l * 384 * 128,
                                                               (const float*)(ws + WS_PAR + PAR_COS), (const float*)(ws + WS_PAR + PAR_SIN), MLA, u, lane);
            for (int i = blockIdx.x * NTHR + tid; i < NB * 256 * 4; i += G * NTHR) { const int b = i >> 10, t = (i >> 2) & 255, j = i & 3; MASK[((size_t)b * SEQ + t) * 64 + j] = ~0ull; }
            { const bf16* KX = (const bf16*)(ws + WS_KIDX); DsaOps cur_, nxt_;
              const int R0 = 9 * G <= 3840 ? 9 : 3840 / G, NST = R0 * G;
              gu32* dctr = ctl + CW_QCTR + 64 * (l + 2 * rep) + 32;
              volatile LAS int* dslot = (volatile LAS int*)(lds + MISC_OFF + 128);
              int it = blockIdx.x, r_ = 0;
              if (R0 == 0) { if (tid == 0) *dslot = (int)__hip_atomic_fetch_add(dctr, 1u, RLX_AGENT); __syncthreads(); it = *dslot; __syncthreads(); }
              if (it < 3840) dsa_load_ops(Z, KX, it, wave, lane, cur_);
              while (it < 3840) {
                  int nx;
                  if (++r_ < R0) nx = it + G;
                  else { if (tid == 0) *dslot = NST + (int)__hip_atomic_fetch_add(dctr, 1u, RLX_AGENT); __syncthreads(); nx = *dslot; }
                  dsa_load_ops(Z, KX, nx < 3840 ? nx : it, wave, lane, nxt_); dsa_select_item(Z, KX, MASK, lds, cur_, it, tid); cur_ = nxt_; it = nx; } }
            }
        }
        SEAM(pb + 2);
        if (EN(4) && IN(pb + 3)) { PHASE_ENV for (int rep = 0; rep < NREP(4); ++rep) attn_phase(Z, MLA, XN, MASK, (unsigned*)(ws + WS_O0), par, I.diff_subln, l, ctl + CW_QCTR + 64 * (l + 2 * rep),
                I.w_gate + (size_t)l * NEXP * 1024 * 512, I.w_up + (size_t)l * NEXP * 1024 * 512, I.w_down + (size_t)l * NEXP * 512 * 1024, WGU, WD, lds, tid); }
        SEAM(pb + 3);
        if (EN(5) && IN(pb + 4)) { PHASE_ENV
            pg8::Gemm g{XN, (const bf16*)(ws + WS_WOUT) + (size_t)l * 1024 * 1024, 1024, 1024}; pg8::StaticOrder S; S.init(M, DM, G, (int)blockIdx.x); S.rep = NREP(5);
            pg8::EpiRes<(l != 0)> E{l == 0 ? (const void*)I.x : (const void*)XA, XA, I.norm_ffn + l * DM, ws + WS_XT};
            pg8::gemm_phase<pg8::EpiRes<(l != 0)>, pg8::StaticOrder, true, true>(lds, g, S, E, tid);
        }
        SEAM(pb + 4);
        if (EN(6) && IN(pb + 5)) { PHASE_ENV for (int rep = 0; rep < NREP(6); ++rep) for (int u = blockIdx.x; u < 256; u += G)
            router_unit(XA, (const bf16*)(ws + WS_WR) + (size_t)l * 2 * 64 * 1024, I.b_group + l * 4, I.b_expert + l * 32, rt_e, rt_g, rstd_g, cnt_g, lds, u, tid); }
        SEAM(pb + 5);
        if (EN(7) && IN(pb + 6)) { PHASE_ENV for (int rep = 0; rep < NREP(7); ++rep) for (int u = blockIdx.x; u < 256; u += G) sort_unit(rt_e, rt_d, rstd_g, cnt_g, blk_e, nblk, (int*)(ws + WS_SRC), (float*)(ws + WS_RS), lds, u, tid); }
        SEAM(pb + 6);
        if (EN(8) && IN(pb + 7)) { PHASE_ENV
            pg8::Gemm g{ws + WS_XT, WGU, 1024, 1024}; pg8::MoeOrder S{blk_e, *nblk * 4, G, (int)blockIdx.x, NREP(8), (const int*)(ws + WS_SRC)};
            pg8::EpiGU E{H, (const float*)(ws + WS_RS)};
            pg8::gemm_phase<pg8::EpiGU, pg8::MoeOrder, true, true, 1, true>(lds, g, S, E, tid);
        }
        SEAM(pb + 7);
        if (EN(9) && IN(pb + 8)) { PHASE_ENV
            pg8::Gemm g{H, WD, 512, 512}; pg8::MoeOrder S{blk_e, *nblk * 4, G, (int)blockIdx.x, NREP(9)};
            pg8::EpiF8A E{Y, DM, 16.f / 256.f};
            pg8::gemm_phase<pg8::EpiF8A, pg8::MoeOrder, true, true, 1, false, true>(lds, g, S, E, tid);
        }
        SEAM(pb + 8);
    }
    if (EN(10) && IN(19)) { PHASE_ENV norm_phase<2>(I.x, XA, OUT, XN, I.norm_final, Y, rt_d, rt_g, gw, NGW, lane); }
#undef IN
#undef SEAM
}

#ifndef MK_SPLIT
#define MK_SPLIT 0
#endif
extern "C" void kernel_launch(void* const* d_in, const int* in_sizes, int n_in, void* d_out, int out_size, void* d_ws, size_t ws_size, hipStream_t stream) {
    static int grid = 0;
    if (grid == 0) {
        if (n_in != 23 || out_size != M * DM || ws_size < WS_END) { fprintf(stderr, "kernel_launch: unexpected shapes (n_in %d out %d ws %zu)\n", n_in, out_size, ws_size); grid = -1; return; }
        int dev = 0, cus = 0, per_cu = 0;
        if (hipGetDevice(&dev) != hipSuccess || hipDeviceGetAttribute(&cus, hipDeviceAttributeMultiprocessorCount, dev) != hipSuccess) { grid = -1; return; }
        if (hipFuncSetAttribute((const void*)fwd, hipFuncAttributeMaxDynamicSharedMemorySize, LDS_BYTES) != hipSuccess) { fprintf(stderr, "kernel_launch: hipFuncSetAttribute failed\n"); grid = -1; return; }
        if (hipOccupancyMaxActiveBlocksPerMultiprocessor(&per_cu, (const void*)fwd, NTHR, LDS_BYTES) != hipSuccess || per_cu < 1) { fprintf(stderr, "kernel_launch: occupancy query says %d\n", per_cu); }
        (void)hipGetLastError();
        grid = cus;
    }
    if (grid < 0) return;
    (void)hipMemsetAsync((char*)d_ws + WS_CTL, 0, CTL_ZERO_BYTES, stream);
    Args a{};
    const float** ip = (const float**)&a.in;
    for (int i = 0; i < 23; ++i) ip[i] = (const float*)d_in[i];
    a.out = (float*)d_out; a.ws = (unsigned char*)d_ws;
#if MK_SPLIT
    for (int p = 0; p < NPH; ++p) { a.ph_lo = p; a.ph_hi = p + 1; a.li = p; hipLaunchKernelGGL(fwd, dim3(grid), dim3(NTHR), LDS_BYTES, stream, a); }
#else
    a.ph_lo = 0; a.ph_hi = NPH; a.li = 0;
    hipLaunchKernelGGL(fwd, dim3(grid), dim3(NTHR), LDS_BYTES, stream, a);
#endif
}
```
